# Optimizing an MI355X kernel written in HIP

```python
import math
import jax
import jax.numpy as jnp
from jax import lax
import numpy as np

D_MODEL = 2048
BATCH = 8
SEQ = 2048
DEPTH = 2

GRID_W = 64
CTX_LEN = 256
N_MOD = 9
FFN_DIM = 5632
A_HEADS = 8
A_HEAD_DIM = 64
A_VAL_DIM = 2 * A_HEAD_DIM
B_HEADS = 8
B_HEAD_DIM = 128
WIN_R = 8
WIN_C = 16
C_HEADS = 8
C_KEY_DIM = 64
C_VAL_DIM = 128
RET_CHUNK = 64
BRANCH_W = 1024
N_BRANCH = 3
ATTN_BLOCK = 128
ROPE_BASE = 10000.0
EPS = 1e-6
SPLIT_SIZES = (
    A_HEADS * 2 * A_HEAD_DIM,
    A_HEADS * 2 * A_HEAD_DIM,
    A_HEADS * A_VAL_DIM,
    B_HEADS * B_HEAD_DIM,
    B_HEADS * B_HEAD_DIM,
    B_HEADS * B_HEAD_DIM,
    C_HEADS * C_KEY_DIM,
    C_HEADS * C_KEY_DIM,
    C_HEADS * C_VAL_DIM,
    C_HEADS * C_VAL_DIM,
    N_BRANCH * D_MODEL,
)
IN_COLS = sum(SPLIT_SIZES)

kernel_name = 'hybrid_diffusion_prefix_trunk'


def rmsnorm(x, g):
    x32 = x.astype(jnp.float32)
    y = x32 * lax.rsqrt(jnp.mean(x32 * x32, axis=-1, keepdims=True) + EPS)
    return (y * g.astype(jnp.float32)).astype(x.dtype)


def adaln_in(t, gain, shift, scale):
    return rmsnorm(t, gain) * (1 + scale) + shift


def swiglu(u, w_in, w_out):
    a, b = jnp.split(u @ w_in, 2, axis=-1)
    return (jax.nn.silu(a) * b) @ w_out


def half_ffn_sublayer(t, pre_g, post_g, shift, scale, gate, w1, w2):
    u = adaln_in(t, pre_g, shift, scale)
    return t + 0.5 * gate * rmsnorm(swiglu(u, w1, w2), post_g)


def to_heads(t, n_heads):
    b, l, _ = t.shape
    return t.reshape(b, l, n_heads, -1).transpose(0, 2, 1, 3)


def from_heads(t):
    b, h, l, d = t.shape
    return t.transpose(0, 2, 1, 3).reshape(b, l, h * d)


def rope_1d(t, pos):
    half = t.shape[-1] // 2
    inv = ROPE_BASE ** (-jnp.arange(half, dtype=jnp.float32) / half)
    ang = pos[:, None] * inv[None, :]
    cos = jnp.cos(ang).astype(t.dtype)
    sin = jnp.sin(ang).astype(t.dtype)
    t1, t2 = t[..., :half], t[..., half:]
    return jnp.concatenate([t1 * cos - t2 * sin, t1 * sin + t2 * cos], axis=-1)


def axial_rope(t, prow, pcol):
    half = t.shape[-1] // 2
    return jnp.concatenate([rope_1d(t[..., :half], prow), rope_1d(t[..., half:], pcol)], axis=-1)


def softmax32(s):
    return jax.nn.softmax(s.astype(jnp.float32), axis=-1)


def diff_attention(qc, kc, vc, ql, kl, vl, lam, norm_g, lambda_init, with_ctx_out):
    scale = A_HEAD_DIM ** -0.5

    def attend(q, k, v):
        s1 = jnp.einsum('bhqd,bhkd->bhqk', q[..., :A_HEAD_DIM], k[..., :A_HEAD_DIM]) * scale
        s2 = jnp.einsum('bhqd,bhkd->bhqk', q[..., A_HEAD_DIM:], k[..., A_HEAD_DIM:]) * scale
        p = softmax32(s1) - lam * softmax32(s2)
        return jnp.einsum('bhqk,bhkv->bhqv', p.astype(v.dtype), v)

    def finish(o):
        return from_heads(rmsnorm(o, norm_g) * (1.0 - lambda_init))

    b, h, l, dq = ql.shape
    nb = l // ATTN_BLOCK
    k_all = jnp.concatenate([kc, kl], axis=2)
    v_all = jnp.concatenate([vc, vl], axis=2)
    q_blocks = ql.reshape(b, h, nb, ATTN_BLOCK, dq).transpose(2, 0, 1, 3, 4)
    ol = lax.map(lambda qb: attend(qb, k_all, v_all), q_blocks)
    ol = ol.transpose(1, 2, 0, 3, 4).reshape(b, h, l, -1)
    oc = finish(attend(qc, kc, vc)) if with_ctx_out else None
    return oc, finish(ol)


def neighbourhood_attention(qc, kc, vc, ql, kl, vl, rpb, rows, with_ctx_out):
    b, h, l, d = ql.shape
    scale = d ** -0.5
    wr = min(WIN_R, rows)
    ncb = GRID_W // WIN_C
    band = 2 * WIN_C
    qcol = jnp.arange(GRID_W).reshape(ncb, WIN_C)
    kcol = (jnp.clip(jnp.arange(ncb) * WIN_C - WIN_C // 2, 0, GRID_W - band)[:, None]
            + jnp.arange(band)[None, :])
    cstart = jnp.clip(qcol - WIN_C // 2, 0, GRID_W - WIN_C)
    col_ok = ((kcol[:, None, :] >= cstart[:, :, None])
              & (kcol[:, None, :] < cstart[:, :, None] + WIN_C))
    dc_idx = jnp.clip(kcol[:, None, :] - qcol[:, :, None] + WIN_C - 1, 0, 2 * WIN_C - 2)
    qg, kg, vg = (t.reshape(b, h, rows, GRID_W, d) for t in (ql, kl, vl))

    def row_block(r):
        rs = jnp.clip(r - wr // 2, 0, rows - wr)
        krow = lax.dynamic_slice_in_dim(kg, rs, wr, axis=2)[:, :, :, kcol]
        vrow = lax.dynamic_slice_in_dim(vg, rs, wr, axis=2)[:, :, :, kcol]
        qb = lax.dynamic_index_in_dim(qg, r, axis=2, keepdims=False).reshape(b, h, ncb, WIN_C, d)
        dr_idx = rs + jnp.arange(wr) - r + WIN_R - 1
        bias = rpb[:, dr_idx[None, None, :, None], dc_idx[:, :, None, :]]
        s_lat = (jnp.einsum('bhjqd,bhrjkd->bhjqrk', qb, krow).astype(jnp.float32) * scale
                 + bias.astype(jnp.float32))
        s_lat = jnp.where(col_ok[:, :, None, :], s_lat, -jnp.inf).reshape(b, h, ncb, WIN_C, wr * band)
        s_ctx = jnp.einsum('bhjqd,bhkd->bhjqk', qb, kc).astype(jnp.float32) * scale
        p = softmax32(jnp.concatenate([s_lat, s_ctx], axis=-1)).astype(vl.dtype)
        p_lat = p[..., :wr * band].reshape(b, h, ncb, WIN_C, wr, band)
        o = (jnp.einsum('bhjqrk,bhrjkd->bhjqd', p_lat, vrow)
             + jnp.einsum('bhjqk,bhkd->bhjqd', p[..., wr * band:], vc))
        return o.reshape(b, h, GRID_W, d)

    ol = lax.map(row_block, jnp.arange(rows))
    ol = from_heads(ol.transpose(1, 2, 0, 3, 4).reshape(b, h, l, d))
    oc = None
    if with_ctx_out:
        pc = softmax32(jnp.einsum('bhqd,bhkd->bhqk', qc, kc) * scale).astype(vc.dtype)
        oc = from_heads(jnp.einsum('bhqk,bhkd->bhqd', pc, vc))
    return oc, ol


def retention_chunkwise(q, k, v, log_g, s0):
    b, h, l, dk = q.shape
    dv = v.shape[-1]
    n = l // RET_CHUNK
    idx = jnp.arange(RET_CHUNK, dtype=jnp.float32)
    lg = log_g[:, None]
    dist = idx[:, None] - idx[None, :]
    intra = jnp.where(dist >= 0, jnp.exp(lg[:, :, None] * jnp.maximum(dist, 0.0)), 0.0)
    q_dec = jnp.exp(lg * (idx + 1.0))[..., None]
    k_dec = jnp.exp(lg * (RET_CHUNK - 1.0 - idx))[..., None]
    c_dec = jnp.exp(lg * RET_CHUNK)[..., None]

    def chunks(t):
        return t.reshape(b, h, n, RET_CHUNK, -1).transpose(2, 0, 1, 3, 4)

    def step(s, inp):
        qi, ki, vi = inp
        att = jnp.einsum('bhqd,bhkd->bhqk', qi, ki) * intra
        o = (jnp.einsum('bhqk,bhkv->bhqv', att, vi)
             + jnp.einsum('bhqd,bhdv->bhqv', qi * q_dec, s))
        s = s * c_dec + jnp.einsum('bhkd,bhkv->bhdv', ki * k_dec, vi)
        return s, o

    s, o = lax.scan(step, s0, (chunks(q), chunks(k), chunks(v)))
    return o.transpose(1, 2, 0, 3, 4).reshape(b, h, l, dv), s


def retention(qc, kc, vc, ql, kl, vl, decay_logit, norm_g, with_ctx_out):
    log_g = jax.nn.log_sigmoid(decay_logit.astype(jnp.float32))
    qc, kc, vc, ql, kl, vl = (t.astype(jnp.float32) for t in (qc, kc, vc, ql, kl, vl))
    flip = lambda t: jnp.flip(t, axis=2)
    b, h, _, dk = ql.shape
    s0 = jnp.zeros((b, h, dk, vl.shape[-1]), jnp.float32)
    oc_f, sc_f = retention_chunkwise(qc, kc, vc, log_g[0], s0)
    oc_b, sc_b = retention_chunkwise(flip(qc), flip(kc), flip(vc), log_g[1], s0)
    ol_f, _ = retention_chunkwise(ql, kl, vl, log_g[0], sc_f)
    ol_b, _ = retention_chunkwise(flip(ql), flip(kl), flip(vl), log_g[1], sc_b)
    finish = lambda o: from_heads(rmsnorm(o, norm_g))
    oc = finish(oc_f + flip(oc_b)) if with_ctx_out else None
    return oc, finish(ol_f + flip(ol_b))


def token_mixer(uc, ul, w_in, diff_lambda, diff_norm, na_rpb, ret_decay, ret_norm, w_branch, w_out,
                lambda_init, with_ctx_out):
    b, l, _ = ul.shape
    rows = l // GRID_W
    pos = jnp.arange(l)
    prow = (pos // GRID_W).astype(jnp.float32)
    pcol = (pos % GRID_W).astype(jnp.float32)
    offsets = [int(o) for o in np.cumsum(SPLIT_SIZES)[:-1]]
    aq, ak, av, bq, bk, bv, cq, ck, cv, cg, gates = jnp.split(ul @ w_in, offsets, axis=-1)
    aqc, akc, avc, bqc, bkc, bvc, cqc, ckc, cvc, cgc, gatesc = jnp.split(uc @ w_in, offsets, axis=-1)
    rope = lambda t: axial_rope(t, prow, pcol)
    rope2 = lambda t: jnp.concatenate([rope(t[..., :A_HEAD_DIM]), rope(t[..., A_HEAD_DIM:])], axis=-1)

    lv = diff_lambda.astype(jnp.float32)
    lam = jnp.exp(jnp.sum(lv[0] * lv[1])) - jnp.exp(jnp.sum(lv[2] * lv[3])) + lambda_init
    oa_c, oa_l = diff_attention(
        to_heads(aqc, A_HEADS), to_heads(akc, A_HEADS), to_heads(avc, A_HEADS),
        rope2(to_heads(aq, A_HEADS)), rope2(to_heads(ak, A_HEADS)), to_heads(av, A_HEADS),
        lam, diff_norm, lambda_init, with_ctx_out)

    ob_c, ob_l = neighbourhood_attention(
        to_heads(bqc, B_HEADS), to_heads(bkc, B_HEADS), to_heads(bvc, B_HEADS),
        to_heads(bq, B_HEADS), to_heads(bk, B_HEADS), to_heads(bv, B_HEADS),
        na_rpb, rows, with_ctx_out)

    kscale = C_KEY_DIM ** -0.5
    or_c, or_l = retention(
        to_heads(cqc, C_HEADS), to_heads(ckc, C_HEADS) * kscale, to_heads(cvc, C_HEADS),
        rope(to_heads(cq, C_HEADS)), rope(to_heads(ck, C_HEADS)) * kscale, to_heads(cv, C_HEADS),
        ret_decay, ret_norm, with_ctx_out)

    def merge(oa, ob, orr, g_ret, g_lin):
        yr = jax.nn.silu(g_ret) * orr.astype(g_ret.dtype)
        ga, gb, gr = jnp.split(jax.nn.sigmoid(g_lin), N_BRANCH, axis=-1)
        merged = ga * (oa @ w_branch[0]) + gb * (ob @ w_branch[1]) + gr * (yr @ w_branch[2])
        return merged @ w_out

    yl = merge(oa_l, ob_l, or_l, cg, gates)
    yc = merge(oa_c, ob_c, or_c, cgc, gatesc) if with_ctx_out else None
    return yc, yl


def setup_inputs(seed: int = 0) -> dict:
    key = jax.random.key(seed)
    ks = jax.random.split(key, 18)
    f32 = jnp.float32

    def normal(k, shape):
        return jax.random.normal(k, shape, f32)

    def dense(k, shape, fan_in, gain=1.0):
        return normal(k, shape) * (gain * fan_in ** -0.5)

    def near_one(k, shape):
        return 1.0 + 0.02 * normal(k, shape)

    gamma0 = 1.0 - 2.0 ** (-5.0 - jnp.arange(C_HEADS, dtype=f32))
    decay_logit = jnp.log(gamma0) - jnp.log1p(-gamma0)
    return {
        'x': normal(ks[0], (BATCH, SEQ, D_MODEL)),
        'c': normal(ks[1], (BATCH, D_MODEL)),
        'ctx': normal(ks[2], (BATCH, CTX_LEN, D_MODEL)),
        'c_ctx': normal(ks[3], (D_MODEL,)),
        'w_mod': dense(ks[4], (DEPTH, D_MODEL, N_MOD * D_MODEL), D_MODEL, 0.5),
        'b_mod': 0.01 * normal(ks[5], (DEPTH, N_MOD * D_MODEL)),
        'pre_norm': near_one(ks[6], (DEPTH, 3, D_MODEL)),
        'post_norm': near_one(ks[7], (DEPTH, 3, D_MODEL)),
        'ffn_w_in': dense(ks[8], (DEPTH, 2, D_MODEL, 2 * FFN_DIM), D_MODEL),
        'ffn_w_out': dense(ks[9], (DEPTH, 2, FFN_DIM, D_MODEL), FFN_DIM),
        'w_in': dense(ks[10], (DEPTH, D_MODEL, IN_COLS), D_MODEL),
        'diff_lambda': 0.1 * normal(ks[11], (DEPTH, 4, A_HEAD_DIM)),
        'diff_norm': near_one(ks[12], (DEPTH, A_VAL_DIM)),
        'na_rpb': 0.1 * normal(ks[13], (DEPTH, B_HEADS, 2 * WIN_R - 1, 2 * WIN_C - 1)),
        'ret_decay': decay_logit + 0.05 * normal(ks[14], (DEPTH, 2, C_HEADS)),
        'ret_norm': near_one(ks[15], (DEPTH, C_VAL_DIM)),
        'w_branch': dense(ks[16], (DEPTH, N_BRANCH, BRANCH_W, D_MODEL), BRANCH_W),
        'w_out': dense(ks[17], (DEPTH, D_MODEL, D_MODEL), D_MODEL),
    }


def reference(x, c, ctx, c_ctx, w_mod, b_mod, pre_norm, post_norm, ffn_w_in, ffn_w_out, w_in,
              diff_lambda, diff_norm, na_rpb, ret_decay, ret_norm, w_branch, w_out):
    b, _, d = x.shape
    h, hc = x, ctx
    for l in range(DEPTH):
        with_ctx_out = l < DEPTH - 1
        lambda_init = 0.8 - 0.6 * math.exp(-0.3 * l)
        mod = (jax.nn.silu(c) @ w_mod[l] + b_mod[l]).reshape(b, N_MOD, d).transpose(1, 0, 2)[:, :, None, :]
        modc = (jax.nn.silu(c_ctx) @ w_mod[l] + b_mod[l]).reshape(N_MOD, d)
        h = half_ffn_sublayer(h, pre_norm[l, 0], post_norm[l, 0], mod[0], mod[1], mod[2],
                              ffn_w_in[l, 0], ffn_w_out[l, 0])
        hc = half_ffn_sublayer(hc, pre_norm[l, 0], post_norm[l, 0], modc[0], modc[1], modc[2],
                               ffn_w_in[l, 0], ffn_w_out[l, 0])
        yc, yl = token_mixer(adaln_in(hc, pre_norm[l, 1], modc[3], modc[4]),
                             adaln_in(h, pre_norm[l, 1], mod[3], mod[4]),
                             w_in[l], diff_lambda[l], diff_norm[l], na_rpb[l], ret_decay[l], ret_norm[l],
                             w_branch[l], w_out[l], lambda_init, with_ctx_out)
        h = h + mod[5] * rmsnorm(yl, post_norm[l, 1])
        h = half_ffn_sublayer(h, pre_norm[l, 2], post_norm[l, 2], mod[6], mod[7], mod[8],
                              ffn_w_in[l, 1], ffn_w_out[l, 1])
        if with_ctx_out:
            hc = hc + modc[5] * rmsnorm(yc, post_norm[l, 1])
            hc = half_ffn_sublayer(hc, pre_norm[l, 2], post_norm[l, 2], modc[6], modc[7], modc[8],
                                   ffn_w_in[l, 1], ffn_w_out[l, 1])
    return h
```

```cpp
#include <hip/hip_runtime.h>
#include <cstdio>
#include <cstdint>
#include <type_traits>
namespace pg8 {
#define PG8_LAS __attribute__((address_space(3)))
typedef unsigned short bf16_t;
typedef short bf16x8 __attribute__((ext_vector_type(8)));
typedef float f32x4 __attribute__((ext_vector_type(4)));
typedef unsigned u32x4 __attribute__((ext_vector_type(4)));
constexpr int BM = 256, BK = 64, HALF = 128, HTB = HALF * BK * 2  , STAGE_BYTES = 8 * HTB, NXCD = 8, WGM = 4;

__host__ __device__ __forceinline__ int lds_byte(int r, int c) { const int st = (r >> 4) * 2 + (c >> 5), rr = r & 15, cc = c & 31, ob = rr * 64 + cc * 2; return st * 1024 + (ob ^ (((ob >> 9) & 1) << 5)); }
__host__ __device__ __forceinline__ void stage_rc(int b, int& R, int& C) { const int st = b / 1024, sb = b % 1024, swz = sb ^ (((sb >> 9) & 1) << 5); R = (st >> 1) * 16 + swz / 64; C = (st & 1) * 32 + (swz % 64) / 2; }
__host__ __device__ __forceinline__ int perm32(int rho) { const int n = rho >> 4, i = rho & 15; return 8 * (i >> 2) + 4 * n + (i & 3); }

struct Unit { int pm, pn, z, kt; };
struct Gemm { const bf16_t* A; const bf16_t* Bt; int M, N, K, ld; size_t zA, zB; };

struct PanelOrder {
    int nM, nN, nwg, G, c, lat, zn;
    __host__ __device__ void init(int nM_, int N, int G_, int c_, int lat_, int zn_ = 1) { nM = nM_; nN = N / BM; nwg = nM * nN; G = G_; c = c_; lat = lat_; zn = zn_; }
    __host__ __device__ bool next(int i, Unit& u) const {
        const int ti = i / zn; u.z = i - ti * zn; u.kt = 0;
        const long L = (long)ti * G + c; if (L >= nwg) return false;
        int wgid = (int)L; { const int q = nwg / NXCD, r = nwg % NXCD, xcd = wgid % NXCD, off = wgid / NXCD; wgid = (xcd < r ? xcd * (q + 1) : r * (q + 1) + (xcd - r) * q) + off; }
        const int nig = WGM * nN, gid = wgid / nig, fm = gid * WGM, gsz = (nM - fm) < WGM ? (nM - fm) : WGM;
        const int pm = fm + ((wgid % nig) % gsz); u.pn = (wgid % nig) / gsz; u.pm = lat ? pm + pm / 8 + 1 : pm; return true;
    }
    __device__ __forceinline__ void a_ready(const Unit&) const {}
    __device__ __forceinline__ void done(const Unit&) const {}
};
struct CtxSplitOrder {
    int nN, G, c;
    __host__ __device__ void init(int N, int G_, int c_) { nN = N / BM; G = G_; c = c_; }
    __host__ __device__ bool next(int i, Unit& u) const {
        const long L = (long)i * G + c; if (L >= 8 * nN * 4) return false;
        const int t = (int)(L >> 2); u.z = (int)(L & 3); u.kt = 0; u.pm = 9 * (t / nN); u.pn = t % nN; return true;
    }
    __device__ __forceinline__ void a_ready(const Unit&) const {}
    __device__ __forceinline__ void done(const Unit&) const {}
};
struct CtxColsOrder {
    int G, c;
    __host__ __device__ void init(int G_, int c_) { G = G_; c = c_; }
    __host__ __device__ bool next(int i, Unit& u) const {
        const long L = (long)i * G + c; if (L >= 8 * 22) return false;
        const int p = (int)L / 22, k = (int)L % 22; u.z = 0; u.kt = 0; u.pm = 9 * p; u.pn = k < 8 ? 4 + k : k < 16 ? 8 + k : 10 + k; return true;
    }
    __device__ __forceinline__ void a_ready(const Unit&) const {}
    __device__ __forceinline__ void done(const Unit&) const {}
};
struct LatCtxOrder {
    PanelOrder lat; int G, c, ktq;
    __host__ __device__ void init(int G_, int c_, int ktq_) { lat.init(64, 2048, G_, c_, 1, 1); G = G_; c = c_; ktq = ktq_; }
    __host__ __device__ bool next(int i, Unit& u) const {
        if (i == 0) { const int q = c, t = q >> 2; u.z = q & 3; u.kt = ktq; u.pm = 9 * (t >> 3); u.pn = t & 7; return q < 256; }
        return lat.next(i - 1, u);
    }
    __device__ __forceinline__ void a_ready(const Unit&) const {}
    __device__ __forceinline__ void done(const Unit&) const {}
};

template <class Epi, class Sched, bool ALIGN_EPI = false, bool SP2 = false>
__device__ __forceinline__ void gemm_phase(PG8_LAS unsigned char* lds, const Gemm g, const Sched& S, const Epi& E) {
    int tid_l = threadIdx.x; asm volatile("" : "+v"(tid_l));
    const int tid = tid_l, wid = __builtin_amdgcn_readfirstlane(tid >> 6), lane = tid & 63, wr = wid >> 2, wc = wid & 3, fr = lane & 15, fq = lane >> 4;
    const int K = g.K, nt = K / BK, LD = g.ld;
    unsigned voffA[2], voffB[2];
#pragma unroll
    for (int i = 0; i < 2; ++i) { int R, C; stage_rc(tid * 16 + i * 8192, R, C); const int Rb = Epi::PERM ? ((R & ~31) + perm32(R & 31)) : R;
        voffA[i] = (unsigned)(R * LD + C) * 2u; voffB[i] = (unsigned)(Rb * LD + C) * 2u; }
    const size_t kstep = (size_t)(BK * 2);
    const size_t hstep = (size_t)HALF * LD * 2;
    const size_t tstep = 2 * hstep;
    const unsigned ldsbase = (unsigned)__builtin_amdgcn_readfirstlane((int)((unsigned)(unsigned long)lds + (unsigned)wid * 1024u));
    const unsigned ldsw = (unsigned)wid * 1024u;
    const int aoff = lds_byte(wr * 64 + fr, fq * 8), boff = lds_byte(wc * 32 + fr, fq * 8);
#define PG8_SA(b, h) (((b) * 2 + (h)) * HTB)
#define PG8_SB(b, h) ((4 + (b) * 2 + (h)) * HTB)
#define PG8_STAGE(bufoff, gbase, voff) do { _Pragma("unroll") for (int _i = 0; _i < 2; ++_i) \
        asm volatile("s_mov_b32 m0, %2\n\ts_nop 0\n\tglobal_load_lds_dwordx4 %0, %1" :: "v"((voff)[_i]), "s"((const char*)(gbase)), "s"(ldsbase + (unsigned)((bufoff) + _i * 8192)) : "memory", "m0"); } while (0)
#define PG8_LDA(dst, b, h) do { _Pragma("unroll") for (int m = 0; m < 4; ++m) _Pragma("unroll") for (int k = 0; k < 2; ++k) dst[m][k] = *(const PG8_LAS bf16x8*)(lds + PG8_SA(b, h) + aoff + m * 2048 + k * 1024); } while (0)
#define PG8_LDB(dst, b, h) do { _Pragma("unroll") for (int n = 0; n < 2; ++n) _Pragma("unroll") for (int k = 0; k < 2; ++k) dst[n][k] = *(const PG8_LAS bf16x8*)(lds + PG8_SB(b, h) + boff + n * 2048 + k * 1024); } while (0)
#define PG8_MMA(ai, bj, At, Bt) do { __builtin_amdgcn_s_setprio(1); _Pragma("unroll") for (int m = 0; m < 4; ++m) _Pragma("unroll") for (int n = 0; n < 2; ++n) _Pragma("unroll") for (int k = 0; k < 2; ++k) \
        acc[ai][bj][m][n] = __builtin_amdgcn_mfma_f32_16x16x32_bf16(Bt[n][k], At[m][k], acc[ai][bj][m][n], 0, 0, 0); __builtin_amdgcn_s_setprio(0); } while (0)
#define PG8_WAIT_V(n) asm volatile("s_waitcnt vmcnt(" #n ")" ::: "memory")
#define PG8_WAIT_L(n) do { __builtin_amdgcn_s_waitcnt(0xC07F | ((n) << 8)); asm volatile("" ::: "memory"); } while (0)
#define PG8_WAIT_VL8 do { __builtin_amdgcn_s_waitcnt(0x0078); asm volatile("" ::: "memory"); } while (0)
#define PG8_BAR __builtin_amdgcn_s_barrier()
#define PG8_SCHED __builtin_amdgcn_sched_barrier(0)
    Unit cur, nxt; int ui = 0;
    if (!S.next(0, cur)) return;
    f32x4 acc[2][2][4][2];
#pragma unroll
    for (int a = 0; a < 2; ++a)
#pragma unroll
        for (int b = 0; b < 2; ++b)
#pragma unroll
            for (int m = 0; m < 4; ++m)
#pragma unroll
                for (int n = 0; n < 2; ++n) acc[a][b][m][n] = (f32x4){0.f, 0.f, 0.f, 0.f};
    bf16x8 At[4][2], B0[2][2], B1[2][2];
    const char* cA = (const char*)g.A + (size_t)cur.z * g.zA + (size_t)cur.pm * tstep; const char* cB = (const char*)g.Bt + (size_t)cur.z * g.zB + (size_t)cur.pn * tstep;
    S.a_ready(cur);
    if constexpr (SP2) {
        PG8_STAGE(PG8_SB(0, 0), cB, voffB); PG8_STAGE(PG8_SB(0, 1), cB + hstep, voffB); PG8_STAGE(PG8_SA(0, 0), cA, voffA); PG8_STAGE(PG8_SA(0, 1), cA + hstep, voffA);
        if (wr == 1) PG8_BAR;
        PG8_WAIT_V(2); PG8_BAR;
        PG8_STAGE(PG8_SB(1, 0), cB + kstep, voffB); PG8_STAGE(PG8_SA(1, 0), cA + kstep, voffA); PG8_STAGE(PG8_SB(1, 1), cB + hstep + kstep, voffB);
        PG8_WAIT_V(6); PG8_BAR;
    } else {
        PG8_STAGE(PG8_SB(0, 0), cB, voffB); PG8_STAGE(PG8_SA(0, 0), cA, voffA); PG8_STAGE(PG8_SB(0, 1), cB + hstep, voffB); PG8_STAGE(PG8_SA(0, 1), cA + hstep, voffA);
        if (wr == 1) PG8_BAR;
        PG8_WAIT_V(4); PG8_BAR;
        PG8_STAGE(PG8_SB(1, 0), cB + kstep, voffB); PG8_STAGE(PG8_SA(1, 0), cA + kstep, voffA); PG8_STAGE(PG8_SB(1, 1), cB + hstep + kstep, voffB);
        PG8_WAIT_V(6); PG8_BAR;
    }
    for (;;) {
        const bool has_next = S.next(ui + 1, nxt);
        const char* nA = has_next ? (const char*)g.A + (size_t)nxt.z * g.zA + (size_t)nxt.pm * tstep : cA; const char* nB = has_next ? (const char*)g.Bt + (size_t)nxt.z * g.zB + (size_t)nxt.pn * tstep : cB;
        const int ntu = cur.kt ? cur.kt : nt;
        for (int t = 0; t < ntu; t += 2) {
            const bool last = (t == ntu - 2);
            const char* a1 = cA + (size_t)(t + 1) * kstep;
            const char* a2 = last ? nA : cA + (size_t)(t + 2) * kstep; const char* b2 = last ? nB : cB + (size_t)(t + 2) * kstep;
            const char* a3 = a2 + kstep; const char* b3 = b2 + kstep;
            if (last && has_next) S.a_ready(nxt);
            if constexpr (SP2) {
            PG8_LDB(B0, 0, 0); PG8_LDB(B1, 0, 1); PG8_SCHED; PG8_LDA(At, 0, 0); PG8_STAGE(PG8_SA(1, 1), a1 + hstep, voffA);
            PG8_WAIT_VL8; PG8_BAR; PG8_MMA(0, 0, At, B0); PG8_MMA(0, 1, At, B1); PG8_BAR; PG8_SCHED;
            PG8_LDA(At, 0, 1); PG8_STAGE(PG8_SB(0, 0), b2, voffB); PG8_STAGE(PG8_SB(0, 1), b2 + hstep, voffB); PG8_STAGE(PG8_SA(0, 0), a2, voffA);
            PG8_WAIT_VL8; PG8_BAR; PG8_MMA(1, 0, At, B0); PG8_MMA(1, 1, At, B1); PG8_BAR; PG8_SCHED;
            PG8_LDB(B0, 1, 0); PG8_LDB(B1, 1, 1); PG8_SCHED; PG8_LDA(At, 1, 0); PG8_STAGE(PG8_SA(0, 1), a2 + hstep, voffA);
            PG8_WAIT_VL8; PG8_BAR; PG8_MMA(0, 0, At, B0); PG8_MMA(0, 1, At, B1); PG8_BAR; PG8_SCHED;
            PG8_LDA(At, 1, 1); PG8_STAGE(PG8_SB(1, 0), b3, voffB); PG8_STAGE(PG8_SB(1, 1), b3 + hstep, voffB); PG8_STAGE(PG8_SA(1, 0), a3, voffA);
            PG8_WAIT_VL8; PG8_BAR; PG8_MMA(1, 0, At, B0); PG8_MMA(1, 1, At, B1); PG8_BAR; PG8_SCHED;
            } else {
            PG8_LDB(B0, 0, 0); PG8_SCHED; PG8_LDA(At, 0, 0); PG8_STAGE(PG8_SA(1, 1), a1 + hstep, voffA);
            PG8_WAIT_L(8); PG8_BAR; PG8_WAIT_L(0); PG8_MMA(0, 0, At, B0); PG8_BAR; PG8_SCHED;
            PG8_LDB(B1, 0, 1); PG8_STAGE(PG8_SB(0, 0), b2, voffB);
            PG8_BAR; PG8_WAIT_L(0); PG8_MMA(0, 1, At, B1); PG8_BAR;
            PG8_LDA(At, 0, 1); PG8_STAGE(PG8_SA(0, 0), a2, voffA);
            PG8_BAR; PG8_WAIT_L(0); PG8_MMA(1, 0, At, B0); PG8_BAR; PG8_SCHED;
            PG8_STAGE(PG8_SB(0, 1), b2 + hstep, voffB);
            PG8_WAIT_V(6); PG8_BAR; PG8_MMA(1, 1, At, B1); PG8_BAR;
            PG8_LDB(B0, 1, 0); PG8_SCHED; PG8_LDA(At, 1, 0); PG8_STAGE(PG8_SA(0, 1), a2 + hstep, voffA);
            PG8_WAIT_L(8); PG8_BAR; PG8_WAIT_L(0); PG8_MMA(0, 0, At, B0); PG8_BAR; PG8_SCHED;
            PG8_LDB(B1, 1, 1); PG8_STAGE(PG8_SB(1, 0), b3, voffB);
            PG8_BAR; PG8_WAIT_L(0); PG8_MMA(0, 1, At, B1); PG8_BAR;
            PG8_LDA(At, 1, 1); PG8_STAGE(PG8_SA(1, 0), a3, voffA);
            PG8_BAR; PG8_WAIT_L(0); PG8_MMA(1, 0, At, B0); PG8_BAR; PG8_SCHED;
            PG8_STAGE(PG8_SB(1, 1), b3 + hstep, voffB);
            PG8_WAIT_V(6); PG8_BAR; PG8_MMA(1, 1, At, B1); PG8_BAR;
            }
        }
        if constexpr (ALIGN_EPI) { if (wr == 0) PG8_BAR; }
        if constexpr (!Epi::AFTER_DRAIN) { E(acc, cur, wr, wc, fr, fq); S.done(cur); }
        if (!has_next) break;
        if (!Epi::KEEP_ACC || nxt.z == 0) {
#pragma unroll
        for (int a = 0; a < 2; ++a)
#pragma unroll
            for (int b = 0; b < 2; ++b)
#pragma unroll
                for (int m = 0; m < 4; ++m)
#pragma unroll
                    for (int n = 0; n < 2; ++n) acc[a][b][m][n] = (f32x4){0.f, 0.f, 0.f, 0.f};
        }
        cur = nxt; cA = nA; cB = nB; ++ui;
        if constexpr (ALIGN_EPI) { if (wr == 1) PG8_BAR; }
    }
    PG8_WAIT_V(0);
    if constexpr (!ALIGN_EPI) { if (wr == 0) PG8_BAR; }
    PG8_BAR;
    if constexpr (Epi::AFTER_DRAIN) { E.fused(acc, cur, wr, wc, fr, fq, lds, wid, lane); S.done(cur); }
#undef PG8_SA
#undef PG8_SB
#undef PG8_STAGE
#undef PG8_LDA
#undef PG8_LDB
#undef PG8_MMA
#undef PG8_WAIT_V
#undef PG8_WAIT_L
#undef PG8_BAR
#undef PG8_SCHED
}
}


constexpr int DM = 2048, NBATCH = 8, SEQ = 2048, CTXL = 256, SB = SEQ + CTXL  , R = NBATCH * SB  ;
constexpr int FFN = 5632, INC = 15360, NPAN = R / 256  ;
constexpr int C_AQ = 0, C_AK = 1024, C_AV = 2048, C_BQ = 3072, C_BK = 4096, C_BV = 5120, C_CQ = 6144, C_CK = 6656, C_CV = 7168, C_CG = 8192, C_GATE = 9216;
constexpr float EPS = 1e-6f, LOG2E = 1.4426950408889634f;
constexpr float SCALE_A = 0.125f * LOG2E, SCALE_B = 0.08838834764831845f * LOG2E, SCALE_CK = 0.125f;

#define GAS __attribute__((address_space(1)))
#define LAS __attribute__((address_space(3)))
typedef unsigned short bf16;
typedef unsigned v4u __attribute__((ext_vector_type(4)));
typedef unsigned v2u __attribute__((ext_vector_type(2)));
typedef float f32x4 __attribute__((ext_vector_type(4)));
typedef float f32x2 __attribute__((ext_vector_type(2)));
#define LDS_WAIT() asm volatile("s_waitcnt lgkmcnt(0)" ::: "memory")
#define VM_WAIT() asm volatile("s_waitcnt vmcnt(0)" ::: "memory")
__device__ __forceinline__ unsigned cvt_pk_bf16(float lo, float hi) { unsigned r; asm volatile("v_cvt_pk_bf16_f32 %0, %1, %2" : "=v"(r) : "v"(lo), "v"(hi)); return r; }
__device__ __forceinline__ float bflo(unsigned w) { return __uint_as_float(w << 16); }
__device__ __forceinline__ float bfhi(unsigned w) { return __uint_as_float(w & 0xffff0000u); }
__device__ __forceinline__ float bf1(bf16 w) { return __uint_as_float(((unsigned)w) << 16); }
__device__ __forceinline__ float sigm_f(float x) { return __builtin_amdgcn_rcpf(1.0f + __builtin_amdgcn_exp2f(-LOG2E * x)); }
__device__ __forceinline__ float silu_f(float x) { return x * sigm_f(x); }
__device__ __forceinline__ f32x4 swiglu4(f32x4 a, f32x4 b) {
    f32x4 e;
    e[0] = __builtin_amdgcn_exp2f(a[0]); e[1] = __builtin_amdgcn_exp2f(a[1]); e[2] = __builtin_amdgcn_exp2f(a[2]); e[3] = __builtin_amdgcn_exp2f(a[3]);
    e = e + 1.0f; f32x4 r;
    r[0] = __builtin_amdgcn_rcpf(e[0]); r[1] = __builtin_amdgcn_rcpf(e[1]); r[2] = __builtin_amdgcn_rcpf(e[2]); r[3] = __builtin_amdgcn_rcpf(e[3]);
    return (a * b) * r;
}
template <int M> __device__ __forceinline__ float swz_xor(float v) { return __builtin_bit_cast(float, __builtin_amdgcn_ds_swizzle(__builtin_bit_cast(int, v), 0x1f | (M << 10))); }
__device__ __forceinline__ float wave_sum(float v) {
    v += swz_xor<1>(v); v += swz_xor<2>(v); v += swz_xor<4>(v); v += swz_xor<8>(v); v += swz_xor<16>(v);
    auto rr = __builtin_amdgcn_permlane32_swap(__float_as_uint(v), __float_as_uint(v), false, false); return __uint_as_float(rr[0]) + __uint_as_float(rr[1]);
}
__device__ __forceinline__ float wave_max(float v) {
    v = fmaxf(v, swz_xor<1>(v)); v = fmaxf(v, swz_xor<2>(v)); v = fmaxf(v, swz_xor<4>(v)); v = fmaxf(v, swz_xor<8>(v)); v = fmaxf(v, swz_xor<16>(v));
    auto rr = __builtin_amdgcn_permlane32_swap(__float_as_uint(v), __float_as_uint(v), false, false); return fmaxf(__uint_as_float(rr[0]), __uint_as_float(rr[1]));
}
__device__ __forceinline__ float other_half(float v, bool lower) { auto rr = __builtin_amdgcn_permlane32_swap(__float_as_uint(v), __float_as_uint(v), false, false); return __uint_as_float(lower ? rr[1] : rr[0]); }

namespace ep {
using pg8::Unit; using pg8::BM; using pg8::HALF;
struct EpiF32 {
    static constexpr bool PERM = false, AFTER_DRAIN = false, KEEP_ACC = false;
    float* C; int ldc;
    __device__ __forceinline__ void operator()(const f32x4 (&acc)[2][2][4][2], const Unit& u, int wr, int wc, int fr, int fq) const {
        const int row0 = u.pm * BM + wr * 64 + fr, col0 = u.pn * BM + wc * 32 + 4 * fq;
#pragma unroll
        for (int ai = 0; ai < 2; ++ai)
#pragma unroll
            for (int m = 0; m < 4; ++m) { float* rowp = C + (size_t)(row0 + ai * HALF + m * 16) * ldc + col0;
#pragma unroll
                for (int bj = 0; bj < 2; ++bj)
#pragma unroll
                    for (int n = 0; n < 2; ++n) *(f32x4*)(rowp + bj * HALF + n * 16) = acc[ai][bj][m][n]; }
    }
};
struct EpiSwiGLU {
    static constexpr bool PERM = true, AFTER_DRAIN = false, KEEP_ACC = false;
    bf16* O;
    __device__ __forceinline__ void operator()(const f32x4 (&acc)[2][2][4][2], const Unit& u, int wr, int wc, int fr, int fq) const {
        const int row0 = u.pm * BM + wr * 64 + fr, col0 = u.pn * 128 + wc * 32 + 8 * fq;
#pragma unroll
        for (int ai = 0; ai < 2; ++ai)
#pragma unroll
            for (int m = 0; m < 4; ++m) { bf16* rowp = O + (size_t)(row0 + ai * HALF + m * 16) * FFN + col0;
                const f32x4 a0 = acc[ai][0][m][0], a1 = acc[ai][0][m][1], b0 = acc[ai][1][m][0], b1 = acc[ai][1][m][1];
                const f32x4 r0 = swiglu4(a0, b0), r1 = swiglu4(a1, b1);
                v4u w; w.x = cvt_pk_bf16(r0[0], r0[1]); w.y = cvt_pk_bf16(r0[2], r0[3]); w.z = cvt_pk_bf16(r1[0], r1[1]); w.w = cvt_pk_bf16(r1[2], r1[3]);
                *(v4u*)rowp = w; }
    }
};
struct EpiInProj {
    static constexpr bool PERM = true, AFTER_DRAIN = false, KEEP_ACC = false;
    bf16* O; const LAS f32x2* tab;
    __device__ __forceinline__ void operator()(const f32x4 (&acc)[2][2][4][2], const Unit& u, int wr, int wc, int fr, int fq) const {
        const int pj = u.pm % 9;
        const bool rope = ((u.pn < 8) || (u.pn >= 24 && u.pn < 28)) && (pj != 0);
        const bool gate = u.pn >= C_GATE / 256;
        const int row0 = u.pm * BM + wr * 64 + fr, col0 = u.pn * BM + wc * 32 + 8 * fq;
        const int t0 = (pj - 1) * 256 + wr * 64 + fr;
#pragma unroll
        for (int ai = 0; ai < 2; ++ai)
#pragma unroll
            for (int m = 0; m < 4; ++m) { bf16* rowp = O + (size_t)(row0 + ai * HALF + m * 16) * INC + col0;
                f32x2 cs[8];
                if (rope) { const int t = t0 + ai * HALF + m * 16, pos = (wc & 1) ? (t & 63) : (t >> 6); const LAS f32x4* tp = (const LAS f32x4*)(tab + pos * 16 + 8 * (fq & 1));
#pragma unroll
                    for (int q = 0; q < 4; ++q) { const f32x4 v = tp[q]; cs[2 * q] = (f32x2){v[0], v[1]}; cs[2 * q + 1] = (f32x2){v[2], v[3]}; } }
#pragma unroll
                for (int bj = 0; bj < 2; ++bj) { float v[8];
#pragma unroll
                    for (int j = 0; j < 4; ++j) { v[j] = acc[ai][bj][m][0][j]; v[4 + j] = acc[ai][bj][m][1][j]; }
                    if (rope) {
#pragma unroll
                        for (int j = 0; j < 8; ++j) { const float p = other_half(v[j], fq < 2); v[j] = (fq < 2) ? (v[j] * cs[j].x - p * cs[j].y) : (p * cs[j].y + v[j] * cs[j].x); } }
                    if (gate) {
#pragma unroll
                        for (int j = 0; j < 8; ++j) v[j] = 1.0f + __builtin_amdgcn_exp2f(-LOG2E * fminf(fmaxf(v[j], -60.f), 60.f)); }
                    v4u w; w.x = cvt_pk_bf16(v[0], v[1]); w.y = cvt_pk_bf16(v[2], v[3]); w.z = cvt_pk_bf16(v[4], v[5]); w.w = cvt_pk_bf16(v[6], v[7]);
                    *(v4u*)(rowp + bj * HALF) = w; } }
    }
};
struct EpiBf16 {
    static constexpr bool PERM = true, AFTER_DRAIN = false, KEEP_ACC = false;
    bf16* O; int ldc;
    __device__ __forceinline__ void operator()(const f32x4 (&acc)[2][2][4][2], const Unit& u, int wr, int wc, int fr, int fq) const {
        const int row0 = u.pm * BM + wr * 64 + fr, col0 = u.pn * BM + wc * 32 + 8 * fq;
#pragma unroll
        for (int ai = 0; ai < 2; ++ai)
#pragma unroll
            for (int m = 0; m < 4; ++m) { bf16* rowp = O + (size_t)(row0 + ai * HALF + m * 16) * ldc + col0;
#pragma unroll
                for (int bj = 0; bj < 2; ++bj) { const f32x4 v0 = acc[ai][bj][m][0], v1 = acc[ai][bj][m][1];
                    v4u w; w.x = cvt_pk_bf16(v0[0], v0[1]); w.y = cvt_pk_bf16(v0[2], v0[3]); w.z = cvt_pk_bf16(v1[0], v1[1]); w.w = cvt_pk_bf16(v1[2], v1[3]);
                    *(v4u*)(rowp + bj * HALF) = w; } }
    }
};
struct EpiMerge {
    static constexpr bool PERM = true, AFTER_DRAIN = false, KEEP_ACC = true;
    const bf16* G; bf16* MERGED;
    static __device__ __forceinline__ float e1(float x) { return 1.0f + __builtin_amdgcn_exp2f(-LOG2E * fminf(fmaxf(x, -60.f), 60.f)); }
    __device__ __forceinline__ void operator()(f32x4 (&acc)[2][2][4][2], const Unit& u, int wr, int wc, int fr, int fq) const {
        const int row0 = u.pm * BM + wr * 64 + fr, col0 = u.pn * BM + wc * 32 + 8 * fq, z = u.z;
        const bf16* Ga = G + z * DM + col0; const bf16* Gb = Ga + DM; bf16* Oz = MERGED + col0;
        v4u ga[2][2], gb[2][2];
#define MRG_ROW(b) ((size_t)(row0 + ((b) >> 2) * HALF + ((b) & 3) * 16))
#define MRG_LOAD(b, s) do { _Pragma("unroll") for (int bj = 0; bj < 2; ++bj) { ga[s][bj] = *(const v4u*)(Ga + MRG_ROW(b) * INC + bj * HALF); \
            if (z != 2) gb[s][bj] = *(const v4u*)(Gb + MRG_ROW(b) * INC + bj * HALF); } } while (0)
        MRG_LOAD(0, 0);
#pragma unroll
        for (int b = 0; b < 8; ++b) { const int cur = b & 1, ai = b >> 2, m = b & 3;
            if (b + 1 < 8) MRG_LOAD(b + 1, cur ^ 1);
#pragma unroll
            for (int bj = 0; bj < 2; ++bj) { const v4u A = ga[cur][bj];
                float f[8] = {bflo(A.x), bfhi(A.x), bflo(A.y), bfhi(A.y), bflo(A.z), bfhi(A.z), bflo(A.w), bfhi(A.w)};
#pragma unroll
                for (int j = 0; j < 8; ++j) f[j] = __builtin_amdgcn_rcpf(f[j]);
                if (z != 2) { const v4u B = gb[cur][bj];
                    f[0] *= bflo(B.x); f[1] *= bfhi(B.x); f[2] *= bflo(B.y); f[3] *= bfhi(B.y); f[4] *= bflo(B.z); f[5] *= bfhi(B.z); f[6] *= bflo(B.w); f[7] *= bfhi(B.w); }
                f32x4 v0 = acc[ai][bj][m][0], v1 = acc[ai][bj][m][1];
                v0[0] *= f[0]; v0[1] *= f[1]; v0[2] *= f[2]; v0[3] *= f[3]; v1[0] *= f[4]; v1[1] *= f[5]; v1[2] *= f[6]; v1[3] *= f[7];
                if (z != 2) { acc[ai][bj][m][0] = v0; acc[ai][bj][m][1] = v1; }
                else { v4u w; w.x = cvt_pk_bf16(v0[0], v0[1]); w.y = cvt_pk_bf16(v0[2], v0[3]); w.z = cvt_pk_bf16(v1[0], v1[1]); w.w = cvt_pk_bf16(v1[2], v1[3]);
                    *(v4u*)(Oz + MRG_ROW(b) * DM + bj * HALF) = w; } } }
#undef MRG_ROW
#undef MRG_LOAD
    }
};
struct EpiF32Part {
    static constexpr bool PERM = false, AFTER_DRAIN = false, KEEP_ACC = false;
    float* YP;
    __device__ __forceinline__ void operator()(const f32x4 (&acc)[2][2][4][2], const Unit& u, int wr, int wc, int fr, int fq) const {
        const int row0 = (u.pm / 9) * BM + wr * 64 + fr, col0 = u.pn * BM + wc * 32 + 4 * fq;
        float* base = YP + (size_t)u.z * ((size_t)NBATCH * CTXL * DM);
#pragma unroll
        for (int ai = 0; ai < 2; ++ai)
#pragma unroll
            for (int m = 0; m < 4; ++m) { float* rowp = base + (size_t)(row0 + ai * HALF + m * 16) * DM + col0;
#pragma unroll
                for (int bj = 0; bj < 2; ++bj)
#pragma unroll
                    for (int n = 0; n < 2; ++n) *(f32x4*)(rowp + bj * HALF + n * 16) = acc[ai][bj][m][n]; }
    }
};
struct EpiNull {
    static constexpr bool PERM = true, AFTER_DRAIN = false, KEEP_ACC = false;
    bf16* O;
    __device__ __forceinline__ void operator()(const f32x4 (&acc)[2][2][4][2], const Unit& u, int wr, int wc, int fr, int fq) const {
        float s = 0.f;
#pragma unroll
        for (int ai = 0; ai < 2; ++ai)
#pragma unroll
            for (int bj = 0; bj < 2; ++bj)
#pragma unroll
                for (int m = 0; m < 4; ++m)
#pragma unroll
                    for (int n = 0; n < 2; ++n) s += acc[ai][bj][m][n][0] + acc[ai][bj][m][n][1] + acc[ai][bj][m][n][2] + acc[ai][bj][m][n][3];
        if (s == 1234.56789f) O[u.pm * 4096 + u.pn + wr + wc + fr + fq] = 1;
    }
};
struct EpiYMix {
    static constexpr bool PERM = true, AFTER_DRAIN = false, KEEP_ACC = false;
    bf16* O; bf16* YP;
    __device__ __forceinline__ void operator()(const f32x4 (&acc)[2][2][4][2], const Unit& u, int wr, int wc, int fr, int fq) const {
        const int col0 = u.pn * BM + wc * 32 + 8 * fq;
        if (u.kt == 0) { const int row0 = u.pm * BM + wr * 64 + fr;
#pragma unroll
            for (int ai = 0; ai < 2; ++ai)
#pragma unroll
                for (int m = 0; m < 4; ++m) { bf16* rowp = O + (size_t)(row0 + ai * HALF + m * 16) * DM + col0;
#pragma unroll
                    for (int bj = 0; bj < 2; ++bj) { const f32x4 v0 = acc[ai][bj][m][0], v1 = acc[ai][bj][m][1];
                        v4u w; w.x = cvt_pk_bf16(v0[0], v0[1]); w.y = cvt_pk_bf16(v0[2], v0[3]); w.z = cvt_pk_bf16(v1[0], v1[1]); w.w = cvt_pk_bf16(v1[2], v1[3]);
                        *(v4u*)(rowp + bj * HALF) = w; } } }
        else { const int row0 = (u.pm / 9) * BM + wr * 64 + fr; bf16* base = YP + (size_t)u.z * ((size_t)NBATCH * CTXL * DM);
#pragma unroll
            for (int ai = 0; ai < 2; ++ai)
#pragma unroll
                for (int m = 0; m < 4; ++m) { bf16* rowp = base + (size_t)(row0 + ai * HALF + m * 16) * DM + col0;
#pragma unroll
                    for (int bj = 0; bj < 2; ++bj) { const f32x4 v0 = acc[ai][bj][m][0], v1 = acc[ai][bj][m][1];
                        v4u w; w.x = cvt_pk_bf16(v0[0], v0[1]); w.y = cvt_pk_bf16(v0[2], v0[3]); w.z = cvt_pk_bf16(v1[0], v1[1]); w.w = cvt_pk_bf16(v1[2], v1[3]);
                        *(v4u*)(rowp + bj * HALF) = w; } } }
    }
};
}

constexpr size_t MiB = 1u << 20;
constexpr size_t WS_CTL = 0, CTL_ZERO_BYTES = 1 * MiB;
constexpr size_t WS_MOD = 1 * MiB;
constexpr size_t WS_TAB = 3 * MiB;
constexpr size_t WS_HC = 4 * MiB;
constexpr size_t WS_U = 20 * MiB;
constexpr size_t WS_OA = 92 * MiB, WS_OB = 128 * MiB, WS_YR = 164 * MiB;
constexpr size_t WS_MACC = 200 * MiB;
constexpr size_t WS_WT = 344 * MiB;
constexpr size_t WT_W1A = 0, WT_W1B = 44 * MiB, WT_W2A = 88 * MiB, WT_W2B = 110 * MiB, WT_IN = 132 * MiB, WT_WB = 192 * MiB, WT_WO = 204 * MiB, WT_BYTES = 212 * MiB;
constexpr size_t WS_R1 = 556 * MiB;
constexpr size_t R1_ACT = 0, R1_Y = 198 * MiB;
constexpr size_t WS_WT1 = 1096 * MiB;
constexpr size_t WS_END = 1308 * MiB;
static_assert((size_t)R * DM * 2 == 72 * MiB && (size_t)R * 1024 * 2 == 36 * MiB && (size_t)R * DM * 4 == 144 * MiB && (size_t)R * INC * 2 == 540 * MiB && (size_t)R * FFN * 2 == 198 * MiB, "sizes");
static_assert((size_t)2 * FFN * DM * 2 == 44 * MiB && (size_t)INC * DM * 2 == 60 * MiB && (size_t)3 * DM * 1024 * 2 == 12 * MiB, "weight sizes");
constexpr int CW_TMO = 0, CW_BAR = 4096;

constexpr int RING_BYTES = 135168;
constexpr int LDSCTL_OFF = RING_BYTES, MISC_OFF = LDSCTL_OFF + 320, LTAB_OFF = LDSCTL_OFF + 1024;
constexpr int LDS_BYTES = 147456;
static_assert(LTAB_OFF + 8192 <= LDS_BYTES && LDS_BYTES <= 163840, "LDS map");
constexpr int NWAVES = 8, GRID = 256;
#ifndef BSD
#define BSD 1
#endif

#define XB_TMO      128
#define XB_XCNT(j)  (256  + 64 * (j))
#define XB_XSUB(j)  (1280 + 64 * (j))
#define XB_XGEN(j)  (2304 + 64 * (j))
#define XB_TOP      3328
#define XB_TOPGEN   3392
#define XCD_BAR_WORDS 3456
#define XB_SPIN_CAP (1u << 21)

__device__ __forceinline__ unsigned xb_ld(unsigned* p)              { return __hip_atomic_load(p, __ATOMIC_RELAXED, __HIP_MEMORY_SCOPE_AGENT); }
__device__ __forceinline__ unsigned xb_add(unsigned* p, unsigned v) { return __hip_atomic_fetch_add(p, v, __ATOMIC_RELAXED, __HIP_MEMORY_SCOPE_AGENT); }
__device__ __forceinline__ unsigned xb_xcc_id() { return (unsigned)__builtin_amdgcn_s_getreg((3 << 11) | 20) & 0xFu; }
#define XB_SPIN(cond, bar) do { unsigned _sp = 0; while (cond) { __builtin_amdgcn_s_sleep(1); \
    if ((++_sp & 255u) == 0u) { if (xb_ld(&(bar)[XB_TMO])) break; if (_sp > XB_SPIN_CAP) { atomicAdd(&(bar)[XB_TMO], 1u); break; } } } } while (0)

struct XcdBarrier {
    unsigned* bar; unsigned x;
    volatile LAS unsigned* st;
};

__device__ __forceinline__ XcdBarrier xcd_barrier_post(unsigned* bar, volatile LAS unsigned* st) {
    XcdBarrier b; b.bar = bar; b.x = xb_xcc_id(); b.st = st;
    if (threadIdx.x == 0) (void)xb_add(&bar[XB_XCNT(b.x)], 1u);
    return b;
}
__device__ __forceinline__ void xcd_barrier_complete(unsigned* bar, unsigned x, unsigned& nloc, unsigned& nx) {
    const unsigned G = gridDim.x * gridDim.y * gridDim.z;
    unsigned sum, cnt, mine, sp = 0u;
    for (;;) {
        sum = 0u; cnt = 0u; mine = 0u;
#pragma unroll
        for (unsigned j = 0; j < 16; ++j) { const unsigned c = xb_ld(&bar[XB_XCNT(j)]); sum += c; cnt += (c > 0u) ? 1u : 0u; mine = (j == x) ? c : mine; }
        if (sum == G) break;
        __builtin_amdgcn_s_sleep(1);
        if ((++sp & 255u) == 0u) { if (xb_ld(&bar[XB_TMO])) break; if (sp > XB_SPIN_CAP) { atomicAdd(&bar[XB_TMO], 1u); break; } }
    }
    nloc = mine > 0u ? mine : 1u; nx = cnt > 0u ? cnt : 1u;
}

__device__ __forceinline__ void xcd_barrier(const XcdBarrier& b) {
    asm volatile("s_waitcnt vmcnt(0)" ::: "memory");
    __syncthreads();
    if (threadIdx.x == 0) {
        unsigned* bar = b.bar;
        __builtin_amdgcn_s_waitcnt(0);
        unsigned nloc = b.st[0], nx = b.st[1];
        if (nloc == 0u) { xcd_barrier_complete(bar, b.x, nloc, nx); b.st[0] = nloc; b.st[1] = nx; }
        const unsigned old = xb_add(&bar[XB_XSUB(b.x)], 1u);
        const unsigned gen = old / nloc;
        if (old + 1u == (gen + 1u) * nloc) {
            __builtin_amdgcn_fence(__ATOMIC_RELEASE, "agent");
            asm volatile("s_waitcnt vmcnt(0)" ::: "memory");
            const unsigned og = xb_add(&bar[XB_TOP], 1u);
            const unsigned tg = og / nx;
            if (og + 1u == (tg + 1u) * nx) xb_add(&bar[XB_TOPGEN], 1u);
            else XB_SPIN(xb_ld(&bar[XB_TOPGEN]) == tg, bar);
            __builtin_amdgcn_fence(__ATOMIC_ACQUIRE, "agent");
            xb_add(&bar[XB_XGEN(b.x)], 1u);
            asm volatile("s_waitcnt vmcnt(0)" ::: "memory");
        } else {
            XB_SPIN(xb_ld(&bar[XB_XGEN(b.x)]) == gen, bar);
            __builtin_amdgcn_fence(__ATOMIC_ACQUIRE, "agent");
            asm volatile("s_waitcnt vmcnt(0)" ::: "memory");
        }
    }
    __syncthreads();
}


__device__ __forceinline__ unsigned f2bf(float f) { unsigned u = __builtin_bit_cast(unsigned, f); return (u + 0x7fffu + ((u >> 16) & 1u)) >> 16; }
__device__ __forceinline__ unsigned pk2(float lo, float hi) { return f2bf(lo) | (f2bf(hi) << 16); }
__device__ __forceinline__ void transpose_item(const float* W, int K, int N, bf16* WT, int k0, int n0, int orow0, float scale, LAS float* scr, int lane) {
    { float v[32];
      const float* src = W + (size_t)(k0 + (lane >> 5)) * N + n0 + (lane & 31);
#pragma unroll
      for (int i = 0; i < 32; ++i) v[i] = __builtin_nontemporal_load(src + (size_t)(2 * i) * N);
#pragma unroll
      for (int i = 0; i < 32; ++i) scr[(2 * i + (lane >> 5)) * 33 + (lane & 31)] = v[i]; }
    LDS_WAIT(); asm volatile("" ::: "memory");
    const int c = lane & 7;
#pragma unroll
    for (int j = 0; j < 4; ++j) { const int n = (lane >> 3) + 8 * j; const LAS float* s = scr + (8 * c) * 33 + n;
        v4u o; o.x = pk2(s[0 * 33] * scale, s[1 * 33] * scale); o.y = pk2(s[2 * 33] * scale, s[3 * 33] * scale); o.z = pk2(s[4 * 33] * scale, s[5 * 33] * scale); o.w = pk2(s[6 * 33] * scale, s[7 * 33] * scale);
        *(GAS v4u*)(WT + (size_t)(orow0 + n) * K + k0 + 8 * c) = o; }
    LDS_WAIT(); asm volatile("" ::: "memory");
}

struct Args { const float* in[18]; float* out; unsigned char* ws; };

template <int N> __device__ __forceinline__ void load_q(float (&q)[N], const bf16* p) {
#pragma unroll
    for (int c = 0; c < N / 8; ++c) { const v4u w = *(const v4u*)(p + 8 * c);
        q[8 * c + 0] = bflo(w.x); q[8 * c + 1] = bfhi(w.x); q[8 * c + 2] = bflo(w.y); q[8 * c + 3] = bfhi(w.y); q[8 * c + 4] = bflo(w.z); q[8 * c + 5] = bfhi(w.z); q[8 * c + 6] = bflo(w.w); q[8 * c + 7] = bfhi(w.w); }
}
template <int N> __device__ __forceinline__ float dot_q(const float (&q)[N], const bf16* k) {
    float s0 = 0.f, s1 = 0.f;
#pragma unroll
    for (int c = 0; c < N / 8; ++c) { const v4u w = *(const v4u*)(k + 8 * c);
        s0 += q[8 * c + 0] * bflo(w.x); s1 += q[8 * c + 1] * bfhi(w.x); s0 += q[8 * c + 2] * bflo(w.y); s1 += q[8 * c + 3] * bfhi(w.y);
        s0 += q[8 * c + 4] * bflo(w.z); s1 += q[8 * c + 5] * bfhi(w.z); s0 += q[8 * c + 6] * bflo(w.w); s1 += q[8 * c + 7] * bfhi(w.w); }
    return s0 + s1;
}
__device__ __forceinline__ float softmax_buf(LAS float* buf, int nk, float mx, int lane) {
    mx = wave_max(mx); float sum = 0.f;
    for (int j = lane; j < nk; j += 64) { const float e = __builtin_amdgcn_exp2f(buf[j] - mx); buf[j] = e; sum += e; }
    sum = wave_sum(sum); LDS_WAIT();
    return 1.0f / sum;
}

namespace att {
using bf16x8 = __attribute__((ext_vector_type(8))) short;
using s16x4  = __attribute__((ext_vector_type(4))) short;
using f32x16 = __attribute__((ext_vector_type(16))) float;
constexpr int LDP = INC;
constexpr int L_V = 0, L_K = 32768, L_WS = 65536, L_RPB = 67584, L_STASH = 69632, L_OEPI = 16896;
static_assert(L_STASH + 8 * 8192 <= RING_BYTES && 8 * L_OEPI <= RING_BYTES, "attention LDS map");
constexpr float THR2 = 11.541560327111707f;
#define SBAR() __builtin_amdgcn_sched_barrier(0)
#ifndef A_RING3
#define A_RING3 1
#endif
#ifndef B_RING3
#define B_RING3 1
#endif
__device__ __forceinline__ int crow(int r, int hi) { return (r & 3) + 8 * (r >> 2) + 4 * hi; }
template <int DK> __device__ __forceinline__ int kswz(int row, int colB) { return row * (2 * DK) + (colB ^ ((DK == 64 ? ((row >> 1) & 7) : (row & 15)) << 4)); }
__device__ __forceinline__ int v_st(int k, int c) { const int kk = (k & ~0xC) | ((k & 4) << 1) | ((k & 8) >> 1); return ((kk >> 3) * 4 + (c >> 5)) * 512 + ((kk & 7) * 32 + (c & 31)) * 2; }
__device__ __forceinline__ int v_rd_base(int lane) { return ((lane & 3) << 3) | (((lane >> 2) & 3) << 6) | (((lane >> 4) & 1) << 5) | (((lane >> 5) & 1) << 8); }
constexpr int v_rd_off(int d0, int ks, int half) { return d0 * 512 + ks * 4096 + half * 2048; }
template <int OFF> __device__ __forceinline__ s16x4 tr_read(int vb) { s16x4 r; asm volatile("ds_read_b64_tr_b16 %0, %1 offset:%2" : "=&v"(r) : "v"(vb), "i"(OFF) : "memory"); return r; }
template <int D0> __device__ __forceinline__ void pv_one(f32x16& od, int vb, bf16x8 pa0, bf16x8 pa1, bf16x8 pa2, bf16x8 pa3) {
    const s16x4 l0 = tr_read<v_rd_off(D0, 0, 0)>(vb), h0 = tr_read<v_rd_off(D0, 0, 1)>(vb), l1 = tr_read<v_rd_off(D0, 1, 0)>(vb), h1 = tr_read<v_rd_off(D0, 1, 1)>(vb);
    const s16x4 l2 = tr_read<v_rd_off(D0, 2, 0)>(vb), h2 = tr_read<v_rd_off(D0, 2, 1)>(vb), l3 = tr_read<v_rd_off(D0, 3, 0)>(vb), h3 = tr_read<v_rd_off(D0, 3, 1)>(vb);
    asm volatile("s_waitcnt lgkmcnt(0)" ::: "memory"); SBAR();
#define PK(L, H) (bf16x8){L[0], L[1], L[2], L[3], H[0], H[1], H[2], H[3]}
    od = __builtin_amdgcn_mfma_f32_32x32x16_bf16(pa0, PK(l0, h0), od, 0, 0, 0);
    od = __builtin_amdgcn_mfma_f32_32x32x16_bf16(pa1, PK(l1, h1), od, 0, 0, 0);
    od = __builtin_amdgcn_mfma_f32_32x32x16_bf16(pa2, PK(l2, h2), od, 0, 0, 0);
    od = __builtin_amdgcn_mfma_f32_32x32x16_bf16(pa3, PK(l3, h3), od, 0, 0, 0);
#undef PK
}
#ifndef PV_PIPE
#define PV_PIPE 1
#endif
template <int D0> __device__ __forceinline__ void pv_reads(int vb, s16x4 (&f)[8]) {
    f[0] = tr_read<v_rd_off(D0, 0, 0)>(vb); f[1] = tr_read<v_rd_off(D0, 0, 1)>(vb); f[2] = tr_read<v_rd_off(D0, 1, 0)>(vb); f[3] = tr_read<v_rd_off(D0, 1, 1)>(vb);
    f[4] = tr_read<v_rd_off(D0, 2, 0)>(vb); f[5] = tr_read<v_rd_off(D0, 2, 1)>(vb); f[6] = tr_read<v_rd_off(D0, 3, 0)>(vb); f[7] = tr_read<v_rd_off(D0, 3, 1)>(vb);
}
__device__ __forceinline__ void pv_mma(f32x16& od, const s16x4 (&f)[8], bf16x8 pa0, bf16x8 pa1, bf16x8 pa2, bf16x8 pa3) {
#define PK(L, H) (bf16x8){L[0], L[1], L[2], L[3], H[0], H[1], H[2], H[3]}
    od = __builtin_amdgcn_mfma_f32_32x32x16_bf16(pa0, PK(f[0], f[1]), od, 0, 0, 0);
    od = __builtin_amdgcn_mfma_f32_32x32x16_bf16(pa1, PK(f[2], f[3]), od, 0, 0, 0);
    od = __builtin_amdgcn_mfma_f32_32x32x16_bf16(pa2, PK(f[4], f[5]), od, 0, 0, 0);
    od = __builtin_amdgcn_mfma_f32_32x32x16_bf16(pa3, PK(f[6], f[7]), od, 0, 0, 0);
#undef PK
}
__device__ __forceinline__ void pv_d0(f32x16* o, int vb, bf16x8 pa0, bf16x8 pa1, bf16x8 pa2, bf16x8 pa3) {
#if PV_PIPE
    s16x4 fa[8], fb[8];
    pv_reads<0>(vb, fa); pv_reads<1>(vb, fb);
    asm volatile("s_waitcnt lgkmcnt(8)" ::: "memory"); SBAR(); pv_mma(o[0], fa, pa0, pa1, pa2, pa3); SBAR();
    pv_reads<2>(vb, fa);
    asm volatile("s_waitcnt lgkmcnt(8)" ::: "memory"); SBAR(); pv_mma(o[1], fb, pa0, pa1, pa2, pa3); SBAR();
    pv_reads<3>(vb, fb);
    asm volatile("s_waitcnt lgkmcnt(8)" ::: "memory"); SBAR(); pv_mma(o[2], fa, pa0, pa1, pa2, pa3); SBAR();
    asm volatile("s_waitcnt lgkmcnt(0)" ::: "memory"); SBAR(); pv_mma(o[3], fb, pa0, pa1, pa2, pa3);
#else
    pv_one<0>(o[0], vb, pa0, pa1, pa2, pa3); pv_one<1>(o[1], vb, pa0, pa1, pa2, pa3); pv_one<2>(o[2], vb, pa0, pa1, pa2, pa3); pv_one<3>(o[3], vb, pa0, pa1, pa2, pa3);
#endif
}
#define MF1(OD, PA, L, H) OD = __builtin_amdgcn_mfma_f32_32x32x16_bf16(PA, (bf16x8){L[0], L[1], L[2], L[3], H[0], H[1], H[2], H[3]}, OD, 0, 0, 0)
__device__ __forceinline__ void pv_sm(f32x16* o, int vb, bf16x8 pa0, bf16x8 pa1, bf16x8 pa2, bf16x8 pa3, f32x16& p0, f32x16& p1, float& m_reg, float& mn, float& alpha) {
    s16x4 fa[8], fb[8];
    pv_reads<0>(vb, fa); pv_reads<1>(vb, fb);
    asm volatile("s_waitcnt lgkmcnt(8)" ::: "memory"); SBAR();
    float pmax = p0[0];
    MF1(o[0], pa0, fa[0], fa[1]); SBAR();
#pragma unroll
    for (int r = 1; r < 8; ++r) pmax = fmaxf(pmax, p0[r]);
    SBAR(); MF1(o[0], pa1, fa[2], fa[3]); SBAR();
#pragma unroll
    for (int r = 8; r < 16; ++r) pmax = fmaxf(pmax, p0[r]);
    SBAR(); MF1(o[0], pa2, fa[4], fa[5]); SBAR();
#pragma unroll
    for (int r = 0; r < 8; ++r) pmax = fmaxf(pmax, p1[r]);
    SBAR(); MF1(o[0], pa3, fa[6], fa[7]); SBAR();
#pragma unroll
    for (int r = 8; r < 16; ++r) pmax = fmaxf(pmax, p1[r]);
    SBAR();
    pv_reads<2>(vb, fa);
    { auto rr = __builtin_amdgcn_permlane32_swap(__float_as_uint(pmax), __float_as_uint(pmax), false, false); pmax = fmaxf(__uint_as_float(rr[0]), __uint_as_float(rr[1])); }
    if (__builtin_expect(__all(pmax - m_reg <= THR2), 1)) { mn = m_reg; alpha = 1.f; }
    else { mn = fmaxf(m_reg, pmax); alpha = __builtin_amdgcn_exp2f(m_reg - mn); m_reg = mn; }
    asm volatile("s_waitcnt lgkmcnt(8)" ::: "memory"); SBAR();
#define EX2(R) do { float t_ = __builtin_amdgcn_exp2f(p0[R] - mn); asm volatile("" : "+v"(t_)); p0[R] = t_; } while (0)
#define SB2(R) do { float t_ = p1[R] - mn; asm volatile("" : "+v"(t_)); p1[R] = t_; } while (0)
    MF1(o[1], pa0, fb[0], fb[1]); SBAR(); EX2(0); EX2(1); SBAR();
    MF1(o[1], pa1, fb[2], fb[3]); SBAR(); EX2(2); EX2(3); SBAR();
    MF1(o[1], pa2, fb[4], fb[5]); SBAR(); EX2(4); EX2(5); SBAR();
    MF1(o[1], pa3, fb[6], fb[7]); SBAR(); EX2(6); EX2(7); SBAR();
    pv_reads<3>(vb, fb);
    asm volatile("s_waitcnt lgkmcnt(8)" ::: "memory"); SBAR();
    MF1(o[2], pa0, fa[0], fa[1]); SBAR(); EX2(8); SB2(0); SB2(1); SBAR();
    MF1(o[2], pa1, fa[2], fa[3]); SBAR(); EX2(9); SB2(2); SB2(3); SBAR();
    MF1(o[2], pa2, fa[4], fa[5]); SBAR(); EX2(10); SB2(4); SB2(5); SBAR();
    MF1(o[2], pa3, fa[6], fa[7]); SBAR(); EX2(11); SB2(6); SB2(7); SBAR();
    asm volatile("s_waitcnt lgkmcnt(0)" ::: "memory"); SBAR();
    MF1(o[3], pa0, fb[0], fb[1]); SBAR(); EX2(12); SB2(8); SB2(9); SBAR();
    MF1(o[3], pa1, fb[2], fb[3]); SBAR(); EX2(13); SB2(10); SB2(11); SBAR();
    MF1(o[3], pa2, fb[4], fb[5]); SBAR(); EX2(14); SB2(12); SB2(13); SBAR();
    MF1(o[3], pa3, fb[6], fb[7]); SBAR(); EX2(15); SB2(14); SB2(15); SBAR();
#undef EX2
#undef SB2
}
#undef MF1
template <int DK> __device__ __forceinline__ void qkt(f32x16& p0, f32x16& p1, const LAS unsigned char* Ks, const bf16x8* qr, int r32, int hi) {
    p0 = f32x16{}; p1 = f32x16{};
#pragma unroll
    for (int d0 = 0; d0 < DK / 16; ++d0) { const int cb = (d0 * 16 + hi * 8) * 2;
        const bf16x8 b0 = *(const LAS bf16x8*)(Ks + kswz<DK>(r32, cb)), b1 = *(const LAS bf16x8*)(Ks + kswz<DK>(32 + r32, cb));
        p0 = __builtin_amdgcn_mfma_f32_32x32x16_bf16(b0, qr[d0], p0, 0, 0, 0);
        p1 = __builtin_amdgcn_mfma_f32_32x32x16_bf16(b1, qr[d0], p1, 0, 0, 0); }
}
__device__ __forceinline__ void pack_p(const f32x16& p0, const f32x16& p1, bf16x8& pa0, bf16x8& pa1, bf16x8& pa2, bf16x8& pa3) {
#define PK4(P, BASE, OUT) do { unsigned a0 = cvt_pk_bf16(P[BASE + 0], P[BASE + 1]), a1 = cvt_pk_bf16(P[BASE + 2], P[BASE + 3]);   \
    unsigned b0 = cvt_pk_bf16(P[BASE + 4], P[BASE + 5]), b1 = cvt_pk_bf16(P[BASE + 6], P[BASE + 7]);                              \
    auto r0 = __builtin_amdgcn_permlane32_swap(a0, b0, false, false); auto r1 = __builtin_amdgcn_permlane32_swap(a1, b1, false, false); \
    v4u w = {r0[0], r1[0], r0[1], r1[1]}; OUT = *reinterpret_cast<bf16x8*>(&w); } while (0)
    PK4(p0, 0, pa0); PK4(p0, 8, pa1); PK4(p1, 0, pa2); PK4(p1, 8, pa3);
#undef PK4
}
__device__ __forceinline__ void sm_part(f32x16& p0, f32x16& p1, float& m_reg, float& mn, float& alpha) {
    float pmax = p0[0];
#pragma unroll
    for (int r = 1; r < 16; ++r) pmax = fmaxf(pmax, p0[r]);
#pragma unroll
    for (int r = 0; r < 16; ++r) pmax = fmaxf(pmax, p1[r]);
    { auto rr = __builtin_amdgcn_permlane32_swap(__float_as_uint(pmax), __float_as_uint(pmax), false, false); pmax = fmaxf(__uint_as_float(rr[0]), __uint_as_float(rr[1])); }
    if (__builtin_expect(__all(pmax - m_reg <= THR2), 1)) { mn = m_reg; alpha = 1.f; }
    else { mn = fmaxf(m_reg, pmax); alpha = __builtin_amdgcn_exp2f(m_reg - mn); m_reg = mn; }
#pragma unroll
    for (int r = 0; r < 16; ++r) { p0[r] = __builtin_amdgcn_exp2f(p0[r] - mn); p1[r] = p1[r] - mn; }
}
__device__ __forceinline__ void sm_fin(f32x16& p0, f32x16& p1, float alpha, float& l_reg, bf16x8& pa0, bf16x8& pa1, bf16x8& pa2, bf16x8& pa3) {
#pragma unroll
    for (int r = 0; r < 16; ++r) p1[r] = __builtin_amdgcn_exp2f(p1[r]);
    float ps = 0.f;
#pragma unroll
    for (int r = 0; r < 16; ++r) ps += p0[r];
#pragma unroll
    for (int r = 0; r < 16; ++r) ps += p1[r];
    { auto rr = __builtin_amdgcn_permlane32_swap(__float_as_uint(ps), __float_as_uint(ps), false, false); ps = __uint_as_float(rr[0]) + __uint_as_float(rr[1]); }
    l_reg = l_reg * alpha + ps;
    pack_p(p0, p1, pa0, pa1, pa2, pa3);
}
__device__ __forceinline__ void b_mask(f32x16& p0, f32x16& p1, int j, const LAS float* tab, int kr0, int nkr, int qrow, int rs, int qc, int cst, int hi) {
    const int jj = j - 4, kr = kr0 + (jj < nkr ? jj : nkr - 1);
    const bool rowok = (jj < nkr) && (kr >= rs) && (kr < rs + 8);
    const float NEG = -INFINITY;
    if (!rowok) {
#pragma unroll
        for (int r = 0; r < 16; ++r) { p0[r] = NEG; p1[r] = NEG; }
        return; }
    const int base = (kr - qrow + 7) * 31 + 15 - qc + 4 * hi, cb = 4 * hi - cst;
#pragma unroll
    for (int q = 0; q < 4; ++q) {
        float b0[4], b1[4];
#pragma unroll
        for (int e = 0; e < 4; ++e) { b0[e] = tab[base + 8 * q + e]; b1[e] = tab[base + 8 * q + e + 32]; }
        asm volatile("" : "+v"(b0[0]), "+v"(b0[1]), "+v"(b0[2]), "+v"(b0[3]), "+v"(b1[0]), "+v"(b1[1]), "+v"(b1[2]), "+v"(b1[3]));
#pragma unroll
        for (int e = 0; e < 4; ++e) { const int r = 4 * q + e, cr = 8 * q + e;
            p0[r] = ((unsigned)(cr + cb) < 16u) ? p0[r] + b0[e] : NEG;
            p1[r] = ((unsigned)(cr + 32 + cb) < 16u) ? p1[r] + b1[e] : NEG; }
    }
}
__device__ __forceinline__ void c_weight(f32x16& p, int half, int kind, float base, float lf, float lb, const LAS float* tab) {
    if (kind == 3) {
#pragma unroll
        for (int r = 0; r < 16; ++r) { const float df = base - (float)((r & 3) + 8 * (r >> 2) + 32 * half), db = -df;
            const float w = (df >= 0.f ? __builtin_amdgcn_exp2f(lf * df) : 0.f) + (db >= 0.f ? __builtin_amdgcn_exp2f(lb * db) : 0.f); p[r] *= w; }
        return; }
    if (kind == 1) { const float af = __builtin_amdgcn_exp2f(lf * base);
#pragma unroll
        for (int q = 0; q < 4; ++q) { const f32x4 t = *(const LAS f32x4*)(tab + half * 16 + 4 * q);
#pragma unroll
            for (int e = 0; e < 4; ++e) p[4 * q + e] *= af * t[e]; } }
    else if (kind == 2) { const float ab = __builtin_amdgcn_exp2f(-lb * base);
#pragma unroll
        for (int q = 0; q < 4; ++q) { const f32x4 t = *(const LAS f32x4*)(tab + 32 + half * 16 + 4 * q);
#pragma unroll
            for (int e = 0; e < 4; ++e) p[4 * q + e] *= ab * t[e]; } }
    else { const float af = __builtin_amdgcn_exp2f(lf * base), ab = __builtin_amdgcn_exp2f(lb * ((float)SB - base));
#pragma unroll
        for (int q = 0; q < 4; ++q) { const f32x4 t = *(const LAS f32x4*)(tab + half * 16 + 4 * q), u = *(const LAS f32x4*)(tab + 32 + half * 16 + 4 * q);
#pragma unroll
            for (int e = 0; e < 4; ++e) p[4 * q + e] *= af * t[e] + ab * u[e]; } }
}

struct UnitD { const bf16* Q; const bf16* K; const bf16* V; int row_base, off, cap, NT; };
struct ModeP { int plain, kr0, nkr, qr0; const float* rpb; float lf, lb; int sq0, latq; };

template <int DK, int MODE, int SDEPTH>
__device__ __forceinline__ void attn_core(LAS unsigned char* lds, const UnitD& ud, const ModeP& mp, f32x16 (&o)[4], int tid) {
    const int wid = __builtin_amdgcn_readfirstlane(tid >> 6), lane = tid & 63, r32 = lane & 31, hi = lane >> 5;
    LAS unsigned char* Vl = lds + L_V; LAS unsigned char* Kl = lds + L_K;
    LAS float* wsf = (LAS float*)(lds + L_WS) + wid * 64; LAS float* li_l = wsf; LAS float* al_l = wsf + 32;
    const LAS float* rtab = (const LAS float*)(lds + L_RPB);
    float m_reg = -1e30f, l_reg = 0.f;
#pragma unroll
    for (int d = 0; d < 4; ++d) o[d] = f32x16{};
    bf16x8 qr[DK / 16];
    { const bf16* Qw = ud.Q + (size_t)(wid * 32 + r32) * LDP + hi * 8;
#pragma unroll
      for (int d0 = 0; d0 < DK / 16; ++d0) qr[d0] = *(const bf16x8*)(Qw + d0 * 16); }
    const int sr = tid >> 4, sc = (tid & 15) * 8, vst0 = v_st(sr, sc), vst1 = v_st(32 + sr, sc);
    const int kr64 = tid >> 3, kc64 = (tid & 7) * 8;
    const int vb0 = (int)(unsigned)(unsigned long)Vl + v_rd_base(lane);
    const int qc = 32 * (wid & 1) + r32, qrow = mp.qr0 + (wid >> 1), rs = min(max(qrow - 4, 0), 24), cst = min(max(qc - 8, 0), 48);
    const int s_lo = mp.sq0 + wid * 32, si = s_lo + r32;
    bf16x8 vs0[SDEPTH], vs1[SDEPTH], ks0[SDEPTH], ks1[SDEPTH];
#define TROW(j_) (ud.row_base + 64 * ((j_) < 4 ? (j_) : ud.off + min((j_) - 4, ud.cap)))
#define SLOAD(i, j_) do { const int tr_ = TROW(j_); \
        vs0[i] = *(const bf16x8*)(ud.V + (size_t)(tr_ + sr) * LDP + sc); vs1[i] = *(const bf16x8*)(ud.V + (size_t)(tr_ + 32 + sr) * LDP + sc); \
        if constexpr (DK == 128) { ks0[i] = *(const bf16x8*)(ud.K + (size_t)(tr_ + sr) * LDP + sc); ks1[i] = *(const bf16x8*)(ud.K + (size_t)(tr_ + 32 + sr) * LDP + sc); } \
        else { ks0[i] = *(const bf16x8*)(ud.K + (size_t)(tr_ + kr64) * LDP + kc64); } } while (0)
#define SWRITE(b, i) do { *(LAS bf16x8*)(Vl + (b) * 16384 + vst0) = vs0[i]; *(LAS bf16x8*)(Vl + (b) * 16384 + vst1) = vs1[i]; \
        if constexpr (DK == 128) { *(LAS bf16x8*)(Kl + (b) * 16384 + kswz<128>(sr, sc * 2)) = ks0[i]; *(LAS bf16x8*)(Kl + (b) * 16384 + kswz<128>(32 + sr, sc * 2)) = ks1[i]; } \
        else { *(LAS bf16x8*)(Kl + (b) * 16384 + kswz<64>(kr64, kc64 * 2)) = ks0[i]; } } while (0)
#define SWAIT() do { if constexpr (SDEPTH == 2) { if constexpr (DK == 128) asm volatile("s_waitcnt vmcnt(4)" ::: "memory"); else asm volatile("s_waitcnt vmcnt(3)" ::: "memory"); } \
        else asm volatile("s_waitcnt vmcnt(0)" ::: "memory"); } while (0)
#define RESC(a) do { if constexpr (MODE != 2) { if (__any((a) < 1.f)) { if (hi == 0) al_l[r32] = (a); asm volatile("s_waitcnt lgkmcnt(0)" ::: "memory"); \
        _Pragma("unroll") for (int d = 0; d < 4; ++d) _Pragma("unroll") for (int r = 0; r < 16; ++r) o[d][r] *= al_l[crow(r, hi)]; } } } while (0)
#define PART1(P0, P1, j_, MN, AL) do { \
        if constexpr (MODE == 2) { const int ck_ = (mp.latq && (j_) < 4) ? 0 : (64 * (j_) + 63 < s_lo) ? 1 : (64 * (j_) > s_lo + 31) ? 2 : 3; c_weight(P0, 0, ck_, (float)(si - 64 * (j_) - 4 * hi), mp.lf, mp.lb, rtab); AL = 1.f; MN = 0.f; } \
        else { if constexpr (MODE == 1) { if (!mp.plain && (j_) >= 4) b_mask(P0, P1, (j_), rtab, mp.kr0, mp.nkr, qrow, rs, qc, cst, hi); } sm_part(P0, P1, m_reg, MN, AL); } } while (0)
#define PART2(P0, P1, j_, AL) do { \
        if constexpr (MODE == 2) { const int ck_ = (mp.latq && (j_) < 4) ? 0 : (64 * (j_) + 63 < s_lo) ? 1 : (64 * (j_) > s_lo + 31) ? 2 : 3; c_weight(P1, 1, ck_, (float)(si - 64 * (j_) - 4 * hi), mp.lf, mp.lb, rtab); pack_p(P0, P1, pa0, pa1, pa2, pa3); } \
        else sm_fin(P0, P1, AL, l_reg, pa0, pa1, pa2, pa3); } while (0)
#define PVSM(VB, P0, P1, j_, MN, AL) do { \
        if constexpr (MODE != 0) { pv_d0(o, (VB), pa0, pa1, pa2, pa3); PART1(P0, P1, (j_), MN, AL); } \
        else pv_sm(o, (VB), pa0, pa1, pa2, pa3, P0, P1, m_reg, MN, AL); } while (0)
    f32x16 pA0, pA1, pB0, pB1; float mnA, mnB, alA, alB; bf16x8 pa0, pa1, pa2, pa3; const int NT = ud.NT;
    constexpr int SE = 0, SO = SDEPTH - 1;
    __syncthreads();
    if constexpr (MODE == 1) { if (!mp.plain) { if (tid < 465) ((LAS float*)(lds + L_RPB))[tid] = mp.rpb[tid] * LOG2E; } }
    if constexpr (MODE == 2) { if (tid < 64) { const int t_ = tid & 31, cr_ = (t_ & 3) + 8 * ((t_ & 15) >> 2) + 32 * (t_ >> 4);
        ((LAS float*)(lds + L_RPB))[tid] = __builtin_amdgcn_exp2f((tid < 32 ? -mp.lf : mp.lb) * (float)cr_); } }
    SLOAD(SE, 0); asm volatile("s_waitcnt vmcnt(0)" ::: "memory"); SWRITE(0, SE); __syncthreads();
    qkt<DK>(pA0, pA1, Kl, qr, r32, hi); PART1(pA0, pA1, 0, mnA, alA);
    SLOAD(SO, 1); if constexpr (SDEPTH == 2) { if (2 < NT) SLOAD(SE, 2); }
    SWAIT(); SWRITE(1, SO); __syncthreads();
    for (int j = 1; j + 1 < NT; j += 2) {
        SBAR(); qkt<DK>(pB0, pB1, Kl + 16384, qr, r32, hi);
        PART2(pA0, pA1, j - 1, alA); SBAR();
        SLOAD(SO, j + SDEPTH); SBAR();
        PVSM(vb0, pB0, pB1, j, mnB, alB);
        __syncthreads(); SWAIT(); SWRITE(0, SE);
        RESC(alB); __syncthreads();
        SBAR(); qkt<DK>(pA0, pA1, Kl, qr, r32, hi);
        PART2(pB0, pB1, j, alB); SBAR();
        if (SDEPTH == 1 || j + 3 < NT) SLOAD(SE, j + 1 + SDEPTH); SBAR();
        PVSM(vb0 + 16384, pA0, pA1, j + 1, mnA, alA);
        __syncthreads(); SWAIT(); SWRITE(1, SO);
        RESC(alA); __syncthreads();
    }
    SBAR(); qkt<DK>(pB0, pB1, Kl + 16384, qr, r32, hi);
    PART2(pA0, pA1, NT - 2, alA); SBAR();
    PVSM(vb0, pB0, pB1, NT - 1, mnB, alB);
    __syncthreads(); RESC(alB);
    PART2(pB0, pB1, NT - 1, alB); SBAR();
    pv_d0(o, vb0 + 16384, pa0, pa1, pa2, pa3);
    if constexpr (MODE != 2) {
        if (hi == 0) li_l[r32] = l_reg; asm volatile("s_waitcnt lgkmcnt(0)" ::: "memory");
#pragma unroll
        for (int r = 0; r < 16; ++r) { const float rl = __builtin_amdgcn_rcpf(li_l[crow(r, hi)]);
#pragma unroll
            for (int d = 0; d < 4; ++d) o[d][r] *= rl; }
    }
    (void)mnA; (void)mnB;
#undef TROW
#undef SLOAD
#undef SWRITE
#undef SWAIT
#undef RESC
#undef PART1
#undef PVSM
#undef PART2
}

constexpr int A3_K = 0, A3_V = 24576, A3_WS = 73728, L_STASH3 = 75776;
static_assert(L_STASH3 + 7 * 8192 <= RING_BYTES, "attention LDS map (ring-3): stash slots 0..6 inside the ring, slot 7 overlays LTAB");
typedef LAS const char* lds_cptr;
typedef short v4i16_t __attribute__((ext_vector_type(4)));
typedef unsigned u32x4_t __attribute__((ext_vector_type(4)));
#define A3_PIN(x) asm volatile("" : "+v"(x))
#define A3_WAIT_BAR(N) asm volatile("s_waitcnt vmcnt(" #N ") lgkmcnt(0)\n\ts_barrier" ::: "memory")
__device__ __forceinline__ void glds16(const void* g, unsigned lds_base) {
    unsigned sv; asm volatile("s_mov_b32 %0, m0\n\ts_mov_b32 m0, %2\n\ts_nop 0\n\tglobal_load_lds_dwordx4 %1, off\n\ts_mov_b32 m0, %0" : "=&s"(sv) : "v"(g), "s"(lds_base) : "memory"); }
__device__ __forceinline__ void glds16s(const void* sbase, unsigned voff, unsigned lds_base) {
    asm volatile("s_mov_b32 m0, %2\n\ts_nop 0\n\tglobal_load_lds_dwordx4 %0, %1" :: "v"(voff), "s"(sbase), "s"(lds_base) : "memory", "m0"); }
__device__ __forceinline__ void kload2(bf16x8* kf, lds_cptr kp, int d0) { kf[2 * d0] = *(const LAS bf16x8*)(kp + d0 * 2048); kf[2 * d0 + 1] = *(const LAS bf16x8*)(kp + d0 * 2048 + 512); }
__device__ __forceinline__ s16x4 vtr(lds_cptr p) { return __builtin_bit_cast(s16x4, __builtin_amdgcn_ds_read_tr16_b64_v4i16((LAS v4i16_t*)p)); }
#define A3_MX3(a, b, c) fmaxf(fmaxf((a), (b)), (c))
__device__ __forceinline__ float rowmax3(const f32x16& p0, const f32x16& p1) {
    float a = A3_MX3(p0[0], p0[1], p1[0]), b = A3_MX3(p0[2], p0[3], p1[1]); a = A3_MX3(a, p1[2], p1[3]);
#pragma unroll
    for (int r = 4; r < 16; r += 4) { a = A3_MX3(a, p0[r], p0[r + 1]); b = A3_MX3(b, p0[r + 2], p0[r + 3]); a = A3_MX3(a, p1[r], p1[r + 1]); b = A3_MX3(b, p1[r + 2], p1[r + 3]); }
    float m = fmaxf(a, b); auto rr = __builtin_amdgcn_permlane32_swap(__float_as_uint(m), __float_as_uint(m), false, false);
    return fmaxf(__uint_as_float(rr[0]), __uint_as_float(rr[1])); }
__device__ __forceinline__ void attn_a3(LAS unsigned char* lds, const bf16* Q, const bf16* K, const bf16* V, int row_base, int NT, f32x16 (&o)[4], int tid) {
    const int lane = tid & 63, r32 = lane & 31, hi = lane >> 5; const int wid = __builtin_amdgcn_readfirstlane(tid >> 6);
    const unsigned lds0 = (unsigned)(unsigned long)lds; LAS float* wsf = (LAS float*)(lds + A3_WS) + wid * 64;
    const unsigned koff = (unsigned)(((size_t)(row_base + lane) * LDP + wid * 8) * 2);
    const unsigned voff = (unsigned)(((size_t)(row_base + 16 * (wid & 3) + (lane >> 2)) * LDP + (wid >> 2) * 32 + (lane & 3) * 8) * 2);
    const unsigned kdst = lds0 + A3_K + wid * 1024, vdst = lds0 + A3_V + wid * 1024;
#define DMA_K(t, sl) glds16s(K + (size_t)(t) * (64 * LDP), koff, (unsigned)__builtin_amdgcn_readfirstlane((int)(kdst + (sl))))
#define DMA_V(t, sl) do { const bf16* v_ = V + (size_t)(t) * (64 * LDP); const unsigned d_ = (unsigned)__builtin_amdgcn_readfirstlane((int)(vdst + 2 * (sl))); glds16s(v_, voff, d_); glds16s(v_ + 64, voff, d_ + 8192); } while (0)
    const lds_cptr vp0 = (lds_cptr)lds + A3_V + ((lane >> 4) & 1) * 32 + (lane & 3) * 8 + (4 * hi + ((lane & 15) >> 2)) * 64;
    const lds_cptr kp0 = (lds_cptr)lds + A3_K + hi * 1024 + r32 * 16;
    __syncthreads();
    DMA_K(0, 0); DMA_V(0, 0); DMA_K(1, 8192);
    bf16x8 qr[4];
    { const bf16* Qw = Q + (size_t)(wid * 32 + r32) * LDP + hi * 8;
#pragma unroll
      for (int d0 = 0; d0 < 4; ++d0) qr[d0] = *(const bf16x8*)(Qw + d0 * 16); }
    float mhat = 0.f, l_reg = 0.f;
#pragma unroll
    for (int d = 0; d < 4; ++d) o[d] = f32x16{};
    bool resc = false; f32x16 negm;
    f32x16 pA0, pA1, pB0, pB1; bf16x8 kf[8]; s16x4 vlo[4], vhi[4]; u32x4_t pw0, pw1, pw2, pw3;
    int sl_prev = 0, sl_cur = 0, sl_next = 8192;
#define ROT() do { sl_prev = sl_cur; sl_cur = sl_next; sl_next = (sl_next == 16384) ? 0 : sl_next + 8192; } while (0)
#define MFMA_(a, b, c) __builtin_amdgcn_mfma_f32_32x32x16_bf16(a, b, c, 0, 0, 0)
#define EX(v) __builtin_amdgcn_exp2f(v)
#define RESC3() do { if (resc) { _Pragma("unroll") for (int d_ = 0; d_ < 4; ++d_) _Pragma("unroll") for (int r = 0; r < 16; ++r) o[d_][r] *= wsf[crow(r, hi)]; } } while (0)
    DMA_K(2, 16384);
    A3_WAIT_BAR(4);
#pragma unroll
    for (int d0 = 0; d0 < 4; ++d0) kload2(kf, kp0, d0);
    pA0 = f32x16{}; pA1 = f32x16{};
#pragma unroll
    for (int d0 = 0; d0 < 4; ++d0) { pA0 = MFMA_(kf[2 * d0], qr[d0], pA0); pA1 = MFMA_(kf[2 * d0 + 1], qr[d0], pA1); }
    { mhat = rowmax3(pA0, pA1); const float nmh = -mhat;
#pragma unroll
      for (int r = 0; r < 16; ++r) { pA0[r] = EX(pA0[r] + nmh); pA1[r] = EX(pA1[r] + nmh); negm[r] = nmh; }
      A3_PIN(negm); }
    A3_WAIT_BAR(0);
    DMA_K(3, 0); DMA_V(1, 8192); ROT();
#pragma unroll
    for (int d0 = 0; d0 < 4; ++d0) kload2(kf, kp0 + sl_cur, d0);
    A3_WAIT_BAR(3);
#define PKW(P, i) cvt_pk_bf16(P[i], P[i + 1])
#define VFR(s) (bf16x8){vlo[s][0], vlo[s][1], vlo[s][2], vlo[s][3], vhi[s][0], vhi[s][1], vhi[s][2], vhi[s][3]}
#define VRD(s, g) do { vlo[s] = vtr(vp_ + (((g) & 3) * 4096 + ((g) >> 2) * 1024)); vhi[s] = vtr(vp_ + (((g) & 3) * 4096 + ((g) >> 2) * 1024 + 512)); } while (0)
#define KRD(G, d0) do { if (G) kload2(kf, kp0 + sl_next, d0); } while (0)
#define GAPA(MF, a0, a1, a2, a3, W0, W1, PW, RD) do { MF; RD; sacc += a0; sacc += a1; sacc += a2; sacc += a3; W0; W1; A3_PIN(PW); A3_PIN(sacc); SBAR(); } while (0)
#define GAPB(g, PA, X, i, RD) do { o[(g) & 3] = MFMA_(__builtin_bit_cast(bf16x8, PA), VFR((g) & 3), o[(g) & 3]); RD; X[i] = EX(X[i]); X[i + 1] = EX(X[i + 1]); A3_PIN(X); SBAR(); } while (0)
#define NORD do { } while (0)
#define STEP(C0, C1, P0, P1, t, GK, GV, GL) do { SBAR(); \
    const lds_cptr vp_ = vp0 + 2 * sl_prev; float sacc = P0[0] + P0[1]; \
    GAPA(C0 = MFMA_(kf[0], qr[0], negm),     P0[2], P0[3], P0[4], P0[5],     pw0[0] = PKW(P0, 0),  pw0[1] = PKW(P0, 2),  pw0, NORD); \
    GAPA(C1 = MFMA_(kf[1], qr[0], negm),     P0[6], P0[7], P0[8], P0[9],     pw0[2] = PKW(P0, 4),  pw0[3] = PKW(P0, 6),  pw0, NORD); \
    GAPA(C0 = MFMA_(kf[2], qr[1], C0),       P0[10], P0[11], P0[12], P0[13], pw1[0] = PKW(P0, 8),  pw1[1] = PKW(P0, 10), pw1, NORD); \
    GAPA(C1 = MFMA_(kf[3], qr[1], C1),       P0[14], P0[15], P1[0], P1[1],   pw1[2] = PKW(P0, 12), pw1[3] = PKW(P0, 14), pw1, NORD); \
    GAPA(C0 = MFMA_(kf[4], qr[2], C0),       P1[2], P1[3], P1[4], P1[5],     pw2[0] = PKW(P1, 0),  pw2[1] = PKW(P1, 2),  pw2, VRD(0, 0)); \
    GAPA(C1 = MFMA_(kf[5], qr[2], C1),       P1[6], P1[7], P1[8], P1[9],     pw2[2] = PKW(P1, 4),  pw2[3] = PKW(P1, 6),  pw2, VRD(1, 1)); \
    GAPA(C0 = MFMA_(kf[6], qr[3], C0),       P1[10], P1[11], P1[12], P1[13], pw3[0] = PKW(P1, 8),  pw3[1] = PKW(P1, 10), pw3, VRD(2, 2)); \
    GAPA(C1 = MFMA_(kf[7], qr[3], C1),       P1[14], P1[15], 0.f, 0.f,       pw3[2] = PKW(P1, 12), pw3[3] = PKW(P1, 14), pw3, VRD(3, 3)); \
    l_reg += sacc; \
    if (GK) DMA_K((t) + 3, sl_cur); if (GV) DMA_V((t) + 1, sl_next);                                                       \
    { const float rm = rowmax3(C0, C1); resc = false;                                                                      \
      if (__builtin_expect(__any(rm > THR2), 0)) { const float dl = fmaxf(rm, 0.f); mhat += dl;                            \
          const float f = __builtin_amdgcn_exp2f(-dl); l_reg *= f; if (hi == 0) wsf[r32] = f; resc = true; \
          _Pragma("unroll") for (int r = 0; r < 16; ++r) { C0[r] -= dl; C1[r] -= dl; negm[r] = -mhat; } } } \
    SBAR(); \
    GAPB(0,  pw0, C0, 0,  VRD(0, 4));  GAPB(1,  pw0, C0, 2,  VRD(1, 5));  GAPB(2,  pw0, C0, 4,  VRD(2, 6));  GAPB(3,  pw0, C0, 6,  VRD(3, 7)); \
    GAPB(4,  pw1, C0, 8,  VRD(0, 8));  GAPB(5,  pw1, C0, 10, VRD(1, 9));  GAPB(6,  pw1, C0, 12, VRD(2, 10)); GAPB(7,  pw1, C0, 14, VRD(3, 11)); \
    GAPB(8,  pw2, C1, 0,  VRD(0, 12)); GAPB(9,  pw2, C1, 2,  VRD(1, 13)); GAPB(10, pw2, C1, 4,  VRD(2, 14)); GAPB(11, pw2, C1, 6,  VRD(3, 15)); \
    GAPB(12, pw3, C1, 8,  KRD(GL, 0)); GAPB(13, pw3, C1, 10, KRD(GL, 1)); GAPB(14, pw3, C1, 12, KRD(GL, 2)); GAPB(15, pw3, C1, 14, KRD(GL, 3)); \
    } while (0)
#define ENDW(tt) do { if ((tt) + 3 < NT) { A3_WAIT_BAR(3); } else if ((tt) + 2 < NT) { A3_WAIT_BAR(2); } else { A3_WAIT_BAR(0); } } while (0)
    int t = 1;
    for (; t + 5 < NT; t += 2) {
        STEP(pB0, pB1, pA0, pA1, t, true, true, true);     A3_WAIT_BAR(3); RESC3(); ROT();
        STEP(pA0, pA1, pB0, pB1, t + 1, true, true, true); A3_WAIT_BAR(3); RESC3(); ROT();
    }
    for (; t + 1 < NT; t += 2) {
        STEP(pB0, pB1, pA0, pA1, t, (t + 3 < NT), (t + 1 < NT), (t + 1 < NT));         ENDW(t);     RESC3(); ROT();
        STEP(pA0, pA1, pB0, pB1, t + 1, (t + 4 < NT), (t + 2 < NT), (t + 2 < NT));     ENDW(t + 1); RESC3(); ROT();
    }
    STEP(pB0, pB1, pA0, pA1, NT - 1, false, false, false); RESC3();
    { float sacc = pB0[0] + pB0[1];
#pragma unroll
      for (int r = 2; r < 16; ++r) sacc += pB0[r];
#pragma unroll
      for (int r = 0; r < 16; ++r) sacc += pB1[r];
      l_reg += sacc;
      pw0 = (u32x4_t){PKW(pB0, 0), PKW(pB0, 2), PKW(pB0, 4), PKW(pB0, 6)}; pw1 = (u32x4_t){PKW(pB0, 8), PKW(pB0, 10), PKW(pB0, 12), PKW(pB0, 14)};
      pw2 = (u32x4_t){PKW(pB1, 0), PKW(pB1, 2), PKW(pB1, 4), PKW(pB1, 6)}; pw3 = (u32x4_t){PKW(pB1, 8), PKW(pB1, 10), PKW(pB1, 12), PKW(pB1, 14)};
      const lds_cptr vp_ = vp0 + 2 * sl_cur;
#define DR4(ks, PA) do { VRD(0, 4 * (ks)); VRD(1, 4 * (ks) + 1); VRD(2, 4 * (ks) + 2); VRD(3, 4 * (ks) + 3); \
      o[0] = MFMA_(__builtin_bit_cast(bf16x8, PA), VFR(0), o[0]); o[1] = MFMA_(__builtin_bit_cast(bf16x8, PA), VFR(1), o[1]); \
      o[2] = MFMA_(__builtin_bit_cast(bf16x8, PA), VFR(2), o[2]); o[3] = MFMA_(__builtin_bit_cast(bf16x8, PA), VFR(3), o[3]); } while (0)
      DR4(0, pw0); DR4(1, pw1); DR4(2, pw2); DR4(3, pw3);
#undef DR4
    }
    { auto rr = __builtin_amdgcn_permlane32_swap(__float_as_uint(l_reg), __float_as_uint(l_reg), false, false); l_reg = __uint_as_float(rr[0]) + __uint_as_float(rr[1]); }
    if (hi == 0) wsf[32 + r32] = l_reg; asm volatile("s_waitcnt lgkmcnt(0)" ::: "memory");
#pragma unroll
    for (int r = 0; r < 16; ++r) { const float rl = __builtin_amdgcn_rcpf(wsf[32 + crow(r, hi)]);
#pragma unroll
        for (int d = 0; d < 4; ++d) o[d][r] *= rl; }
#undef DMA_K
#undef DMA_V
#undef ROT
#undef MFMA_
#undef EX
#undef RESC3
#undef PKW
#undef VFR
#undef VRD
#undef KRD
#undef GAPA
#undef GAPB
#undef NORD
#undef STEP
#undef ENDW
}

constexpr int B3_V = 0, B3_K = 49152, B3_WS = 98304, B3_RPB = 100352;
static_assert(B3_RPB + 2048 <= RING_BYTES, "attention LDS map (B ring-3)");
#ifndef B_SMSPLIT
#define B_SMSPLIT 1
#endif
__device__ __forceinline__ void attn_b3(LAS unsigned char* lds, const UnitD& ud, const ModeP& mp, f32x16 (&o)[4], int tid) {
    constexpr int DK = 128;
    const int wid = __builtin_amdgcn_readfirstlane(tid >> 6), lane = tid & 63, r32 = lane & 31, hi = lane >> 5;
    LAS unsigned char* Vl = lds + B3_V; LAS unsigned char* Kl = lds + B3_K; const unsigned lds0 = (unsigned)(unsigned long)lds;
    LAS float* wsf = (LAS float*)(lds + B3_WS) + wid * 64; LAS float* li_l = wsf; LAS float* al_l = wsf + 32;
    const LAS float* rtab = (const LAS float*)(lds + B3_RPB);
    float m_reg = -1e30f, l_reg = 0.f;
#pragma unroll
    for (int d = 0; d < 4; ++d) o[d] = f32x16{};
    bf16x8 qr[DK / 16];
    { const bf16* Qw = ud.Q + (size_t)(wid * 32 + r32) * LDP + hi * 8;
#pragma unroll
      for (int d0 = 0; d0 < DK / 16; ++d0) qr[d0] = *(const bf16x8*)(Qw + d0 * 16); }
    const int vb0 = (int)(unsigned)(unsigned long)Vl + v_rd_base(lane);
    const int qc = 32 * (wid & 1) + r32, qrow = mp.qr0 + (wid >> 1), rs = min(max(qrow - 4, 0), 24), cst = min(max(qc - 8, 0), 48);
    const int krow = 4 * wid + (lane >> 4);
    const bf16* ksrc = ud.K + (size_t)krow * LDP + (((lane & 15) ^ (krow & 15)) * 8);
    const int bl = 2 * wid + (lane >> 5), kk = (bl >> 2) * 8 + ((lane & 31) >> 2), vk = (kk & ~0xC) | ((kk & 4) << 1) | ((kk & 8) >> 1);
    const bf16* vsrc = ud.V + (size_t)vk * LDP + (bl & 3) * 32 + (lane & 3) * 8;
    const unsigned kdst = lds0 + B3_K + wid * 1024, vdst = lds0 + B3_V + wid * 1024;
#define TROW(j_) (ud.row_base + 64 * ((j_) < 4 ? (j_) : ud.off + min((j_) - 4, ud.cap)))
#define DMA_T(j_, sl) do { const size_t ro_ = (size_t)TROW(j_) * LDP; const unsigned ks_ = (unsigned)__builtin_amdgcn_readfirstlane((int)(kdst + (sl))), vs_ = (unsigned)__builtin_amdgcn_readfirstlane((int)(vdst + (sl))); \
        glds16(ksrc + ro_, ks_); glds16(ksrc + ro_ + (size_t)32 * LDP, ks_ + 8192); glds16(vsrc + ro_, vs_); glds16(vsrc + ro_ + (size_t)32 * LDP, vs_ + 8192); } while (0)
#define WAIT0_BAR() asm volatile("s_waitcnt vmcnt(0) lgkmcnt(0)\n\ts_barrier" ::: "memory")
#define ROT() do { sp = sc; sc = sn; sn = (sn == 32768) ? 0 : sn + 16384; } while (0)
#define RESC(a) do { if (__any((a) < 1.f)) { if (hi == 0) al_l[r32] = (a); asm volatile("s_waitcnt lgkmcnt(0)" ::: "memory"); \
        _Pragma("unroll") for (int d = 0; d < 4; ++d) _Pragma("unroll") for (int r = 0; r < 16; ++r) o[d][r] *= al_l[crow(r, hi)]; } } while (0)
#define MASK(P0, P1, j_) do { if (!mp.plain && (j_) >= 4) b_mask(P0, P1, (j_), rtab, mp.kr0, mp.nkr, qrow, rs, qc, cst, hi); } while (0)
#if B_SMSPLIT
#define PVP1(VB, P0, P1, j_, MN, AL) do { MASK(P0, P1, j_); pv_sm(o, (VB), pa0, pa1, pa2, pa3, P0, P1, m_reg, MN, AL); } while (0)
#else
#define PVP1(VB, P0, P1, j_, MN, AL) do { pv_d0(o, (VB), pa0, pa1, pa2, pa3); MASK(P0, P1, j_); sm_part(P0, P1, m_reg, MN, AL); } while (0)
#endif
    f32x16 pA0, pA1, pB0, pB1; float mnA, mnB, alA, alB; bf16x8 pa0, pa1, pa2, pa3; const int NT = ud.NT;
    int sp = 0, sc = 0, sn = 16384;
    __syncthreads();
    if (!mp.plain) { if (tid < 465) ((LAS float*)(lds + B3_RPB))[tid] = mp.rpb[tid] * LOG2E; }
    DMA_T(0, 0); WAIT0_BAR();
    DMA_T(1, sn);
    qkt<DK>(pA0, pA1, Kl, qr, r32, hi); MASK(pA0, pA1, 0); sm_part(pA0, pA1, m_reg, mnA, alA);
    WAIT0_BAR(); ROT();
    for (int j = 1; j + 1 < NT; j += 2) {
        DMA_T(j + 1, sn);
        SBAR(); qkt<DK>(pB0, pB1, Kl + sc, qr, r32, hi);
        sm_fin(pA0, pA1, alA, l_reg, pa0, pa1, pa2, pa3); SBAR();
        PVP1(vb0 + sp, pB0, pB1, j, mnB, alB);
        WAIT0_BAR(); RESC(alB); ROT();
        if (j + 2 < NT) DMA_T(j + 2, sn);
        SBAR(); qkt<DK>(pA0, pA1, Kl + sc, qr, r32, hi);
        sm_fin(pB0, pB1, alB, l_reg, pa0, pa1, pa2, pa3); SBAR();
        PVP1(vb0 + sp, pA0, pA1, j + 1, mnA, alA);
        WAIT0_BAR(); RESC(alA); ROT();
    }
    SBAR(); qkt<DK>(pB0, pB1, Kl + sc, qr, r32, hi);
    sm_fin(pA0, pA1, alA, l_reg, pa0, pa1, pa2, pa3); SBAR();
    PVP1(vb0 + sp, pB0, pB1, NT - 1, mnB, alB);
    RESC(alB);
    sm_fin(pB0, pB1, alB, l_reg, pa0, pa1, pa2, pa3); SBAR();
    pv_d0(o, vb0 + sc, pa0, pa1, pa2, pa3);
    { if (hi == 0) li_l[r32] = l_reg; asm volatile("s_waitcnt lgkmcnt(0)" ::: "memory");
#pragma unroll
      for (int r = 0; r < 16; ++r) { const float rl = __builtin_amdgcn_rcpf(li_l[crow(r, hi)]);
#pragma unroll
          for (int d = 0; d < 4; ++d) o[d][r] *= rl; } }
    (void)mnA; (void)mnB;
#undef TROW
#undef DMA_T
#undef WAIT0_BAR
#undef ROT
#undef RESC
#undef MASK
#undef PVP1
}

constexpr int B4_K = 0, B4_V = 49152, B4_WS = 98304, B4_RPB = 100352;
static_assert(B4_RPB + 2048 <= RING_BYTES, "attention LDS map (B4)");
#ifndef B_STEP4
#define B_STEP4 1
#endif
__device__ __forceinline__ void attn_b4(LAS unsigned char* lds, const UnitD& ud, const ModeP& mp, f32x16 (&o)[4], int tid) {
    const int lane = tid & 63, r32 = lane & 31, hi = lane >> 5; const int wid = __builtin_amdgcn_readfirstlane(tid >> 6);
    const unsigned lds0 = (unsigned)(unsigned long)lds; LAS float* wsf = (LAS float*)(lds + B4_WS) + wid * 64;
    const LAS float* rtab = (const LAS float*)(lds + B4_RPB);
    const int qc = 32 * (wid & 1) + r32, qrow = mp.qr0 + (wid >> 1), rs = min(max(qrow - 4, 0), 24), cst = min(max(qc - 8, 0), 48);
    const unsigned koff = (unsigned)(((size_t)lane * LDP + wid * 8) * 2);
    const unsigned voff = (unsigned)(((size_t)(16 * (wid & 3) + (lane >> 2)) * LDP + (wid >> 2) * 32 + (lane & 3) * 8) * 2);
    const unsigned kdst = lds0 + B4_K + wid * 1024, vdst = lds0 + B4_V + wid * 1024;
#define TROW(j_) (ud.row_base + 64 * ((j_) < 4 ? (j_) : ud.off + min((j_) - 4, ud.cap)))
#define DMA_K(j_, sl) do { const bf16* k_ = ud.K + (size_t)TROW(j_) * LDP; const unsigned d_ = (unsigned)__builtin_amdgcn_readfirstlane((int)(kdst + (sl))); glds16s(k_, koff, d_); glds16s(k_ + 64, koff, d_ + 8192); } while (0)
#define DMA_V(j_, sl) do { const bf16* v_ = ud.V + (size_t)TROW(j_) * LDP; const unsigned d_ = (unsigned)__builtin_amdgcn_readfirstlane((int)(vdst + (sl))); glds16s(v_, voff, d_); glds16s(v_ + 64, voff, d_ + 8192); } while (0)
    const lds_cptr vp0 = (lds_cptr)lds + B4_V + ((lane >> 4) & 1) * 32 + (lane & 3) * 8 + (4 * hi + ((lane & 15) >> 2)) * 64;
    const lds_cptr kp0 = (lds_cptr)lds + B4_K + hi * 1024 + r32 * 16;
    __syncthreads();
    DMA_K(0, 0); DMA_V(0, 0); DMA_K(1, 16384); DMA_K(2, 32768);
    bf16x8 qr[8];
    { const bf16* Qw = ud.Q + (size_t)(wid * 32 + r32) * LDP + hi * 8;
#pragma unroll
      for (int d0 = 0; d0 < 8; ++d0) qr[d0] = *(const bf16x8*)(Qw + d0 * 16); }
    if (!mp.plain) { if (tid < 465) ((LAS float*)(lds + B4_RPB))[tid] = mp.rpb[tid] * LOG2E; }
    float mhat = 0.f, l_reg = 0.f;
#pragma unroll
    for (int d = 0; d < 4; ++d) o[d] = f32x16{};
    bool resc = false; const int NT = ud.NT;
    f32x16 pA0, pA1, pB0, pB1; bf16x8 kfr[4]; s16x4 vlo[4], vhi[4]; u32x4_t pw0, pw1, pw2, pw3;
    int sl_prev = 0, sl_cur = 0, sl_next = 16384;
#define ROT() do { sl_prev = sl_cur; sl_cur = sl_next; sl_next = (sl_next == 32768) ? 0 : sl_next + 16384; } while (0)
#define MFMA_(a, b, c) __builtin_amdgcn_mfma_f32_32x32x16_bf16(a, b, c, 0, 0, 0)
#define KF1(s, kp, g) kfr[s] = *(const LAS bf16x8*)((kp) + ((g) >> 1) * 2048 + ((g) & 1) * 512)
#define EX(v) __builtin_amdgcn_exp2f((v) + nmh)
#define RESC4() do { if (resc) { _Pragma("unroll") for (int d_ = 0; d_ < 4; ++d_) _Pragma("unroll") for (int r = 0; r < 16; ++r) o[d_][r] *= wsf[crow(r, hi)]; } } while (0)
#define WAIT0_BAR() asm volatile("s_waitcnt vmcnt(0) lgkmcnt(0)\n\ts_barrier" ::: "memory")
    WAIT0_BAR();
    pA0 = f32x16{}; pA1 = f32x16{};
#pragma unroll
    for (int g = 0; g < 16; g += 2) { KF1(0, kp0, g); KF1(1, kp0, g + 1); pA0 = MFMA_(kfr[0], qr[g >> 1], pA0); pA1 = MFMA_(kfr[1], qr[g >> 1], pA1); }
    { mhat = rowmax3(pA0, pA1); const float nmh = -mhat;
#pragma unroll
      for (int r = 0; r < 16; ++r) { pA0[r] = EX(pA0[r]); pA1[r] = EX(pA1[r]); } }
    asm volatile("s_waitcnt lgkmcnt(0)\n\ts_barrier" ::: "memory");
    DMA_V(1, 16384); ROT();
    KF1(0, kp0 + sl_cur, 0); KF1(1, kp0 + sl_cur, 1); KF1(2, kp0 + sl_cur, 2); KF1(3, kp0 + sl_cur, 3);
#define PKW(P, i) cvt_pk_bf16(P[i], P[i + 1])
#define VFR(s) (bf16x8){vlo[s][0], vlo[s][1], vlo[s][2], vlo[s][3], vhi[s][0], vhi[s][1], vhi[s][2], vhi[s][3]}
#define VRD(s, g) do { vlo[s] = vtr(vp_ + (((g) & 3) * 4096 + ((g) >> 2) * 1024)); vhi[s] = vtr(vp_ + (((g) & 3) * 4096 + ((g) >> 2) * 1024 + 512)); } while (0)
#define GA(g, CD, CS, a0, a1, W, PW, RD) do { CD = MFMA_(kfr[(g) & 3], qr[(g) >> 1], CS); RD; sacc += a0; sacc += a1; W; A3_PIN(PW); A3_PIN(sacc); SBAR(); } while (0)
#define GB(g, PA, X, i, RD) do { o[(g) & 3] = MFMA_(__builtin_bit_cast(bf16x8, PA), VFR((g) & 3), o[(g) & 3]); RD; X[i] = EX(X[i]); X[i + 1] = EX(X[i + 1]); A3_PIN(X); SBAR(); } while (0)
#define KNX(G, s) do { if (G) KF1(s, kp0 + sl_next, s); } while (0)
#define STEPB(C0, C1, P0, P1, t, GK, GV, GL) do { SBAR(); \
    const lds_cptr vp_ = vp0 + sl_prev; const lds_cptr kq_ = kp0 + sl_cur; float sacc = P0[0] + P0[1]; \
    GA(0,  C0, f32x16{}, P0[2],  P0[3],  pw0[0] = PKW(P0, 0),  pw0, KF1(0, kq_, 4)); \
    GA(1,  C1, f32x16{}, P0[4],  P0[5],  pw0[1] = PKW(P0, 2),  pw0, KF1(1, kq_, 5)); \
    GA(2,  C0, C0,       P0[6],  P0[7],  pw0[2] = PKW(P0, 4),  pw0, KF1(2, kq_, 6)); \
    GA(3,  C1, C1,       P0[8],  P0[9],  pw0[3] = PKW(P0, 6),  pw0, KF1(3, kq_, 7)); \
    GA(4,  C0, C0,       P0[10], P0[11], pw1[0] = PKW(P0, 8),  pw1, KF1(0, kq_, 8)); \
    GA(5,  C1, C1,       P0[12], P0[13], pw1[1] = PKW(P0, 10), pw1, KF1(1, kq_, 9)); \
    GA(6,  C0, C0,       P0[14], P0[15], pw1[2] = PKW(P0, 12), pw1, KF1(2, kq_, 10)); \
    GA(7,  C1, C1,       P1[0],  P1[1],  pw1[3] = PKW(P0, 14), pw1, KF1(3, kq_, 11)); \
    GA(8,  C0, C0,       P1[2],  P1[3],  pw2[0] = PKW(P1, 0),  pw2, KF1(0, kq_, 12)); \
    GA(9,  C1, C1,       P1[4],  P1[5],  pw2[1] = PKW(P1, 2),  pw2, KF1(1, kq_, 13)); \
    GA(10, C0, C0,       P1[6],  P1[7],  pw2[2] = PKW(P1, 4),  pw2, KF1(2, kq_, 14)); \
    GA(11, C1, C1,       P1[8],  P1[9],  pw2[3] = PKW(P1, 6),  pw2, KF1(3, kq_, 15)); \
    GA(12, C0, C0,       P1[10], P1[11], pw3[0] = PKW(P1, 8),  pw3, VRD(0, 0)); \
    GA(13, C1, C1,       P1[12], P1[13], pw3[1] = PKW(P1, 10), pw3, VRD(1, 1)); \
    GA(14, C0, C0,       P1[14], P1[15], pw3[2] = PKW(P1, 12), pw3, VRD(2, 2)); \
    GA(15, C1, C1,       0.f,    0.f,    pw3[3] = PKW(P1, 14), pw3, VRD(3, 3)); \
    l_reg += sacc; \
    if (GK) DMA_K((t) + 2, sl_prev); if (GV) DMA_V((t) + 1, sl_next);                                                      \
    if (!mp.plain && (t) >= 4) b_mask(C0, C1, (t), rtab, mp.kr0, mp.nkr, qrow, rs, qc, cst, hi); \
    { const float rm = rowmax3(C0, C1) - mhat; resc = false;                                                               \
      if (__builtin_expect(__any(rm > THR2), 0)) { const float dl = fmaxf(rm, 0.f); mhat += dl;                            \
          const float f = __builtin_amdgcn_exp2f(-dl); l_reg *= f; if (hi == 0) wsf[r32] = f; resc = true; } } \
    const float nmh = -mhat; SBAR(); \
    GB(0,  pw0, C0, 0,  VRD(0, 4));  GB(1,  pw0, C0, 2,  VRD(1, 5));  GB(2,  pw0, C0, 4,  VRD(2, 6));  GB(3,  pw0, C0, 6,  VRD(3, 7)); \
    GB(4,  pw1, C0, 8,  VRD(0, 8));  GB(5,  pw1, C0, 10, VRD(1, 9));  GB(6,  pw1, C0, 12, VRD(2, 10)); GB(7,  pw1, C0, 14, VRD(3, 11)); \
    GB(8,  pw2, C1, 0,  VRD(0, 12)); GB(9,  pw2, C1, 2,  VRD(1, 13)); GB(10, pw2, C1, 4,  VRD(2, 14)); GB(11, pw2, C1, 6,  VRD(3, 15)); \
    GB(12, pw3, C1, 8,  KNX(GL, 0)); GB(13, pw3, C1, 10, KNX(GL, 1)); GB(14, pw3, C1, 12, KNX(GL, 2)); GB(15, pw3, C1, 14, KNX(GL, 3)); \
    } while (0)
#define ACT(j_) (mp.plain || (j_) < 4 || (((j_) - 4 < mp.nkr) && (mp.kr0 + (j_) - 4 >= rs) && (mp.kr0 + (j_) - 4 < rs + 8)))
#define STEPI(C0, C1, t, GK, GV, GL) do { if (GK) DMA_K((t) + 2, sl_prev); if (GV) DMA_V((t) + 1, sl_next); resc = false; C0 = f32x16{}; C1 = f32x16{}; \
    if ((GL) && ACT((t) + 1)) { KF1(0, kp0 + sl_next, 0); KF1(1, kp0 + sl_next, 1); KF1(2, kp0 + sl_next, 2); KF1(3, kp0 + sl_next, 3); } } while (0)
#define STEPX(C0, C1, P0, P1, t, GK, GV, GL) do { if (ACT(t) || ACT((t) - 1)) STEPB(C0, C1, P0, P1, t, GK, GV, GL); else STEPI(C0, C1, t, GK, GV, GL); } while (0)
    int t = 1;
    for (; t + 3 < NT; t += 2) {
        STEPX(pB0, pB1, pA0, pA1, t, true, true, true);     WAIT0_BAR(); RESC4(); ROT();
        STEPX(pA0, pA1, pB0, pB1, t + 1, true, true, true); WAIT0_BAR(); RESC4(); ROT();
    }
    for (; t + 1 < NT; t += 2) {
        STEPX(pB0, pB1, pA0, pA1, t, (t + 2 < NT), (t + 1 < NT), (t + 1 < NT));         WAIT0_BAR(); RESC4(); ROT();
        STEPX(pA0, pA1, pB0, pB1, t + 1, (t + 3 < NT), (t + 2 < NT), (t + 2 < NT));     WAIT0_BAR(); RESC4(); ROT();
    }
    STEPX(pB0, pB1, pA0, pA1, NT - 1, false, false, false); RESC4();
    if (ACT(NT - 1)) { float sacc = pB0[0] + pB0[1];
#pragma unroll
      for (int r = 2; r < 16; ++r) sacc += pB0[r];
#pragma unroll
      for (int r = 0; r < 16; ++r) sacc += pB1[r];
      l_reg += sacc;
      pw0 = (u32x4_t){PKW(pB0, 0), PKW(pB0, 2), PKW(pB0, 4), PKW(pB0, 6)}; pw1 = (u32x4_t){PKW(pB0, 8), PKW(pB0, 10), PKW(pB0, 12), PKW(pB0, 14)};
      pw2 = (u32x4_t){PKW(pB1, 0), PKW(pB1, 2), PKW(pB1, 4), PKW(pB1, 6)}; pw3 = (u32x4_t){PKW(pB1, 8), PKW(pB1, 10), PKW(pB1, 12), PKW(pB1, 14)};
      const lds_cptr vp_ = vp0 + sl_cur;
#define DR4(ks, PA) do { VRD(0, 4 * (ks)); VRD(1, 4 * (ks) + 1); VRD(2, 4 * (ks) + 2); VRD(3, 4 * (ks) + 3); \
      o[0] = MFMA_(__builtin_bit_cast(bf16x8, PA), VFR(0), o[0]); o[1] = MFMA_(__builtin_bit_cast(bf16x8, PA), VFR(1), o[1]); \
      o[2] = MFMA_(__builtin_bit_cast(bf16x8, PA), VFR(2), o[2]); o[3] = MFMA_(__builtin_bit_cast(bf16x8, PA), VFR(3), o[3]); } while (0)
      DR4(0, pw0); DR4(1, pw1); DR4(2, pw2); DR4(3, pw3);
#undef DR4
    }
    { auto rr = __builtin_amdgcn_permlane32_swap(__float_as_uint(l_reg), __float_as_uint(l_reg), false, false); l_reg = __uint_as_float(rr[0]) + __uint_as_float(rr[1]); }
    if (hi == 0) wsf[32 + r32] = l_reg; asm volatile("s_waitcnt lgkmcnt(0)" ::: "memory");
#pragma unroll
    for (int r = 0; r < 16; ++r) { const float rl = __builtin_amdgcn_rcpf(wsf[32 + crow(r, hi)]);
#pragma unroll
        for (int d = 0; d < 4; ++d) o[d][r] *= rl; }
#undef TROW
#undef DMA_K
#undef DMA_V
#undef ROT
#undef MFMA_
#undef KF1
#undef EX
#undef RESC4
#undef WAIT0_BAR
#undef PKW
#undef VFR
#undef VRD
#undef GA
#undef GB
#undef KNX
#undef STEPB
#undef STEPI
#undef STEPX
#undef ACT
}

template <int KIND>
__device__ __forceinline__ void attn_epi(LAS unsigned char* lds, const f32x16 (&o)[4], int tid, int grow0, bf16* OUT, int ocol, const float* gw, float cm, const bf16* CG) {
    const int wid = __builtin_amdgcn_readfirstlane(tid >> 6), lane = tid & 63, r32 = lane & 31, hi = lane >> 5;
    __syncthreads();
    LAS float* Ow = (LAS float*)(lds + wid * L_OEPI);
#pragma unroll
    for (int d = 0; d < 4; ++d)
#pragma unroll
        for (int r = 0; r < 16; ++r) Ow[crow(r, hi) * 132 + d * 32 + r32] = o[d][r];
    asm volatile("s_waitcnt lgkmcnt(0)" ::: "memory");
    const int row = lane >> 1, half = lane & 1; const size_t grow = (size_t)(grow0 + wid * 32 + row);
    f32x4 x[16]; float ss = 0.f;
#pragma unroll
    for (int i = 0; i < 16; ++i) { x[i] = *(const LAS f32x4*)(Ow + row * 132 + half * 64 + 4 * i); ss += (x[i][0] * x[i][0] + x[i][1] * x[i][1]) + (x[i][2] * x[i][2] + x[i][3] * x[i][3]); }
    if constexpr (KIND != 1) {
        ss += swz_xor<1>(ss);
        const float rstd = 1.0f / sqrtf(ss * (1.0f / 128.0f) + EPS) * cm;
#pragma unroll
        for (int i = 0; i < 16; ++i) x[i] = x[i] * rstd * *(const f32x4*)(gw + half * 64 + 4 * i);
    }
    if constexpr (KIND == 2) {
        const v4u* cg = (const v4u*)(CG + grow * LDP + half * 64);
#pragma unroll
        for (int i = 0; i < 8; ++i) { const v4u g = cg[i];
            x[2 * i][0] *= silu_f(bflo(g.x)); x[2 * i][1] *= silu_f(bfhi(g.x)); x[2 * i][2] *= silu_f(bflo(g.y)); x[2 * i][3] *= silu_f(bfhi(g.y));
            x[2 * i + 1][0] *= silu_f(bflo(g.z)); x[2 * i + 1][1] *= silu_f(bfhi(g.z)); x[2 * i + 1][2] *= silu_f(bflo(g.w)); x[2 * i + 1][3] *= silu_f(bfhi(g.w)); }
    }
    v4u* op = (v4u*)(OUT + grow * 1024 + ocol + half * 64);
#pragma unroll
    for (int i = 0; i < 8; ++i) { v4u w; w.x = cvt_pk_bf16(x[2 * i][0], x[2 * i][1]); w.y = cvt_pk_bf16(x[2 * i][2], x[2 * i][3]); w.z = cvt_pk_bf16(x[2 * i + 1][0], x[2 * i + 1][1]); w.w = cvt_pk_bf16(x[2 * i + 1][2], x[2 * i + 1][3]); op[i] = w; }
}

constexpr int CST_K = 0, CST_VF = 16384, CST_VB = 32768;
__device__ __forceinline__ bf16x8 trfrag(int vb, int off) { s16x4 l, h; asm volatile("ds_read_b64_tr_b16 %0, %1" : "=&v"(l) : "v"(vb + off) : "memory"); asm volatile("ds_read_b64_tr_b16 %0, %1" : "=&v"(h) : "v"(vb + off + 2048) : "memory");
    return (bf16x8){l[0], l[1], l[2], l[3], h[0], h[1], h[2], h[3]}; }
__device__ __forceinline__ bf16x8 scale_frag(bf16x8 q, float f) { const v4u w = __builtin_bit_cast(v4u, q); v4u o;
    o.x = cvt_pk_bf16(bflo(w.x) * f, bfhi(w.x) * f); o.y = cvt_pk_bf16(bflo(w.y) * f, bfhi(w.y) * f); o.z = cvt_pk_bf16(bflo(w.z) * f, bfhi(w.z) * f); o.w = cvt_pk_bf16(bflo(w.w) * f, bfhi(w.w) * f);
    return __builtin_bit_cast(bf16x8, o); }
__device__ __forceinline__ void c_state_item(LAS unsigned char* lds, const bf16* K, const bf16* V, int row0, float lf, float lb, float* UO, int tid) {
    const int wid = __builtin_amdgcn_readfirstlane(tid >> 6), lane = tid & 63, r32 = lane & 31, hi = lane >> 5;
    const int sr = tid >> 4, sc = (tid & 15) * 8, kr64 = tid >> 3, kc64 = (tid & 7) * 8;
    const int dkh = wid >> 2, dvq = wid & 3;
    const int vbK = (int)(unsigned)(unsigned long)(lds + CST_K) + v_rd_base(lane), vbF = (int)(unsigned)(unsigned long)(lds + CST_VF) + v_rd_base(lane), vbB = (int)(unsigned)(unsigned long)(lds + CST_VB) + v_rd_base(lane);
    f32x16 aF = f32x16{}, aB = f32x16{};
    for (int t = 0; t < 4; ++t) {
        const bf16x8 kk = *(const bf16x8*)(K + (size_t)(row0 + 64 * t + kr64) * LDP + kc64);
        const bf16x8 v0 = *(const bf16x8*)(V + (size_t)(row0 + 64 * t + sr) * LDP + sc), v1 = *(const bf16x8*)(V + (size_t)(row0 + 64 * t + 32 + sr) * LDP + sc);
        const float j0 = (float)(64 * t + sr), j1 = j0 + 32.f;
        const float f0 = __builtin_amdgcn_exp2f(lf * (255.f - j0)), f1 = __builtin_amdgcn_exp2f(lf * (255.f - j1)), b0 = __builtin_amdgcn_exp2f(lb * j0), b1 = __builtin_amdgcn_exp2f(lb * j1);
        __syncthreads();
        *(LAS bf16x8*)(lds + CST_K + v_st(kr64, kc64)) = kk;
        *(LAS bf16x8*)(lds + CST_VF + v_st(sr, sc)) = scale_frag(v0, f0); *(LAS bf16x8*)(lds + CST_VF + v_st(32 + sr, sc)) = scale_frag(v1, f1);
        *(LAS bf16x8*)(lds + CST_VB + v_st(sr, sc)) = scale_frag(v0, b0); *(LAS bf16x8*)(lds + CST_VB + v_st(32 + sr, sc)) = scale_frag(v1, b1);
        __syncthreads();
#pragma unroll
        for (int ks = 0; ks < 4; ++ks) {
            const bf16x8 a = trfrag(vbK, v_rd_off(dkh, ks, 0)), bf = trfrag(vbF, v_rd_off(dvq, ks, 0)), bb = trfrag(vbB, v_rd_off(dvq, ks, 0));
            asm volatile("s_waitcnt lgkmcnt(0)" ::: "memory"); SBAR();
            aF = __builtin_amdgcn_mfma_f32_32x32x16_bf16(a, bf, aF, 0, 0, 0);
            aB = __builtin_amdgcn_mfma_f32_32x32x16_bf16(a, bb, aB, 0, 0, 0);
        }
    }
    float* o0 = UO + (size_t)(32 * dkh) * 128 + 32 * dvq + r32;
#pragma unroll
    for (int r = 0; r < 16; ++r) { o0[(size_t)crow(r, hi) * 128] = aF[r]; o0[8192 + (size_t)crow(r, hi) * 128] = aB[r]; }
    __syncthreads();
}
__device__ __forceinline__ void c_build_states(LAS unsigned char* lds, const float* UBH, int c, float lf, float lb, int tid) {
    const int d = tid >> 3, c0 = (tid & 7) * 16;
    f32x4 sf[4], sb[4];
#pragma unroll
    for (int q = 0; q < 4; ++q) { sf[q] = (f32x4){0.f, 0.f, 0.f, 0.f}; sb[q] = (f32x4){0.f, 0.f, 0.f, 0.f}; }
#pragma unroll
    for (int g = 0; g < 3; ++g) {
        f32x4 x[3][4]; float wf[3], wb[3];
#pragma unroll
        for (int u = 0; u < 3; ++u) { const int cp = 3 * g + u; const bool fw = cp < c;
            const float w = (cp == c) ? 0.f : fw ? __builtin_amdgcn_exp2f(lf * (float)(256 * (c - cp) - 255)) : __builtin_amdgcn_exp2f(lb * (float)(256 * (cp - c) - 255));
            wf[u] = fw ? w : 0.f; wb[u] = fw ? 0.f : w;
            const f32x4* src = (const f32x4*)(UBH + ((size_t)cp * 2 + (fw ? 0 : 1)) * 8192 + (size_t)d * 128 + c0);
#pragma unroll
            for (int q = 0; q < 4; ++q) x[u][q] = src[q]; }
#pragma unroll
        for (int u = 0; u < 3; ++u)
#pragma unroll
            for (int q = 0; q < 4; ++q) { sf[q] += x[u][q] * wf[u]; sb[q] += x[u][q] * wb[u]; }
    }
    { const float w = __builtin_amdgcn_exp2f(lb * (float)(2049 - 256 * c));
      const f32x4* src = (const f32x4*)(UBH + (size_t)1 * 8192 + (size_t)d * 128 + c0);
#pragma unroll
      for (int q = 0; q < 4; ++q) sb[q] += src[q] * w; }
#pragma unroll
    for (int half = 0; half < 2; ++half) {
        v4u wf, wb; wf.x = cvt_pk_bf16(sf[2 * half][0], sf[2 * half][1]); wf.y = cvt_pk_bf16(sf[2 * half][2], sf[2 * half][3]); wf.z = cvt_pk_bf16(sf[2 * half + 1][0], sf[2 * half + 1][1]); wf.w = cvt_pk_bf16(sf[2 * half + 1][2], sf[2 * half + 1][3]);
        wb.x = cvt_pk_bf16(sb[2 * half][0], sb[2 * half][1]); wb.y = cvt_pk_bf16(sb[2 * half][2], sb[2 * half][3]); wb.z = cvt_pk_bf16(sb[2 * half + 1][0], sb[2 * half + 1][1]); wb.w = cvt_pk_bf16(sb[2 * half + 1][2], sb[2 * half + 1][3]);
        *(LAS v4u*)(lds + L_STASH + v_st(d, c0 + 8 * half)) = wf; *(LAS v4u*)(lds + L_STASH + 16384 + v_st(d, c0 + 8 * half)) = wb; }
}
__device__ __forceinline__ void c_state_steps(LAS unsigned char* lds, const bf16* Q, float lf, float lb, f32x16 (&o)[4], int tid) {
    const int wid = __builtin_amdgcn_readfirstlane(tid >> 6), lane = tid & 63, r32 = lane & 31, hi = lane >> 5;
    const float il = (float)(wid * 32 + r32), ff = __builtin_amdgcn_exp2f(lf * il), fb = __builtin_amdgcn_exp2f(lb * (255.f - il));
    const bf16* Qw = Q + (size_t)(wid * 32 + r32) * LDP + hi * 8;
    bf16x8 q0 = *(const bf16x8*)(Qw), q1 = *(const bf16x8*)(Qw + 16), q2 = *(const bf16x8*)(Qw + 32), q3 = *(const bf16x8*)(Qw + 48);
    const int vbF = (int)(unsigned)(unsigned long)(lds + L_STASH) + v_rd_base(lane);
    pv_d0(o, vbF, scale_frag(q0, ff), scale_frag(q1, ff), scale_frag(q2, ff), scale_frag(q3, ff));
    pv_d0(o, vbF + 16384, scale_frag(q0, fb), scale_frag(q1, fb), scale_frag(q2, fb), scale_frag(q3, fb));
}
}

__device__ __forceinline__ void mix_simple(int l, const bf16* P, bf16* OA, bf16* OB, bf16* YR, const float* dlam, const float* dnorm, const float* rpb, const float* rdecay,
                                           const float* rnorm, float lam_init, LAS float* buf, int gw, int NGW, int lane, int modemask) {
    float lam;
    { const float v = dlam[lane] * dlam[64 + lane], w = dlam[128 + lane] * dlam[192 + lane]; lam = expf(wave_sum(v)) - expf(wave_sum(w)) + lam_init; }
    for (int it = gw; it < 3 * R * 8; it += NGW) {
        const int mode = it / (R * 8), rem = it - mode * (R * 8);
        if (!((modemask >> mode) & 1)) continue;
        const int b = rem / (8 * SB), h = (rem / SB) & 7, s = rem % SB;
        const bool cq = s < CTXL; if (cq && l == 1) continue;
        const int row = b * SB + s; const bf16* Pb = P + (size_t)b * SB * INC; const bf16* Prow = P + (size_t)row * INC;
        if (mode == 0) {
            const int nk = cq ? CTXL : SB; float oa0 = 0.f, oa1 = 0.f;
            for (int map = 0; map < 2; ++map) {
                float q[64]; load_q<64>(q, Prow + C_AQ + h * 128 + map * 64);
                float mx = -INFINITY;
                for (int j = lane; j < nk; j += 64) { const float sc = dot_q<64>(q, Pb + (size_t)j * INC + C_AK + h * 128 + map * 64); buf[j] = sc; mx = fmaxf(mx, sc); }
                const float inv = softmax_buf(buf, nk, mx, lane);
                float a0 = 0.f, a1 = 0.f; const bf16* vb = Pb + C_AV + h * 128 + lane;
#pragma unroll 8
                for (int j = 0; j < nk; ++j) { const float p = buf[j]; a0 += p * bf1(vb[(size_t)j * INC]); a1 += p * bf1(vb[(size_t)j * INC + 64]); }
                a0 *= inv; a1 *= inv;
                if (map == 0) { oa0 = a0; oa1 = a1; } else { oa0 -= lam * a0; oa1 -= lam * a1; }
                LDS_WAIT(); asm volatile("" ::: "memory");
            }
            const float rstd = 1.0f / sqrtf(wave_sum(oa0 * oa0 + oa1 * oa1) * (1.0f / 128.0f) + EPS), cm = 1.0f - lam_init;
            bf16* op = OA + (size_t)row * 1024 + h * 128 + lane;
            op[0] = (bf16)f2bf(oa0 * rstd * dnorm[lane] * cm); op[64] = (bf16)f2bf(oa1 * rstd * dnorm[64 + lane] * cm);
        } else if (mode == 1) {
            float q[128]; load_q<128>(q, Prow + C_BQ + h * 128);
            float mx = -INFINITY; int nk = CTXL, r = 0, qc = 0, rs = 0, cs = 0;
            for (int j = lane; j < CTXL; j += 64) { const float sc = dot_q<128>(q, Pb + (size_t)j * INC + C_BK + h * 128); buf[j] = sc; mx = fmaxf(mx, sc); }
            if (!cq) { const int t = s - CTXL; r = t >> 6; qc = t & 63; rs = min(max(r - 4, 0), 24); cs = min(max(qc - 8, 0), 48); nk = CTXL + 128;
                for (int i = lane; i < 128; i += 64) { const int kr = rs + (i >> 4), kc = cs + (i & 15);
                    const float sc = dot_q<128>(q, Pb + (size_t)(CTXL + kr * 64 + kc) * INC + C_BK + h * 128) + rpb[(h * 15 + (kr - r + 7)) * 31 + (kc - qc + 15)] * LOG2E;
                    buf[CTXL + i] = sc; mx = fmaxf(mx, sc); } }
            const float inv = softmax_buf(buf, nk, mx, lane);
            float a0 = 0.f, a1 = 0.f; const bf16* vb = Pb + C_BV + h * 128 + lane;
#pragma unroll 8
            for (int j = 0; j < nk; ++j) { const int kk = (j < CTXL) ? j : CTXL + (rs + ((j - CTXL) >> 4)) * 64 + cs + ((j - CTXL) & 15);
                const float p = buf[j]; a0 += p * bf1(vb[(size_t)kk * INC]); a1 += p * bf1(vb[(size_t)kk * INC + 64]); }
            bf16* op = OB + (size_t)row * 1024 + h * 128 + lane;
            op[0] = (bf16)f2bf(a0 * inv); op[64] = (bf16)f2bf(a1 * inv);
            LDS_WAIT(); asm volatile("" ::: "memory");
        } else {
            float q[64]; load_q<64>(q, Prow + C_CQ + h * 64);
            const int nk = cq ? CTXL : SB;
            const float lf = -log1pf(expf(-rdecay[h])) * LOG2E, lb = -log1pf(expf(-rdecay[8 + h])) * LOG2E;
            for (int j = lane; j < nk; j += 64) { const float sc = dot_q<64>(q, Pb + (size_t)j * INC + C_CK + h * 64);
                const int df = s - j, db = ((!cq && j < CTXL) ? SB : 0) - df;
                const float w = (df >= 0 ? __builtin_amdgcn_exp2f(lf * (float)df) : 0.f) + (db >= 0 ? __builtin_amdgcn_exp2f(lb * (float)db) : 0.f);
                buf[j] = sc * w; }
            LDS_WAIT(); asm volatile("" ::: "memory");
            float a0 = 0.f, a1 = 0.f; const bf16* vb = Pb + C_CV + h * 128 + lane;
#pragma unroll 8
            for (int j = 0; j < nk; ++j) { const float p = buf[j]; a0 += p * bf1(vb[(size_t)j * INC]); a1 += p * bf1(vb[(size_t)j * INC + 64]); }
            const float rstd = 1.0f / sqrtf(wave_sum(a0 * a0 + a1 * a1) * (1.0f / 128.0f) + EPS);
            const bf16* gp = Prow + C_CG + h * 128 + lane;
            bf16* op = YR + (size_t)row * 1024 + h * 128 + lane;
            op[0] = (bf16)f2bf(a0 * rstd * rnorm[lane] * silu_f(bf1(gp[0]))); op[64] = (bf16)f2bf(a1 * rstd * rnorm[64 + lane] * silu_f(bf1(gp[64])));
            LDS_WAIT(); asm volatile("" ::: "memory");
        }
    }
}

__device__ __forceinline__ void mix_states(LAS unsigned char* lds, const bf16* P, float* UST, const float* rdecay, int vcu, int G, int tid_in) {
    for (int it = vcu; it < 64 * 9; it += G) {
        int tid = tid_in; asm volatile("" : "+v"(tid));
        const int bh = it / 9, c = it - bh * 9, b = bh >> 3, h = bh & 7;
        const float lf = -log1pf(expf(-rdecay[h])) * LOG2E, lb = -log1pf(expf(-rdecay[8 + h])) * LOG2E;
        att::c_state_item(lds, P + C_CK + h * 64, P + C_CV + h * 128, b * SB + 256 * c, lf, lb, UST + (size_t)it * 2 * 8192, tid);
    }
}

__device__ __forceinline__ void mix_mfma(int l, LAS unsigned char* lds, const bf16* P, bf16* OA, bf16* OB, bf16* YR, const float* dlam, const float* dnorm, const float* rpb,
                                         const float* rdecay, const float* rnorm, float lam_init, const float* UST, unsigned* STG, int vcu, int G, int tid_in, int modemask) {
    const int wid = __builtin_amdgcn_readfirstlane(tid_in >> 6);
    const int nun = 512 + (l == 0 ? 64 : 0);
    if (modemask & 1) {
        float lam; { const int lane = tid_in & 63; const float v = dlam[lane] * dlam[64 + lane], w = dlam[128 + lane] * dlam[192 + lane]; lam = expf(wave_sum(v)) - expf(wave_sum(w)) + lam_init; }
        lam = __builtin_bit_cast(float, __builtin_amdgcn_readfirstlane(__builtin_bit_cast(int, lam)));
        for (int u = vcu; u < nun; u += G) {
            const bool cu = u >= 512; const int uu = cu ? u - 512 : u;
            const int b = cu ? (uu >> 3) : (uu >> 6), h = cu ? (uu & 7) : ((uu >> 3) & 7), qb = cu ? 0 : (uu & 7);
            const int grow0 = b * SB + (cu ? 0 : CTXL + 256 * qb), NT = cu ? 4 : 36;
            att::f32x16 o[4];
            for (int map = 0; map < 2; ++map) {
                int tid = tid_in; asm volatile("" : "+v"(tid)); const int lane = tid & 63;
                const att::UnitD ud{P + (size_t)grow0 * INC + C_AQ + h * 128 + map * 64, P + C_AK + h * 128 + map * 64, P + C_AV + h * 128, b * SB, 4, 1000, NT};
                const att::ModeP mp{};
#if A_RING3
                att::attn_a3(lds, ud.Q, ud.K, ud.V, ud.row_base, ud.NT, o, tid); (void)mp;
                LAS unsigned* st = (LAS unsigned*)(lds + (wid < 7 ? att::L_STASH3 + wid * 8192 : LTAB_OFF)) + lane;
#else
                att::attn_core<64, 0, 2>(lds, ud, mp, o, tid);
                LAS unsigned* st = (LAS unsigned*)(lds + att::L_STASH) + wid * 2048 + lane;
#endif
                if (map == 0) {
#pragma unroll
                    for (int d = 0; d < 4; ++d)
#pragma unroll
                        for (int r2 = 0; r2 < 8; ++r2) st[(d * 8 + r2) * 64] = cvt_pk_bf16(o[d][2 * r2], o[d][2 * r2 + 1]);
                } else {
#pragma unroll
                    for (int d = 0; d < 4; ++d)
#pragma unroll
                        for (int r2 = 0; r2 < 8; ++r2) { const unsigned w = st[(d * 8 + r2) * 64]; o[d][2 * r2] = bflo(w) - lam * o[d][2 * r2]; o[d][2 * r2 + 1] = bfhi(w) - lam * o[d][2 * r2 + 1]; }
                }
                LDS_WAIT(); asm volatile("" ::: "memory");
            }
            { int tid = tid_in; asm volatile("" : "+v"(tid)); att::attn_epi<0>(lds, o, tid, grow0, OA, h * 128, dnorm, 1.0f - lam_init, nullptr); }
        }
    }
    if (modemask & 4) {
        for (int u = (vcu + 64) % G; u < nun; u += G) {
            const bool cu = u >= 512; const int uu = cu ? u - 512 : u;
            const int b = cu ? (uu >> 3) : (uu >> 6), h = cu ? (uu & 7) : ((uu >> 3) & 7), c = cu ? 0 : (uu & 7) + 1;
            const int grow0 = b * SB + 256 * c;
            att::f32x16 o[4]; int tid = tid_in; asm volatile("" : "+v"(tid));
            const float lf = -log1pf(expf(-rdecay[h])) * LOG2E, lb = -log1pf(expf(-rdecay[8 + h])) * LOG2E;
            const bf16* Qp = P + (size_t)grow0 * INC + C_CQ + h * 64;
            __syncthreads();
            if (!cu) att::c_build_states(lds, UST + (size_t)(b * 8 + h) * 9 * 2 * 8192, c, lf, lb, tid);
            const att::UnitD ud{Qp, P + C_CK + h * 64, P + C_CV + h * 128, grow0, 4, 1000, 4};
            att::ModeP mp{}; mp.lf = lf; mp.lb = lb; mp.sq0 = 0; mp.latq = 0;
            att::attn_core<64, 2, 2>(lds, ud, mp, o, tid);
            if (!cu) att::c_state_steps(lds, Qp, lf, lb, o, tid);
            att::attn_epi<2>(lds, o, tid, grow0, YR, h * 128, rnorm, 1.0f, P + C_CG + h * 128);
        }
    }
    if (modemask & 2) {
        for (int u = (vcu + 128) % G; u < nun; u += G) {
            const bool cu = u >= 512; const int uu = cu ? u - 512 : u;
            const int b = cu ? (uu >> 3) : (uu >> 6), h = cu ? (uu & 7) : ((uu >> 3) & 7), g = cu ? 0 : (uu & 7);
            const int grow0 = b * SB + (cu ? 0 : CTXL + 256 * g);
            const int kr0 = min(max(4 * g - 4, 0), 24), kr1 = min(max(4 * g - 1, 0), 24) + 7, nkr = kr1 - kr0 + 1, NT = cu ? 4 : ((4 + nkr + 1) & ~1);
            att::f32x16 o[4]; int tid = tid_in; asm volatile("" : "+v"(tid));
            const att::UnitD ud{P + (size_t)grow0 * INC + C_BQ + h * 128, P + C_BK + h * 128, P + C_BV + h * 128, b * SB, 4 + kr0, nkr - 1, NT};
            att::ModeP mp{}; mp.plain = cu ? 1 : 0; mp.kr0 = kr0; mp.nkr = nkr; mp.qr0 = 4 * g; mp.rpb = rpb + h * 465;
#if B_STEP4
            att::attn_b4(lds, ud, mp, o, tid);
#elif B_RING3
            att::attn_b3(lds, ud, mp, o, tid);
#else
            att::attn_core<128, 1, BSD>(lds, ud, mp, o, tid);
#endif
            att::attn_epi<1>(lds, o, tid, grow0, OB, h * 128, nullptr, 1.0f, nullptr);
        }
    }
    __syncthreads();
}

struct TArgs { const float* xin; const float* cin; const bf16* hin; bf16* hout; float* fout; const bf16* Y; const bf16* YP; float wgt; const float* gate; const float* postg;
               const float* preg; const float* shift; const float* scale; bf16* U; int upd, nxt, skip_ctx; };
template <bool XIN> struct RawRow { typename std::conditional<XIN, v4u, v2u>::type v[8]; v2u y[8]; };
template <bool XIN> __device__ __forceinline__ void thin_load_row(const TArgs& T, int row, int lane, RawRow<XIN>& r) {
    const int b = row / SB, s = row - b * SB; const bool cq = s < CTXL;
    if (cq && T.skip_ctx) return;
    if constexpr (XIN) { const v4u* hi_ = (const v4u*)(cq ? T.cin + (size_t)(b * CTXL + s) * DM : T.xin + (size_t)(b * SEQ + s - CTXL) * DM) + lane;
#pragma unroll
        for (int j = 0; j < 8; ++j) r.v[j] = __builtin_nontemporal_load(hi_ + 64 * j); }
    else { const v2u* hi_ = (const v2u*)(T.hin + (size_t)row * DM) + lane;
#pragma unroll
        for (int j = 0; j < 8; ++j) r.v[j] = __builtin_nontemporal_load(hi_ + 64 * j); }
    if (T.upd) {
        if (cq && T.YP) { const v2u* yp = (const v2u*)(T.YP + (size_t)(b * CTXL + s) * DM) + lane; constexpr size_t ZS = (size_t)NBATCH * CTXL * DM / 4;
#pragma unroll
            for (int j = 0; j < 8; ++j) { const v2u w0 = yp[64 * j], w1 = yp[64 * j + ZS], w2 = yp[64 * j + 2 * ZS], w3 = yp[64 * j + 3 * ZS];
                r.y[j] = (v2u){cvt_pk_bf16((bflo(w0.x) + bflo(w1.x)) + (bflo(w2.x) + bflo(w3.x)), (bfhi(w0.x) + bfhi(w1.x)) + (bfhi(w2.x) + bfhi(w3.x))),
                               cvt_pk_bf16((bflo(w0.y) + bflo(w1.y)) + (bflo(w2.y) + bflo(w3.y)), (bfhi(w0.y) + bfhi(w1.y)) + (bfhi(w2.y) + bfhi(w3.y)))}; } }
        else { const v2u* yp = (const v2u*)(T.Y + (size_t)row * DM) + lane;
#pragma unroll
            for (int j = 0; j < 8; ++j) r.y[j] = __builtin_nontemporal_load(yp + 64 * j); }
    }
}
template <bool XIN> __device__ __forceinline__ void thin_do_row(const TArgs& T, int row, int lane, const RawRow<XIN>& r, const LAS f32x4* L) {
    const int b = row / SB, s = row - b * SB; const bool cq = s < CTXL;
    if (cq && T.skip_ctx) return;
    const int co = cq ? 512 : 0;
    f32x4 v[8];
#pragma unroll
    for (int j = 0; j < 8; ++j) { if constexpr (XIN) v[j] = __builtin_bit_cast(f32x4, r.v[j]); else v[j] = (f32x4){bflo(r.v[j].x), bfhi(r.v[j].x), bflo(r.v[j].y), bfhi(r.v[j].y)}; }
    if (T.upd) {
        f32x4 y[8]; float ss = 0.f;
#pragma unroll
        for (int j = 0; j < 8; ++j) y[j] = (f32x4){bflo(r.y[j].x), bfhi(r.y[j].x), bflo(r.y[j].y), bfhi(r.y[j].y)};
#pragma unroll
        for (int j = 0; j < 8; ++j) ss += (y[j][0] * y[j][0] + y[j][1] * y[j][1]) + (y[j][2] * y[j][2] + y[j][3] * y[j][3]);
        const float rstd = 1.0f / sqrtf(wave_sum(ss) * (1.0f / DM) + EPS) * T.wgt;
#pragma unroll
        for (int j = 0; j < 8; ++j) v[j] += L[co + lane + 64 * j] * (y[j] * rstd * L[1024 + lane + 64 * j]);
        if (T.fout) { if (!cq) { f32x4* ho_ = (f32x4*)(T.fout + (size_t)(b * SEQ + s - CTXL) * DM) + lane;
#pragma unroll
            for (int j = 0; j < 8; ++j) ho_[64 * j] = v[j]; } }
        else { v2u* ho_ = (v2u*)(T.hout + (size_t)row * DM) + lane;
#pragma unroll
            for (int j = 0; j < 8; ++j) { v2u w; w.x = cvt_pk_bf16(v[j][0], v[j][1]); w.y = cvt_pk_bf16(v[j][2], v[j][3]); ho_[64 * j] = w;
                v[j] = (f32x4){bflo(w.x), bfhi(w.x), bflo(w.y), bfhi(w.y)}; } }
    }
    if (T.nxt) {
        float ss = 0.f;
#pragma unroll
        for (int j = 0; j < 8; ++j) ss += (v[j][0] * v[j][0] + v[j][1] * v[j][1]) + (v[j][2] * v[j][2] + v[j][3] * v[j][3]);
        const float rstd = 1.0f / sqrtf(wave_sum(ss) * (1.0f / DM) + EPS);
        v2u* up = (v2u*)(T.U + (size_t)row * DM) + lane;
#pragma unroll
        for (int j = 0; j < 8; ++j) { const f32x4 u = (v[j] * rstd * L[1536 + lane + 64 * j]) * (L[2048 + co + lane + 64 * j] + 1.0f) + L[3072 + co + lane + 64 * j];
            v2u w; w.x = cvt_pk_bf16(u[0], u[1]); w.y = cvt_pk_bf16(u[2], u[3]); up[64 * j] = w; }
    }
}
template <bool XIN> __device__ __forceinline__ void thin_phase(const TArgs& T, LAS unsigned char* lds, int vcu, int G, int tid) {
    const int lane = tid & 63, wave = __builtin_amdgcn_readfirstlane(tid >> 6);
    const int rpc = R / G, base = vcu * rpc, bb = base / SB;
    LAS f32x4* L = (LAS f32x4*)lds;
    f32x4 sv[8];
#pragma unroll
    for (int vsel = 0; vsel < 8; ++vsel) { const size_t mo = (size_t)((vsel & 1) ? 8 : bb) * (9 * DM);
        const float* src = (vsel < 2) ? (T.upd ? T.gate + mo : nullptr) : (vsel == 2) ? (T.upd ? T.postg : nullptr) : (vsel == 3) ? (T.nxt ? T.preg : nullptr)
                         : (vsel < 6) ? (T.nxt ? T.scale + mo : nullptr) : (T.nxt ? T.shift + mo : nullptr);
        sv[vsel] = src ? ((const f32x4*)src)[tid] : (f32x4){0.f, 0.f, 0.f, 0.f}; }
    const int nk = rpc / NWAVES, r0 = base + wave;
    RawRow<XIN> A, B, C;
    thin_load_row<XIN>(T, r0, lane, A); if (1 < nk) thin_load_row<XIN>(T, r0 + NWAVES, lane, B);
#pragma unroll
    for (int vsel = 0; vsel < 8; ++vsel) L[vsel * 512 + tid] = sv[vsel];
    __syncthreads();
    for (int k = 0; k < nk; k += 3) {
        if (k + 2 < nk) thin_load_row<XIN>(T, r0 + NWAVES * (k + 2), lane, C);
        thin_do_row<XIN>(T, r0 + NWAVES * k, lane, A, L);
        if (k + 1 < nk) { if (k + 3 < nk) thin_load_row<XIN>(T, r0 + NWAVES * (k + 3), lane, A);
            thin_do_row<XIN>(T, r0 + NWAVES * (k + 1), lane, B, L); }
        if (k + 2 < nk) { if (k + 4 < nk) thin_load_row<XIN>(T, r0 + NWAVES * (k + 4), lane, B);
            thin_do_row<XIN>(T, r0 + NWAVES * (k + 2), lane, C, L); }
    }
    __syncthreads();
}

__device__ __forceinline__ void p0_convert(int l, const float* w1, const float* w2, const float* win, const float* wb, const float* wo, unsigned char* wt, LAS unsigned char* lds, int gw, int NGW, int wave, int lane, int it0 = 0, int it1 = 1 << 30) {
    LAS float* scr = (LAS float*)(lds + wave * 16384);
    constexpr int I_W1 = 32 * 352, I_W2 = 88 * 64, I_IN = 32 * 480, I_WB = 16 * 64, I_WO = 32 * 64, NIT = 2 * I_W1 + 2 * I_W2 + I_IN + 3 * I_WB + I_WO;
    const int itE = it1 < NIT ? it1 : NIT;
    for (int it = it0 + gw; it < itE; it += NGW) {
        int r = it;
        if (r < 2 * I_W1) { const int i = r / I_W1; r -= i * I_W1; const int kb = r / 352, n0 = (r % 352) * 32;
            const int orow0 = (n0 < FFN) ? (n0 / 128) * 256 + (n0 % 128) : ((n0 - FFN) / 128) * 256 + 128 + ((n0 - FFN) % 128);
            transpose_item(w1 + (size_t)(l * 2 + i) * DM * (2 * FFN), DM, 2 * FFN, (bf16*)(wt + (i ? WT_W1B : WT_W1A)), kb * 64, n0, orow0, (n0 < FFN) ? -LOG2E : -1.0f / LOG2E, scr, lane); continue; }
        r -= 2 * I_W1;
        if (r < 2 * I_W2) { const int i = r / I_W2; r -= i * I_W2; const int kb = r / 64, n0 = (r % 64) * 32;
            transpose_item(w2 + (size_t)(l * 2 + i) * FFN * DM, FFN, DM, (bf16*)(wt + (i ? WT_W2B : WT_W2A)), kb * 64, n0, n0, 1.0f, scr, lane); continue; }
        r -= 2 * I_W2;
        if (r < I_IN) { const int kb = r / 480, n0 = (r % 480) * 32;
            const float sc = (n0 < C_AK) ? SCALE_A : (n0 >= C_BQ && n0 < C_BK) ? SCALE_B : (n0 >= C_CK && n0 < C_CV) ? SCALE_CK : 1.0f;
            transpose_item(win + (size_t)l * DM * INC, DM, INC, (bf16*)(wt + WT_IN), kb * 64, n0, n0, sc, scr, lane); continue; }
        r -= I_IN;
        if (r < 3 * I_WB) { const int br = r / I_WB; r -= br * I_WB; const int kb = r / 64, n0 = (r % 64) * 32;
            transpose_item(wb + (size_t)(l * 3 + br) * 1024 * DM, 1024, DM, (bf16*)(wt + WT_WB) + (size_t)br * DM * 1024, kb * 64, n0, n0, 1.0f, scr, lane); continue; }
        r -= 3 * I_WB;
        { const int kb = r / 64, n0 = (r % 64) * 32; transpose_item(wo + (size_t)l * DM * DM, DM, DM, (bf16*)(wt + WT_WO), kb * 64, n0, n0, 1.0f, scr, lane); }
    }
}
__device__ __forceinline__ void p0_mod(const float* c, const float* cctx, const float* wmod, const float* bmod, float* MOD, LAS unsigned char* lds, int it0, int it1, int G, int tid, int wave, int lane) {
    LAS float* S = (LAS float*)(lds + wave * 9216);
    for (int it = it0; it < it1; it += G) {
        const int l = it / 72, n0 = (it % 72) * 256, k0 = wave * 256;
        for (int r = 0; r < 9; ++r) for (int kk = lane; kk < 256; kk += 64) { const float x = (r < 8) ? c[r * DM + k0 + kk] : cctx[k0 + kk]; S[r * 256 + kk] = x / (1.0f + expf(-x)); }
        LDS_WAIT(); asm volatile("" ::: "memory");
        f32x4 acc[9];
#pragma unroll
        for (int r = 0; r < 9; ++r) acc[r] = (f32x4){0.f, 0.f, 0.f, 0.f};
        const float* wp = wmod + ((size_t)(l * DM + k0)) * 18432 + n0 + 4 * lane;
#pragma unroll 2
        for (int kk = 0; kk < 256; kk += 4) {
            const f32x4 w0 = *(const f32x4*)(wp + (size_t)(kk + 0) * 18432), w1 = *(const f32x4*)(wp + (size_t)(kk + 1) * 18432), w2 = *(const f32x4*)(wp + (size_t)(kk + 2) * 18432), w3 = *(const f32x4*)(wp + (size_t)(kk + 3) * 18432);
#pragma unroll
            for (int r = 0; r < 9; ++r) { const f32x4 s = *(const LAS f32x4*)(S + r * 256 + kk); acc[r] += w0 * s[0] + w1 * s[1] + w2 * s[2] + w3 * s[3]; }
        }
        asm volatile("" ::: "memory");
#pragma unroll
        for (int r = 0; r < 9; ++r) *(LAS f32x4*)(S + r * 256 + 4 * lane) = acc[r];
        __syncthreads();
        for (int idx = tid; idx < 9 * 256; idx += NWAVES * 64) { const int r = idx >> 8, cc = idx & 255; float s = bmod[l * 18432 + n0 + cc];
#pragma unroll
            for (int w = 0; w < NWAVES; ++w) s += ((const LAS float*)(lds + w * 9216))[r * 256 + cc];
            MOD[(size_t)(l * 9 + r) * 18432 + n0 + cc] = s; }
        __syncthreads();
    }
}

constexpr int BG_NIT = 2 * 32 * 352 + 2 * 88 * 64 + 32 * 480 + 3 * 16 * 64 + 32 * 64;
#ifndef P0_SPLIT
#define P0_SPLIT 38000
#endif
#ifndef BG1
#define BG1 13000
#define BG2 26000
#define BG3 54272
#endif
#define BG_CONVERT(FIRST_IDLE, IT0, IT1) do { if (l == 0 && (int)blockIdx.x >= (FIRST_IDLE) && (IT1) > (IT0)) { PH_VARS \
    p0_convert(1, a.in[8], a.in[9], a.in[10], a.in[16], a.in[17], ws + WS_WT1, lds, ((int)blockIdx.x - (FIRST_IDLE)) * NWAVES + wave, (G - (FIRST_IDLE)) * NWAVES, wave, lane, (IT0), (IT1)); } } while (0)
#ifndef PROBE_DUP
#define PROBE_DUP 0
#endif
#ifndef MFMA_MODES
#define MFMA_MODES 7
#endif
#define GEMM_PHASE_Z(EPI_T, E_, Aptr, Bptr, N_, K_, LD_, ZA_, ZB_, ZN_, NM_, LAT_) do { \
    pg8::Gemm g_{(const bf16*)(Aptr), (const bf16*)(Bptr), R, (N_), (K_), (LD_), (size_t)(ZA_), (size_t)(ZB_)}; pg8::PanelOrder S_; S_.init((NM_), (N_), G, (int)blockIdx.x, (LAT_), (ZN_)); \
    pg8::gemm_phase<EPI_T, pg8::PanelOrder, true, true>(lds, g_, S_, E_); } while (0)
#define GEMM_PHASE_CTX(Aptr, Bptr, N_, KS_, LD_) do { const ep::EpiF32Part Ep_{(float*)YP}; \
    pg8::Gemm g_{(const bf16*)(Aptr), (const bf16*)(Bptr), R, (N_), (KS_), (LD_), (size_t)(KS_) * 2, (size_t)(KS_) * 2}; pg8::CtxSplitOrder S_; S_.init((N_), G, (int)blockIdx.x); \
    pg8::gemm_phase<ep::EpiF32Part, pg8::CtxSplitOrder, true, true>(lds, g_, S_, Ep_); } while (0)
#define GEMM_PHASE_LC(Aptr, Bptr, K_) do { const ep::EpiYMix Em_{Y, YP}; \
    pg8::Gemm g_{(const bf16*)(Aptr), (const bf16*)(Bptr), R, DM, (K_), (K_), (size_t)((K_) / 4) * 2, (size_t)((K_) / 4) * 2}; pg8::LatCtxOrder S_; S_.init(G, (int)blockIdx.x, (K_) / 256); \
    pg8::gemm_phase<ep::EpiYMix, pg8::LatCtxOrder, true, true>(lds, g_, S_, Em_); } while (0)
#define GEMM_PHASE(EPI_T, E_, Aptr, Bptr, N_, K_, NM_, LAT_) GEMM_PHASE_Z(EPI_T, E_, Aptr, Bptr, N_, K_, K_, 0, 0, 1, NM_, LAT_)

#define LTAB_FILL() do { __syncthreads(); { int tid0 = threadIdx.x; asm volatile("" : "+v"(tid0)); for (int e = tid0; e < 1024; e += NWAVES * 64) { const int pos = e >> 4, i = e & 15; \
        const float rev = (float)pos * __builtin_amdgcn_exp2f(-(float)i * 0.8304820237218406f) * 0.15915494309189535f; \
        ((LAS f32x2*)(lds + LTAB_OFF))[e] = (f32x2){__builtin_amdgcn_cosf(rev), __builtin_amdgcn_sinf(rev)}; } } __syncthreads(); } while (0)
__global__ void __launch_bounds__(NWAVES * 64, 2) fwd_kernel(Args a_in) {
    extern __shared__ __attribute__((aligned(16))) unsigned char lds_raw[];
    LAS unsigned char* lds = (LAS unsigned char*)lds_raw;
    constexpr int G = GRID;
    const int bx = blockIdx.x, vcu = (bx % 8) * (G / 8) + bx / 8, NGW = G * NWAVES;
    { const int tid0 = threadIdx.x; for (int u = tid0; u < (LDS_BYTES - LDSCTL_OFF) / 4; u += NWAVES * 64) ((LAS unsigned*)(lds + LDSCTL_OFF))[u] = 0u; }
    __syncthreads();
    XcdBarrier bar = xcd_barrier_post((unsigned*)(a_in.ws + WS_CTL) + CW_BAR, (volatile LAS unsigned*)(lds + MISC_OFF) + 8);
#define GRID_BAR() do { XcdBarrier b_ = bar; asm volatile("" : "+s"(b_.bar)); xcd_barrier(b_); } while (0)
#define PH_VARS \
    int tid = threadIdx.x; asm volatile("" : "+v"(tid)); const int lane = tid & 63, wave = __builtin_amdgcn_readfirstlane(tid >> 6), gw = vcu * NWAVES + wave; (void)lane; (void)gw; \
    const __attribute__((address_space(4))) Args* ap = (const __attribute__((address_space(4))) Args*)__builtin_amdgcn_kernarg_segment_ptr(); asm volatile("" : "+s"(ap)); const __attribute__((address_space(4))) Args& a = *ap;     \
    unsigned char* ws = a.ws; \
    float* MOD = (float*)(ws + WS_MOD); f32x2* TAB = (f32x2*)(ws + WS_TAB); float* HC = (float*)(ws + WS_HC); bf16* U = (bf16*)(ws + WS_U); \
    bf16* OA = (bf16*)(ws + WS_OA); bf16* OB = (bf16*)(ws + WS_OB); bf16* YR = (bf16*)(ws + WS_YR); float* MACC = (float*)(ws + WS_MACC); bf16* YP = (bf16*)MACC; bf16* HB = (bf16*)(ws + WS_MACC + 64 * MiB); \
    unsigned char* wt = ws + (l ? WS_WT1 : WS_WT); bf16* P = (bf16*)(ws + WS_R1); bf16* ACT = (bf16*)(ws + WS_R1 + R1_ACT); bf16* Y = (bf16*)(ws + WS_R1 + R1_Y); float* hlat = a.out; \
    const float* MODl = MOD + (size_t)l * 9 * 18432; const float* pre = a.in[6] + l * 3 * DM; const float* post = a.in[7] + l * 3 * DM; const int lat = (l == 1), nM = lat ? 64 : NPAN; \
    (void)MOD; (void)TAB; (void)HC; (void)U; (void)OA; (void)OB; (void)YR; (void)MACC; (void)YP; (void)HB; (void)wt; (void)P; (void)ACT; (void)Y; (void)hlat; (void)MODl; (void)pre; (void)post; (void)nM;

    for (int l = 0; l < 2; ++l) {
        if (l == 0) { PH_VARS
          if (bx < 72) p0_mod(a.in[1], a.in[3], a.in[4], a.in[5], MOD, lds, bx, 72, G, tid, wave, lane);
          else p0_convert(0, a.in[8], a.in[9], a.in[10], a.in[16], a.in[17], wt, lds, (bx - 72) * NWAVES + wave, (G - 72) * NWAVES, wave, lane, 0, P0_SPLIT);
          p0_convert(0, a.in[8], a.in[9], a.in[10], a.in[16], a.in[17], wt, lds, gw, NGW, wave, lane, P0_SPLIT, BG_NIT);
          GRID_BAR(); }
        if (l == 1 && BG3 < BG_NIT) { PH_VARS p0_convert(1, a.in[8], a.in[9], a.in[10], a.in[16], a.in[17], wt, lds, gw, NGW, wave, lane, BG3, BG_NIT); GRID_BAR(); }
        if (l == 0) {
            PH_VARS
            TArgs T{a.in[0], a.in[2], nullptr, nullptr, nullptr, nullptr, nullptr, 0.f, nullptr, nullptr, pre, MODl, MODl + DM, U, 0, 1, 0};
            if (T.xin) thin_phase<true>(T, lds, vcu, G, tid); else thin_phase<false>(T, lds, vcu, G, tid); GRID_BAR();
        }
        if (PROBE_DUP & 4096) { for (int e_ = 0; e_ < 10; ++e_) GRID_BAR(); }
        { PH_VARS const ep::EpiSwiGLU E{ACT}; GEMM_PHASE(ep::EpiSwiGLU, E, U, wt + WT_W1A, 2 * FFN, DM, NPAN, 0); } BG_CONVERT(96, 0, BG1); GRID_BAR();
        if (PROBE_DUP & 8192) { PH_VARS const ep::EpiNull E{OA}; GEMM_PHASE(ep::EpiNull, E, U, wt + WT_W1A, 2 * FFN, DM, NPAN, 0); GRID_BAR(); }
        if (PROBE_DUP & 4) { PH_VARS const ep::EpiSwiGLU E{ACT}; GEMM_PHASE(ep::EpiSwiGLU, E, U, wt + WT_W1A, 2 * FFN, DM, NPAN, 0); GRID_BAR(); }
        { PH_VARS GEMM_PHASE_LC(ACT, wt + WT_W2A, FFN); } GRID_BAR();
        if (PROBE_DUP & 8) { PH_VARS const ep::EpiBf16 E{Y, DM}; GEMM_PHASE(ep::EpiBf16, E, ACT, wt + WT_W2A, DM, FFN, 64, 1); GRID_BAR(); }
        if (PROBE_DUP & 2048) { PH_VARS GEMM_PHASE_CTX(ACT, wt + WT_W2A, DM, FFN / 4, FFN); GRID_BAR(); }
        if (PROBE_DUP & 32) { PH_VARS
            TArgs T{l == 0 ? a.in[0] : nullptr, a.in[2], HB, (bf16*)ACT, nullptr, Y, YP, 0.5f, MODl + 2 * DM, post, pre + DM, MODl + 3 * DM, MODl + 4 * DM, OA, 1, 1, 0};
            if (T.xin) thin_phase<true>(T, lds, vcu, G, tid); else thin_phase<false>(T, lds, vcu, G, tid); GRID_BAR(); }
        {
            PH_VARS
            TArgs T{l == 0 ? a.in[0] : nullptr, a.in[2], HB, HB, nullptr, Y, YP, 0.5f, MODl + 2 * DM, post, pre + DM, MODl + 3 * DM, MODl + 4 * DM, U, 1, 1, 0};
            if (T.xin) thin_phase<true>(T, lds, vcu, G, tid); else thin_phase<false>(T, lds, vcu, G, tid); } GRID_BAR();
        LTAB_FILL();
        if (l == 0) { PH_VARS const ep::EpiInProj E{P, (const LAS f32x2*)(lds + LTAB_OFF)}; GEMM_PHASE(ep::EpiInProj, E, U, wt + WT_IN, INC, DM, NPAN, 0); }
        else { { PH_VARS const ep::EpiInProj E{P, (const LAS f32x2*)(lds + LTAB_OFF)}; GEMM_PHASE(ep::EpiInProj, E, U, wt + WT_IN, INC, DM, 64, 1); }
               { PH_VARS const ep::EpiInProj E{P, (const LAS f32x2*)(lds + LTAB_OFF)}; pg8::Gemm g_{(const bf16*)U, (const bf16*)(wt + WT_IN), R, INC, DM, DM, 0, 0}; pg8::CtxColsOrder S_; S_.init(G, (int)blockIdx.x);
                 pg8::gemm_phase<ep::EpiInProj, pg8::CtxColsOrder, true, true>(lds, g_, S_, E); } }
        GRID_BAR();
        if (PROBE_DUP & 16) { LTAB_FILL(); PH_VARS const ep::EpiInProj E{P, (const LAS f32x2*)(lds + LTAB_OFF)}; GEMM_PHASE(ep::EpiInProj, E, U, wt + WT_IN, INC, DM, NPAN, 0); GRID_BAR(); }
        if (PROBE_DUP & (64 | 128 | 256)) { PH_VARS
          mix_mfma(l, lds, P, OA, OB, YR, a.in[11] + l * 256, a.in[12] + l * 128, a.in[13] + l * 8 * 465, a.in[14] + l * 16, a.in[15] + l * 128,
                   l == 0 ? 0.2f : 0.35550906759096926f, (const float*)U, (unsigned*)YP, vcu, G, tid, ((PROBE_DUP & 64) ? 1 : 0) | ((PROBE_DUP & 128) ? 4 : 0) | ((PROBE_DUP & 256) ? 2 : 0)); }
        { PH_VARS mix_states(lds, P, (float*)U, a.in[14] + l * 16, vcu, G, tid); } GRID_BAR();
        for (int rep_ = 0; rep_ < ((PROBE_DUP & 2) ? 2 : 1); ++rep_)
        { PH_VARS
          if (MFMA_MODES) mix_mfma(l, lds, P, OA, OB, YR, a.in[11] + l * 256, a.in[12] + l * 128, a.in[13] + l * 8 * 465, a.in[14] + l * 16, a.in[15] + l * 128,
                   l == 0 ? 0.2f : 0.35550906759096926f, (const float*)U, (unsigned*)YP, vcu, G, tid, MFMA_MODES);
          if ((7 & ~MFMA_MODES) != 0) mix_simple(l, P, OA, OB, YR, a.in[11] + l * 256, a.in[12] + l * 128, a.in[13] + l * 8 * 465, a.in[14] + l * 16, a.in[15] + l * 128,
                   l == 0 ? 0.2f : 0.35550906759096926f, (LAS float*)(lds + wave * 9216), gw, NGW, lane, 7 & ~MFMA_MODES); }
        GRID_BAR();
        for (int rep_ = 0; rep_ < ((PROBE_DUP & 512) ? 2 : 1); ++rep_) {
        { PH_VARS const ep::EpiMerge E{P + C_GATE, U}; GEMM_PHASE_Z(ep::EpiMerge, E, OA, wt + WT_WB, DM, 1024, 1024, WS_OB - WS_OA, (size_t)DM * 1024 * 2, 3, nM, lat); } }
        if (l == 0 && bx >= 64 && bx < 136) { PH_VARS p0_mod(a.in[1], a.in[3], a.in[4], a.in[5], MOD, lds, 72 + (bx - 64), 144, G, tid, wave, lane); }
        BG_CONVERT(136, BG2, BG3); GRID_BAR();
        if (l == 0) { PH_VARS GEMM_PHASE_LC(U, wt + WT_WO, DM); } else { PH_VARS const ep::EpiBf16 E{Y, DM}; GEMM_PHASE(ep::EpiBf16, E, U, wt + WT_WO, DM, DM, 64, 1); }
        GRID_BAR();
        if (PROBE_DUP & 1024) { PH_VARS const ep::EpiBf16 E{Y, DM}; GEMM_PHASE(ep::EpiBf16, E, U, wt + WT_WO, DM, DM, nM, lat); GRID_BAR(); }
        {
            PH_VARS
            TArgs T{nullptr, nullptr, HB, HB, nullptr, Y, YP, 1.0f, MODl + 5 * DM, post + DM, pre + 2 * DM, MODl + 6 * DM, MODl + 7 * DM, U, 1, 1, lat};
            if (T.xin) thin_phase<true>(T, lds, vcu, G, tid); else thin_phase<false>(T, lds, vcu, G, tid); } GRID_BAR();
        { PH_VARS const ep::EpiSwiGLU E{ACT}; GEMM_PHASE(ep::EpiSwiGLU, E, U, wt + WT_W1B, 2 * FFN, DM, nM, lat); } BG_CONVERT(96, BG1, BG2); GRID_BAR();
        if (l == 0) { PH_VARS GEMM_PHASE_LC(ACT, wt + WT_W2B, FFN); } else { PH_VARS const ep::EpiBf16 E{Y, DM}; GEMM_PHASE(ep::EpiBf16, E, ACT, wt + WT_W2B, DM, FFN, 64, 1); }
        GRID_BAR();
        {
            PH_VARS
            const float* MOD1 = MOD + (size_t)9 * 18432;
            TArgs T{nullptr, nullptr, HB, HB, l == 1 ? hlat : nullptr, Y, YP, 0.5f, MODl + 8 * DM, post + 2 * DM, a.in[6] + 3 * DM, MOD1, MOD1 + DM, U, 1, l == 0 ? 1 : 0, lat};
            if (T.xin) thin_phase<true>(T, lds, vcu, G, tid); else thin_phase<false>(T, lds, vcu, G, tid); }
        if (l == 0) GRID_BAR();
    }
}

extern "C" void kernel_launch(void* const* d_in, const int* in_sizes, int n_in, void* d_out, int out_size, void* d_ws, size_t ws_size, hipStream_t stream) {
    static int grid = 0;
    if (grid == 0) {
        if (n_in != 18 || in_sizes[0] != NBATCH * SEQ * DM || out_size != NBATCH * SEQ * DM || ws_size < WS_END) {
            fprintf(stderr, "kernel_launch: unexpected shapes / workspace (n_in %d, in0 %d, out %d, ws %zu, need %zu); nothing launched\n", n_in, n_in > 0 ? in_sizes[0] : -1, out_size, ws_size, (size_t)WS_END); grid = -1; return; }
        int dev = 0, cus = 0, per_cu = 0;
        if (hipGetDevice(&dev) != hipSuccess || hipDeviceGetAttribute(&cus, hipDeviceAttributeMultiprocessorCount, dev) != hipSuccess) { grid = -1; return; }
        if (hipFuncSetAttribute((const void*)fwd_kernel, hipFuncAttributeMaxDynamicSharedMemorySize, LDS_BYTES) != hipSuccess) { fprintf(stderr, "kernel_launch: hipFuncSetAttribute failed\n"); grid = -1; return; }
        if (hipOccupancyMaxActiveBlocksPerMultiprocessor(&per_cu, (const void*)fwd_kernel, NWAVES * 64, LDS_BYTES) != hipSuccess || per_cu < 1)
            fprintf(stderr, "kernel_launch: note: occupancy query says %d workgroups per CU\n", per_cu);
        (void)hipGetLastError();
        if (cus < GRID) { fprintf(stderr, "kernel_launch: this kernel needs %d CUs (device has %d); nothing launched\n", GRID, cus); grid = -1; return; }
        grid = GRID;
    }
    if (grid < 0) return;
    if (hipMemsetAsync((char*)d_ws + WS_CTL, 0, CTL_ZERO_BYTES, stream) != hipSuccess) { fprintf(stderr, "kernel_launch: memset failed\n"); return; }
    Args a{};
    for (int i = 0; i < 18; ++i) a.in[i] = (const float*)d_in[i];
    a.out = (float*)d_out; a.ws = (unsigned char*)d_ws;
    hipLaunchKernelGGL(fwd_kernel, dim3(grid), dim3(NWAVES * 64), LDS_BYTES, stream, a);
    const hipError_t le = hipPeekAtLastError();
    if (le != hipSuccess) fprintf(stderr, "kernel_launch: launch failed: %s\n", hipGetErrorName(le));
}
```

```cpp
#include <hip/hip_runtime.h>
#include <cstdio>
#include <cstdint>
#include <type_traits>
namespace pg8 {
#define PG8_LAS __attribute__((address_space(3)))
typedef unsigned short bf16_t;
typedef short bf16x8 __attribute__((ext_vector_type(8)));
typedef float f32x4 __attribute__((ext_vector_type(4)));
typedef unsigned u32x4 __attribute__((ext_vector_type(4)));
constexpr int BM = 256, BK = 64, HALF = 128, HTB = HALF * BK * 2  , STAGE_BYTES = 8 * HTB, NXCD = 8, WGM = 4;

__host__ __device__ __forceinline__ int lds_byte(int r, int c) { const int st = (r >> 4) * 2 + (c >> 5), rr = r & 15, cc = c & 31, ob = rr * 64 + cc * 2; return st * 1024 + (ob ^ (((ob >> 9) & 1) << 5)); }
__host__ __device__ __forceinline__ void stage_rc(int b, int& R, int& C) { const int st = b / 1024, sb = b % 1024, swz = sb ^ (((sb >> 9) & 1) << 5); R = (st >> 1) * 16 + swz / 64; C = (st & 1) * 32 + (swz % 64) / 2; }
__host__ __device__ __forceinline__ int perm32(int rho) { const int n = rho >> 4, i = rho & 15; return 8 * (i >> 2) + 4 * n + (i & 3); }

struct Unit { int pm, pn, z, kt; };
struct Gemm { const bf16_t* A; const bf16_t* Bt; int M, N, K, ld; size_t zA, zB; };

struct PanelOrder {
    int nM, nN, nwg, G, c, lat, zn;
    __host__ __device__ void init(int nM_, int N, int G_, int c_, int lat_, int zn_ = 1) { nM = nM_; nN = N / BM; nwg = nM * nN; G = G_; c = c_; lat = lat_; zn = zn_; }
    __host__ __device__ bool next(int i, Unit& u) const {
        const int ti = i / zn; u.z = i - ti * zn; u.kt = 0;
        const long L = (long)ti * G + c; if (L >= nwg) return false;
        int wgid = (int)L; { const int q = nwg / NXCD, r = nwg % NXCD, xcd = wgid % NXCD, off = wgid / NXCD; wgid = (xcd < r ? xcd * (q + 1) : r * (q + 1) + (xcd - r) * q) + off; }
        const int nig = WGM * nN, gid = wgid / nig, fm = gid * WGM, gsz = (nM - fm) < WGM ? (nM - fm) : WGM;
        const int pm = fm + ((wgid % nig) % gsz); u.pn = (wgid % nig) / gsz; u.pm = lat ? pm + pm / 8 + 1 : pm; return true;
    }
    __device__ __forceinline__ void a_ready(const Unit&) const {}
    __device__ __forceinline__ void done(const Unit&) const {}
};
struct CtxSplitOrder {
    int nN, G, c;
    __host__ __device__ void init(int N, int G_, int c_) { nN = N / BM; G = G_; c = c_; }
    __host__ __device__ bool next(int i, Unit& u) const {
        const long L = (long)i * G + c; if (L >= 8 * nN * 4) return false;
        const int t = (int)(L >> 2); u.z = (int)(L & 3); u.kt = 0; u.pm = 9 * (t / nN); u.pn = t % nN; return true;
    }
    __device__ __forceinline__ void a_ready(const Unit&) const {}
    __device__ __forceinline__ void done(const Unit&) const {}
};
struct CtxColsOrder {
    int G, c;
    __host__ __device__ void init(int G_, int c_) { G = G_; c = c_; }
    __host__ __device__ bool next(int i, Unit& u) const {
        const long L = (long)i * G + c; if (L >= 8 * 22) return false;
        const int p = (int)L / 22, k = (int)L % 22; u.z = 0; u.kt = 0; u.pm = 9 * p; u.pn = k < 8 ? 4 + k : k < 16 ? 8 + k : 10 + k; return true;
    }
    __device__ __forceinline__ void a_ready(const Unit&) const {}
    __device__ __forceinline__ void done(const Unit&) const {}
};
struct LatCtxOrder {
    PanelOrder lat; int G, c, ktq;
    __host__ __device__ void init(int G_, int c_, int ktq_) { lat.init(64, 2048, G_, c_, 1, 1); G = G_; c = c_; ktq = ktq_; }
    __host__ __device__ bool next(int i, Unit& u) const {
        if (i == 0) { const int q = c, t = q >> 2; u.z = q & 3; u.kt = ktq; u.pm = 9 * (t >> 3); u.pn = t & 7; return q < 256; }
        return lat.next(i - 1, u);
    }
    __device__ __forceinline__ void a_ready(const Unit&) const {}
    __device__ __forceinline__ void done(const Unit&) const {}
};

template <class Epi, class Sched, bool ALIGN_EPI = false, bool SP2 = false>
__device__ __forceinline__ void gemm_phase(PG8_LAS unsigned char* lds, const Gemm g, const Sched& S, const Epi& E) {
    int tid_l = threadIdx.x; asm volatile("" : "+v"(tid_l));
    const int tid = tid_l, wid = __builtin_amdgcn_readfirstlane(tid >> 6), lane = tid & 63, wr = wid >> 2, wc = wid & 3, fr = lane & 15, fq = lane >> 4;
    const int K = g.K, nt = K / BK, LD = g.ld;
    unsigned voffA[2], voffB[2];
#pragma unroll
    for (int i = 0; i < 2; ++i) { int R, C; stage_rc(tid * 16 + i * 8192, R, C); const int Rb = Epi::PERM ? ((R & ~31) + perm32(R & 31)) : R;
        voffA[i] = (unsigned)(R * LD + C) * 2u; voffB[i] = (unsigned)(Rb * LD + C) * 2u; }
    const size_t kstep = (size_t)(BK * 2);
    const size_t hstep = (size_t)HALF * LD * 2;
    const size_t tstep = 2 * hstep;
    const unsigned ldsbase = (unsigned)__builtin_amdgcn_readfirstlane((int)((unsigned)(unsigned long)lds + (unsigned)wid * 1024u));
    const unsigned ldsw = (unsigned)wid * 1024u;
    const int aoff = lds_byte(wr * 64 + fr, fq * 8), boff = lds_byte(wc * 32 + fr, fq * 8);
#define PG8_SA(b, h) (((b) * 2 + (h)) * HTB)
#define PG8_SB(b, h) ((4 + (b) * 2 + (h)) * HTB)
#define PG8_STAGE(bufoff, gbase, voff) do { _Pragma("unroll") for (int _i = 0; _i < 2; ++_i) \
        asm volatile("s_mov_b32 m0, %2\n\ts_nop 0\n\tglobal_load_lds_dwordx4 %0, %1" :: "v"((voff)[_i]), "s"((const char*)(gbase)), "s"(ldsbase + (unsigned)((bufoff) + _i * 8192)) : "memory", "m0"); } while (0)
#define PG8_LDA(dst, b, h) do { _Pragma("unroll") for (int m = 0; m < 4; ++m) _Pragma("unroll") for (int k = 0; k < 2; ++k) dst[m][k] = *(const PG8_LAS bf16x8*)(lds + PG8_SA(b, h) + aoff + m * 2048 + k * 1024); } while (0)
#define PG8_LDB(dst, b, h) do { _Pragma("unroll") for (int n = 0; n < 2; ++n) _Pragma("unroll") for (int k = 0; k < 2; ++k) dst[n][k] = *(const PG8_LAS bf16x8*)(lds + PG8_SB(b, h) + boff + n * 2048 + k * 1024); } while (0)
#define PG8_MMA(ai, bj, At, Bt) do { __builtin_amdgcn_s_setprio(1); _Pragma("unroll") for (int m = 0; m < 4; ++m) _Pragma("unroll") for (int n = 0; n < 2; ++n) _Pragma("unroll") for (int k = 0; k < 2; ++k) \
        acc[ai][bj][m][n] = __builtin_amdgcn_mfma_f32_16x16x32_bf16(Bt[n][k], At[m][k], acc[ai][bj][m][n], 0, 0, 0); __builtin_amdgcn_s_setprio(0); } while (0)
#define PG8_WAIT_V(n) asm volatile("s_waitcnt vmcnt(" #n ")" ::: "memory")
#define PG8_WAIT_L(n) do { __builtin_amdgcn_s_waitcnt(0xC07F | ((n) << 8)); asm volatile("" ::: "memory"); } while (0)
#define PG8_WAIT_VL8 do { __builtin_amdgcn_s_waitcnt(0x0078); asm volatile("" ::: "memory"); } while (0)
#define PG8_BAR __builtin_amdgcn_s_barrier()
#define PG8_SCHED __builtin_amdgcn_sched_barrier(0)
    Unit cur, nxt; int ui = 0;
    if (!S.next(0, cur)) return;
    f32x4 acc[2][2][4][2];
#pragma unroll
    for (int a = 0; a < 2; ++a)
#pragma unroll
        for (int b = 0; b < 2; ++b)
#pragma unroll
            for (int m = 0; m < 4; ++m)
#pragma unroll
                for (int n = 0; n < 2; ++n) acc[a][b][m][n] = (f32x4){0.f, 0.f, 0.f, 0.f};
    bf16x8 At[4][2], B0[2][2], B1[2][2];
    const char* cA = (const char*)g.A + (size_t)cur.z * g.zA + (size_t)cur.pm * tstep; const char* cB = (const char*)g.Bt + (size_t)cur.z * g.zB + (size_t)cur.pn * tstep;
    S.a_ready(cur);
    if constexpr (SP2) {
        PG8_STAGE(PG8_SB(0, 0), cB, voffB); PG8_STAGE(PG8_SB(0, 1), cB + hstep, voffB); PG8_STAGE(PG8_SA(0, 0), cA, voffA); PG8_STAGE(PG8_SA(0, 1), cA + hstep, voffA);
        if (wr == 1) PG8_BAR;
        PG8_WAIT_V(2); PG8_BAR;
        PG8_STAGE(PG8_SB(1, 0), cB + kstep, voffB); PG8_STAGE(PG8_SA(1, 0), cA + kstep, voffA); PG8_STAGE(PG8_SB(1, 1), cB + hstep + kstep, voffB);
        PG8_WAIT_V(6); PG8_BAR;
    } else {
        PG8_STAGE(PG8_SB(0, 0), cB, voffB); PG8_STAGE(PG8_SA(0, 0), cA, voffA); PG8_STAGE(PG8_SB(0, 1), cB + hstep, voffB); PG8_STAGE(PG8_SA(0, 1), cA + hstep, voffA);
        if (wr == 1) PG8_BAR;
        PG8_WAIT_V(4); PG8_BAR;
        PG8_STAGE(PG8_SB(1, 0), cB + kstep, voffB); PG8_STAGE(PG8_SA(1, 0), cA + kstep, voffA); PG8_STAGE(PG8_SB(1, 1), cB + hstep + kstep, voffB);
        PG8_WAIT_V(6); PG8_BAR;
    }
    for (;;) {
        const bool has_next = S.next(ui + 1, nxt);
        const char* nA = has_next ? (const char*)g.A + (size_t)nxt.z * g.zA + (size_t)nxt.pm * tstep : cA; const char* nB = has_next ? (const char*)g.Bt + (size_t)nxt.z * g.zB + (size_t)nxt.pn * tstep : cB;
        const int ntu = cur.kt ? cur.kt : nt;
        for (int t = 0; t < ntu; t += 2) {
            const bool last = (t == ntu - 2);
            const char* a1 = cA + (size_t)(t + 1) * kstep;
            const char* a2 = last ? nA : cA + (size_t)(t + 2) * kstep; const char* b2 = last ? nB : cB + (size_t)(t + 2) * kstep;
            const char* a3 = a2 + kstep; const char* b3 = b2 + kstep;
            if (last && has_next) S.a_ready(nxt);
            if constexpr (SP2) {
            PG8_LDB(B0, 0, 0); PG8_LDB(B1, 0, 1); PG8_SCHED; PG8_LDA(At, 0, 0); PG8_STAGE(PG8_SA(1, 1), a1 + hstep, voffA);
            PG8_WAIT_VL8; PG8_BAR; PG8_MMA(0, 0, At, B0); PG8_MMA(0, 1, At, B1); PG8_BAR; PG8_SCHED;
            PG8_LDA(At, 0, 1); PG8_STAGE(PG8_SB(0, 0), b2, voffB); PG8_STAGE(PG8_SB(0, 1), b2 + hstep, voffB); PG8_STAGE(PG8_SA(0, 0), a2, voffA);
            PG8_WAIT_VL8; PG8_BAR; PG8_MMA(1, 0, At, B0); PG8_MMA(1, 1, At, B1); PG8_BAR; PG8_SCHED;
            PG8_LDB(B0, 1, 0); PG8_LDB(B1, 1, 1); PG8_SCHED; PG8_LDA(At, 1, 0); PG8_STAGE(PG8_SA(0, 1), a2 + hstep, voffA);
            PG8_WAIT_VL8; PG8_BAR; PG8_MMA(0, 0, At, B0); PG8_MMA(0, 1, At, B1); PG8_BAR; PG8_SCHED;
            PG8_LDA(At, 1, 1); PG8_STAGE(PG8_SB(1, 0), b3, voffB); PG8_STAGE(PG8_SB(1, 1), b3 + hstep, voffB); PG8_STAGE(PG8_SA(1, 0), a3, voffA);
            PG8_WAIT_VL8; PG8_BAR; PG8_MMA(1, 0, At, B0); PG8_MMA(1, 1, At, B1); PG8_BAR; PG8_SCHED;
            } else {
            PG8_LDB(B0, 0, 0); PG8_SCHED; PG8_LDA(At, 0, 0); PG8_STAGE(PG8_SA(1, 1), a1 + hstep, voffA);
            PG8_WAIT_L(8); PG8_BAR; PG8_WAIT_L(0); PG8_MMA(0, 0, At, B0); PG8_BAR; PG8_SCHED;
            PG8_LDB(B1, 0, 1); PG8_STAGE(PG8_SB(0, 0), b2, voffB);
            PG8_BAR; PG8_WAIT_L(0); PG8_MMA(0, 1, At, B1); PG8_BAR;
            PG8_LDA(At, 0, 1); PG8_STAGE(PG8_SA(0, 0), a2, voffA);
            PG8_BAR; PG8_WAIT_L(0); PG8_MMA(1, 0, At, B0); PG8_BAR; PG8_SCHED;
            PG8_STAGE(PG8_SB(0, 1), b2 + hstep, voffB);
            PG8_WAIT_V(6); PG8_BAR; PG8_MMA(1, 1, At, B1); PG8_BAR;
            PG8_LDB(B0, 1, 0); PG8_SCHED; PG8_LDA(At, 1, 0); PG8_STAGE(PG8_SA(0, 1), a2 + hstep, voffA);
            PG8_WAIT_L(8); PG8_BAR; PG8_WAIT_L(0); PG8_MMA(0, 0, At, B0); PG8_BAR; PG8_SCHED;
            PG8_LDB(B1, 1, 1); PG8_STAGE(PG8_SB(1, 0), b3, voffB);
            PG8_BAR; PG8_WAIT_L(0); PG8_MMA(0, 1, At, B1); PG8_BAR;
            PG8_LDA(At, 1, 1); PG8_STAGE(PG8_SA(1, 0), a3, voffA);
            PG8_BAR; PG8_WAIT_L(0); PG8_MMA(1, 0, At, B0); PG8_BAR; PG8_SCHED;
            PG8_STAGE(PG8_SB(1, 1), b3 + hstep, voffB);
            PG8_WAIT_V(6); PG8_BAR; PG8_MMA(1, 1, At, B1); PG8_BAR;
            }
        }
        if constexpr (ALIGN_EPI) { if (wr == 0) PG8_BAR; }
        if constexpr (!Epi::AFTER_DRAIN) { E(acc, cur, wr, wc, fr, fq); S.done(cur); }
        if (!has_next) break;
        if (!Epi::KEEP_ACC || nxt.z == 0) {
#pragma unroll
        for (int a = 0; a < 2; ++a)
#pragma unroll
            for (int b = 0; b < 2; ++b)
#pragma unroll
                for (int m = 0; m < 4; ++m)
#pragma unroll
                    for (int n = 0; n < 2; ++n) acc[a][b][m][n] = (f32x4){0.f, 0.f, 0.f, 0.f};
        }
        cur = nxt; cA = nA; cB = nB; ++ui;
        if constexpr (ALIGN_EPI) { if (wr == 1) PG8_BAR; }
    }
    PG8_WAIT_V(0);
    if constexpr (!ALIGN_EPI) { if (wr == 0) PG8_BAR; }
    PG8_BAR;
    if constexpr (Epi::AFTER_DRAIN) { E.fused(acc, cur, wr, wc, fr, fq, lds, wid, lane); S.done(cur); }
#undef PG8_SA
#undef PG8_SB
#undef PG8_STAGE
#undef PG8_LDA
#undef PG8_LDB
#undef PG8_MMA
#undef PG8_WAIT_V
#undef PG8_WAIT_L
#undef PG8_BAR
#undef PG8_SCHED
}
}


constexpr int DM = 2048, NBATCH = 8, SEQ = 2048, CTXL = 256, SB = SEQ + CTXL  , R = NBATCH * SB  ;
constexpr int FFN = 5632, INC = 15360, NPAN = R / 256  ;
constexpr int C_AQ = 0, C_AK = 1024, C_AV = 2048, C_BQ = 3072, C_BK = 4096, C_BV = 5120, C_CQ = 6144, C_CK = 6656, C_CV = 7168, C_CG = 8192, C_GATE = 9216;
constexpr float EPS = 1e-6f, LOG2E = 1.4426950408889634f;
constexpr float SCALE_A = 0.125f * LOG2E, SCALE_B = 0.08838834764831845f * LOG2E, SCALE_CK = 0.125f;

#define GAS __attribute__((address_space(1)))
#define LAS __attribute__((address_space(3)))
typedef unsigned short bf16;
typedef unsigned v4u __attribute__((ext_vector_type(4)));
typedef unsigned v2u __attribute__((ext_vector_type(2)));
typedef float f32x4 __attribute__((ext_vector_type(4)));
typedef float f32x2 __attribute__((ext_vector_type(2)));
#define LDS_WAIT() asm volatile("s_waitcnt lgkmcnt(0)" ::: "memory")
#define VM_WAIT() asm volatile("s_waitcnt vmcnt(0)" ::: "memory")
__device__ __forceinline__ unsigned cvt_pk_bf16(float lo, float hi) { unsigned r; asm volatile("v_cvt_pk_bf16_f32 %0, %1, %2" : "=v"(r) : "v"(lo), "v"(hi)); return r; }
__device__ __forceinline__ float bflo(unsigned w) { return __uint_as_float(w << 16); }
__device__ __forceinline__ float bfhi(unsigned w) { return __uint_as_float(w & 0xffff0000u); }
__device__ __forceinline__ float bf1(bf16 w) { return __uint_as_float(((unsigned)w) << 16); }
__device__ __forceinline__ float sigm_f(float x) { return __builtin_amdgcn_rcpf(1.0f + __builtin_amdgcn_exp2f(-LOG2E * x)); }
__device__ __forceinline__ float silu_f(float x) { return x * sigm_f(x); }
__device__ __forceinline__ f32x4 swiglu4(f32x4 a, f32x4 b) {
    f32x4 e;
    e[0] = __builtin_amdgcn_exp2f(a[0]); e[1] = __builtin_amdgcn_exp2f(a[1]); e[2] = __builtin_amdgcn_exp2f(a[2]); e[3] = __builtin_amdgcn_exp2f(a[3]);
    e = e + 1.0f; f32x4 r;
    r[0] = __builtin_amdgcn_rcpf(e[0]); r[1] = __builtin_amdgcn_rcpf(e[1]); r[2] = __builtin_amdgcn_rcpf(e[2]); r[3] = __builtin_amdgcn_rcpf(e[3]);
    return (a * b) * r;
}
template <int M> __device__ __forceinline__ float swz_xor(float v) { return __builtin_bit_cast(float, __builtin_amdgcn_ds_swizzle(__builtin_bit_cast(int, v), 0x1f | (M << 10))); }
__device__ __forceinline__ float wave_sum(float v) {
    v += swz_xor<1>(v); v += swz_xor<2>(v); v += swz_xor<4>(v); v += swz_xor<8>(v); v += swz_xor<16>(v);
    auto rr = __builtin_amdgcn_permlane32_swap(__float_as_uint(v), __float_as_uint(v), false, false); return __uint_as_float(rr[0]) + __uint_as_float(rr[1]);
}
__device__ __forceinline__ float wave_max(float v) {
    v = fmaxf(v, swz_xor<1>(v)); v = fmaxf(v, swz_xor<2>(v)); v = fmaxf(v, swz_xor<4>(v)); v = fmaxf(v, swz_xor<8>(v)); v = fmaxf(v, swz_xor<16>(v));
    auto rr = __builtin_amdgcn_permlane32_swap(__float_as_uint(v), __float_as_uint(v), false, false); return fmaxf(__uint_as_float(rr[0]), __uint_as_float(rr[1]));
}
__device__ __forceinline__ float other_half(float v, bool lower) { auto rr = __builtin_amdgcn_permlane32_swap(__float_as_uint(v), __float_as_uint(v), false, false); return __uint_as_float(lower ? rr[1] : rr[0]); }

namespace ep {
using pg8::Unit; using pg8::BM; using pg8::HALF;
struct EpiF32 {
    static constexpr bool PERM = false, AFTER_DRAIN = false, KEEP_ACC = false;
    float* C; int ldc;
    __device__ __forceinline__ void operator()(const f32x4 (&acc)[2][2][4][2], const Unit& u, int wr, int wc, int fr, int fq) const {
        const int row0 = u.pm * BM + wr * 64 + fr, col0 = u.pn * BM + wc * 32 + 4 * fq;
#pragma unroll
        for (int ai = 0; ai < 2; ++ai)
#pragma unroll
            for (int m = 0; m < 4; ++m) { float* rowp = C + (size_t)(row0 + ai * HALF + m * 16) * ldc + col0;
#pragma unroll
                for (int bj = 0; bj < 2; ++bj)
#pragma unroll
                    for (int n = 0; n < 2; ++n) *(f32x4*)(rowp + bj * HALF + n * 16) = acc[ai][bj][m][n]; }
    }
};
struct EpiSwiGLU {
    static constexpr bool PERM = true, AFTER_DRAIN = false, KEEP_ACC = false;
    bf16* O;
    __device__ __forceinline__ void operator()(const f32x4 (&acc)[2][2][4][2], const Unit& u, int wr, int wc, int fr, int fq) const {
        const int row0 = u.pm * BM + wr * 64 + fr, col0 = u.pn * 128 + wc * 32 + 8 * fq;
#pragma unroll
        for (int ai = 0; ai < 2; ++ai)
#pragma unroll
            for (int m = 0; m < 4; ++m) { bf16* rowp = O + (size_t)(row0 + ai * HALF + m * 16) * FFN + col0;
                const f32x4 a0 = acc[ai][0][m][0], a1 = acc[ai][0][m][1], b0 = acc[ai][1][m][0], b1 = acc[ai][1][m][1];
                const f32x4 r0 = swiglu4(a0, b0), r1 = swiglu4(a1, b1);
                v4u w; w.x = cvt_pk_bf16(r0[0], r0[1]); w.y = cvt_pk_bf16(r0[2], r0[3]); w.z = cvt_pk_bf16(r1[0], r1[1]); w.w = cvt_pk_bf16(r1[2], r1[3]);
                *(v4u*)rowp = w; }
    }
};
struct EpiInProj {
    static constexpr bool PERM = true, AFTER_DRAIN = false, KEEP_ACC = false;
    bf16* O; const LAS f32x2* tab;
    __device__ __forceinline__ void operator()(const f32x4 (&acc)[2][2][4][2], const Unit& u, int wr, int wc, int fr, int fq) const {
        const int pj = u.pm % 9;
        const bool rope = ((u.pn < 8) || (u.pn >= 24 && u.pn < 28)) && (pj != 0);
        const bool gate = u.pn >= C_GATE / 256;
        const int row0 = u.pm * BM + wr * 64 + fr, col0 = u.pn * BM + wc * 32 + 8 * fq;
        const int t0 = (pj - 1) * 256 + wr * 64 + fr;
#pragma unroll
        for (int ai = 0; ai < 2; ++ai)
#pragma unroll
            for (int m = 0; m < 4; ++m) { bf16* rowp = O + (size_t)(row0 + ai * HALF + m * 16) * INC + col0;
                f32x2 cs[8];
                if (rope) { const int t = t0 + ai * HALF + m * 16, pos = (wc & 1) ? (t & 63) : (t >> 6); const LAS f32x4* tp = (const LAS f32x4*)(tab + pos * 16 + 8 * (fq & 1));
#pragma unroll
                    for (int q = 0; q < 4; ++q) { const f32x4 v = tp[q]; cs[2 * q] = (f32x2){v[0], v[1]}; cs[2 * q + 1] = (f32x2){v[2], v[3]}; } }
#pragma unroll
                for (int bj = 0; bj < 2; ++bj) { float v[8];
#pragma unroll
                    for (int j = 0; j < 4; ++j) { v[j] = acc[ai][bj][m][0][j]; v[4 + j] = acc[ai][bj][m][1][j]; }
                    if (rope) {
#pragma unroll
                        for (int j = 0; j < 8; ++j) { const float p = other_half(v[j], fq < 2); v[j] = (fq < 2) ? (v[j] * cs[j].x - p * cs[j].y) : (p * cs[j].y + v[j] * cs[j].x); } }
                    if (gate) {
#pragma unroll
                        for (int j = 0; j < 8; ++j) v[j] = 1.0f + __builtin_amdgcn_exp2f(-LOG2E * fminf(fmaxf(v[j], -60.f), 60.f)); }
                    v4u w; w.x = cvt_pk_bf16(v[0], v[1]); w.y = cvt_pk_bf16(v[2], v[3]); w.z = cvt_pk_bf16(v[4], v[5]); w.w = cvt_pk_bf16(v[6], v[7]);
                    *(v4u*)(rowp + bj * HALF) = w; } }
    }
};
struct EpiBf16 {
    static constexpr bool PERM = true, AFTER_DRAIN = false, KEEP_ACC = false;
    bf16* O; int ldc;
    __device__ __forceinline__ void operator()(const f32x4 (&acc)[2][2][4][2], const Unit& u, int wr, int wc, int fr, int fq) const {
        const int row0 = u.pm * BM + wr * 64 + fr, col0 = u.pn * BM + wc * 32 + 8 * fq;
#pragma unroll
        for (int ai = 0; ai < 2; ++ai)
#pragma unroll
            for (int m = 0; m < 4; ++m) { bf16* rowp = O + (size_t)(row0 + ai * HALF + m * 16) * ldc + col0;
#pragma unroll
                for (int bj = 0; bj < 2; ++bj) { const f32x4 v0 = acc[ai][bj][m][0], v1 = acc[ai][bj][m][1];
                    v4u w; w.x = cvt_pk_bf16(v0[0], v0[1]); w.y = cvt_pk_bf16(v0[2], v0[3]); w.z = cvt_pk_bf16(v1[0], v1[1]); w.w = cvt_pk_bf16(v1[2], v1[3]);
                    *(v4u*)(rowp + bj * HALF) = w; } }
    }
};
struct EpiMerge {
    static constexpr bool PERM = true, AFTER_DRAIN = false, KEEP_ACC = true;
    const bf16* G; bf16* MERGED;
    static __device__ __forceinline__ float e1(float x) { return 1.0f + __builtin_amdgcn_exp2f(-LOG2E * fminf(fmaxf(x, -60.f), 60.f)); }
    __device__ __forceinline__ void operator()(f32x4 (&acc)[2][2][4][2], const Unit& u, int wr, int wc, int fr, int fq) const {
        const int row0 = u.pm * BM + wr * 64 + fr, col0 = u.pn * BM + wc * 32 + 8 * fq, z = u.z;
        const bf16* Ga = G + z * DM + col0; const bf16* Gb = Ga + DM; bf16* Oz = MERGED + col0;
        v4u ga[2][2], gb[2][2];
#define MRG_ROW(b) ((size_t)(row0 + ((b) >> 2) * HALF + ((b) & 3) * 16))
#define MRG_LOAD(b, s) do { _Pragma("unroll") for (int bj = 0; bj < 2; ++bj) { ga[s][bj] = *(const v4u*)(Ga + MRG_ROW(b) * INC + bj * HALF); \
            if (z != 2) gb[s][bj] = *(const v4u*)(Gb + MRG_ROW(b) * INC + bj * HALF); } } while (0)
        MRG_LOAD(0, 0);
#pragma unroll
        for (int b = 0; b < 8; ++b) { const int cur = b & 1, ai = b >> 2, m = b & 3;
            if (b + 1 < 8) MRG_LOAD(b + 1, cur ^ 1);
#pragma unroll
            for (int bj = 0; bj < 2; ++bj) { const v4u A = ga[cur][bj];
                float f[8] = {bflo(A.x), bfhi(A.x), bflo(A.y), bfhi(A.y), bflo(A.z), bfhi(A.z), bflo(A.w), bfhi(A.w)};
#pragma unroll
                for (int j = 0; j < 8; ++j) f[j] = __builtin_amdgcn_rcpf(f[j]);
                if (z != 2) { const v4u B = gb[cur][bj];
                    f[0] *= bflo(B.x); f[1] *= bfhi(B.x); f[2] *= bflo(B.y); f[3] *= bfhi(B.y); f[4] *= bflo(B.z); f[5] *= bfhi(B.z); f[6] *= bflo(B.w); f[7] *= bfhi(B.w); }
                f32x4 v0 = acc[ai][bj][m][0], v1 = acc[ai][bj][m][1];
                v0[0] *= f[0]; v0[1] *= f[1]; v0[2] *= f[2]; v0[3] *= f[3]; v1[0] *= f[4]; v1[1] *= f[5]; v1[2] *= f[6]; v1[3] *= f[7];
                if (z != 2) { acc[ai][bj][m][0] = v0; acc[ai][bj][m][1] = v1; }
                else { v4u w; w.x = cvt_pk_bf16(v0[0], v0[1]); w.y = cvt_pk_bf16(v0[2], v0[3]); w.z = cvt_pk_bf16(v1[0], v1[1]); w.w = cvt_pk_bf16(v1[2], v1[3]);
                    *(v4u*)(Oz + MRG_ROW(b) * DM + bj * HALF) = w; } } }
#undef MRG_ROW
#undef MRG_LOAD
    }
};
struct EpiF32Part {
    static constexpr bool PERM = false, AFTER_DRAIN = false, KEEP_ACC = false;
    float* YP;
    __device__ __forceinline__ void operator()(const f32x4 (&acc)[2][2][4][2], const Unit& u, int wr, int wc, int fr, int fq) const {
        const int row0 = (u.pm / 9) * BM + wr * 64 + fr, col0 = u.pn * BM + wc * 32 + 4 * fq;
        float* base = YP + (size_t)u.z * ((size_t)NBATCH * CTXL * DM);
#pragma unroll
        for (int ai = 0; ai < 2; ++ai)
#pragma unroll
            for (int m = 0; m < 4; ++m) { float* rowp = base + (size_t)(row0 + ai * HALF + m * 16) * DM + col0;
#pragma unroll
                for (int bj = 0; bj < 2; ++bj)
#pragma unroll
                    for (int n = 0; n < 2; ++n) *(f32x4*)(rowp + bj * HALF + n * 16) = acc[ai][bj][m][n]; }
    }
};
struct EpiNull {
    static constexpr bool PERM = true, AFTER_DRAIN = false, KEEP_ACC = false;
    bf16* O;
    __device__ __forceinline__ void operator()(const f32x4 (&acc)[2][2][4][2], const Unit& u, int wr, int wc, int fr, int fq) const {
        float s = 0.f;
#pragma unroll
        for (int ai = 0; ai < 2; ++ai)
#pragma unroll
            for (int bj = 0; bj < 2; ++bj)
#pragma unroll
                for (int m = 0; m < 4; ++m)
#pragma unroll
                    for (int n = 0; n < 2; ++n) s += acc[ai][bj][m][n][0] + acc[ai][bj][m][n][1] + acc[ai][bj][m][n][2] + acc[ai][bj][m][n][3];
        if (s == 1234.56789f) O[u.pm * 4096 + u.pn + wr + wc + fr + fq] = 1;
    }
};
struct EpiYMix {
    static constexpr bool PERM = true, AFTER_DRAIN = false, KEEP_ACC = false;
    bf16* O; bf16* YP;
    __device__ __forceinline__ void operator()(const f32x4 (&acc)[2][2][4][2], const Unit& u, int wr, int wc, int fr, int fq) const {
        const int col0 = u.pn * BM + wc * 32 + 8 * fq;
        if (u.kt == 0) { const int row0 = u.pm * BM + wr * 64 + fr;
#pragma unroll
            for (int ai = 0; ai < 2; ++ai)
#pragma unroll
                for (int m = 0; m < 4; ++m) { bf16* rowp = O + (size_t)(row0 + ai * HALF + m * 16) * DM + col0;
#pragma unroll
                    for (int bj = 0; bj < 2; ++bj) { const f32x4 v0 = acc[ai][bj][m][0], v1 = acc[ai][bj][m][1];
                        v4u w; w.x = cvt_pk_bf16(v0[0], v0[1]); w.y = cvt_pk_bf16(v0[2], v0[3]); w.z = cvt_pk_bf16(v1[0], v1[1]); w.w = cvt_pk_bf16(v1[2], v1[3]);
                        *(v4u*)(rowp + bj * HALF) = w; } } }
        else { const int row0 = (u.pm / 9) * BM + wr * 64 + fr; bf16* base = YP + (size_t)u.z * ((size_t)NBATCH * CTXL * DM);
#pragma unroll
            for (int ai = 0; ai < 2; ++ai)
#pragma unroll
                for (int m = 0; m < 4; ++m) { bf16* rowp = base + (size_t)(row0 + ai * HALF + m * 16) * DM + col0;
#pragma unroll
                    for (int bj = 0; bj < 2; ++bj) { const f32x4 v0 = acc[ai][bj][m][0], v1 = acc[ai][bj][m][1];
                        v4u w; w.x = cvt_pk_bf16(v0[0], v0[1]); w.y = cvt_pk_bf16(v0[2], v0[3]); w.z = cvt_pk_bf16(v1[0], v1[1]); w.w = cvt_pk_bf16(v1[2], v1[3]);
                        *(v4u*)(rowp + bj * HALF) = w; } } }
    }
};
}

constexpr size_t MiB = 1u << 20;
constexpr size_t WS_CTL = 0, CTL_ZERO_BYTES = 1 * MiB;
constexpr size_t WS_MOD = 1 * MiB;
constexpr size_t WS_TAB = 3 * MiB;
constexpr size_t WS_HC = 4 * MiB;
constexpr size_t WS_U = 20 * MiB;
constexpr size_t WS_OA = 92 * MiB, WS_OB = 128 * MiB, WS_YR = 164 * MiB;
constexpr size_t WS_MACC = 200 * MiB;
constexpr size_t WS_WT = 344 * MiB;
constexpr size_t WT_W1A = 0, WT_W1B = 44 * MiB, WT_W2A = 88 * MiB, WT_W2B = 110 * MiB, WT_IN = 132 * MiB, WT_WB = 192 * MiB, WT_WO = 204 * MiB, WT_BYTES = 212 * MiB;
constexpr size_t WS_R1 = 556 * MiB;
constexpr size_t R1_ACT = 0, R1_Y = 198 * MiB;
constexpr size_t WS_WT1 = 1096 * MiB;
constexpr size_t WS_END = 1308 * MiB;
static_assert((size_t)R * DM * 2 == 72 * MiB && (size_t)R * 1024 * 2 == 36 * MiB && (size_t)R * DM * 4 == 144 * MiB && (size_t)R * INC * 2 == 540 * MiB && (size_t)R * FFN * 2 == 198 * MiB, "sizes");
static_assert((size_t)2 * FFN * DM * 2 == 44 * MiB && (size_t)INC * DM * 2 == 60 * MiB && (size_t)3 * DM * 1024 * 2 == 12 * MiB, "weight sizes");
constexpr int CW_TMO = 0, CW_BAR = 4096;

constexpr int RING_BYTES = 135168;
constexpr int LDSCTL_OFF = RING_BYTES, MISC_OFF = LDSCTL_OFF + 320, LTAB_OFF = LDSCTL_OFF + 1024;
constexpr int LDS_BYTES = 147456;
static_assert(LTAB_OFF + 8192 <= LDS_BYTES && LDS_BYTES <= 163840, "LDS map");
constexpr int NWAVES = 8, GRID = 256;
#ifndef BSD
#define BSD 1
#endif

#define XB_TMO      128
#define XB_XCNT(j)  (256  + 64 * (j))
#define XB_XSUB(j)  (1280 + 64 * (j))
#define XB_XGEN(j)  (2304 + 64 * (j))
#define XB_TOP      3328
#define XB_TOPGEN   3392
#define XCD_BAR_WORDS 3456
#define XB_SPIN_CAP (1u << 21)

__device__ __forceinline__ unsigned xb_ld(unsigned* p)              { return __hip_atomic_load(p, __ATOMIC_RELAXED, __HIP_MEMORY_SCOPE_AGENT); }
__device__ __forceinline__ unsigned xb_add(unsigned* p, unsigned v) { return __hip_atomic_fetch_add(p, v, __ATOMIC_RELAXED, __HIP_MEMORY_SCOPE_AGENT); }
__device__ __forceinline__ unsigned xb_xcc_id() { return (unsigned)__builtin_amdgcn_s_getreg((3 << 11) | 20) & 0xFu; }
#define XB_SPIN(cond, bar) do { unsigned _sp = 0; while (cond) { __builtin_amdgcn_s_sleep(1); \
    if ((++_sp & 255u) == 0u) { if (xb_ld(&(bar)[XB_TMO])) break; if (_sp > XB_SPIN_CAP) { atomicAdd(&(bar)[XB_TMO], 1u); break; } } } } while (0)

struct XcdBarrier {
    unsigned* bar; unsigned x;
    volatile LAS unsigned* st;
};

__device__ __forceinline__ XcdBarrier xcd_barrier_post(unsigned* bar, volatile LAS unsigned* st) {
    XcdBarrier b; b.bar = bar; b.x = xb_xcc_id(); b.st = st;
    if (threadIdx.x == 0) (void)xb_add(&bar[XB_XCNT(b.x)], 1u);
    return b;
}
__device__ __forceinline__ void xcd_barrier_complete(unsigned* bar, unsigned x, unsigned& nloc, unsigned& nx) {
    const unsigned G = gridDim.x * gridDim.y * gridDim.z;
    unsigned sum, cnt, mine, sp = 0u;
    for (;;) {
        sum = 0u; cnt = 0u; mine = 0u;
#pragma unroll
        for (unsigned j = 0; j < 16; ++j) { const unsigned c = xb_ld(&bar[XB_XCNT(j)]); sum += c; cnt += (c > 0u) ? 1u : 0u; mine = (j == x) ? c : mine; }
        if (sum == G) break;
        __builtin_amdgcn_s_sleep(1);
        if ((++sp & 255u) == 0u) { if (xb_ld(&bar[XB_TMO])) break; if (sp > XB_SPIN_CAP) { atomicAdd(&bar[XB_TMO], 1u); break; } }
    }
    nloc = mine > 0u ? mine : 1u; nx = cnt > 0u ? cnt : 1u;
}

__device__ __forceinline__ void xcd_barrier(const XcdBarrier& b) {
    asm volatile("s_waitcnt vmcnt(0)" ::: "memory");
    __syncthreads();
    if (threadIdx.x == 0) {
        unsigned* bar = b.bar;
        __builtin_amdgcn_s_waitcnt(0);
        unsigned nloc = b.st[0], nx = b.st[1];
        if (nloc == 0u) { xcd_barrier_complete(bar, b.x, nloc, nx); b.st[0] = nloc; b.st[1] = nx; }
        const unsigned old = xb_add(&bar[XB_XSUB(b.x)], 1u);
        const unsigned gen = old / nloc;
        if (old + 1u == (gen + 1u) * nloc) {
            __builtin_amdgcn_fence(__ATOMIC_RELEASE, "agent");
            asm volatile("s_waitcnt vmcnt(0)" ::: "memory");
            const unsigned og = xb_add(&bar[XB_TOP], 1u);
            const unsigned tg = og / nx;
            if (og + 1u == (tg + 1u) * nx) xb_add(&bar[XB_TOPGEN], 1u);
            else XB_SPIN(xb_ld(&bar[XB_TOPGEN]) == tg, bar);
            __builtin_amdgcn_fence(__ATOMIC_ACQUIRE, "agent");
            xb_add(&bar[XB_XGEN(b.x)], 1u);
            asm volatile("s_waitcnt vmcnt(0)" ::: "memory");
        } else {
            XB_SPIN(xb_ld(&bar[XB_XGEN(b.x)]) == gen, bar);
            __builtin_amdgcn_fence(__ATOMIC_ACQUIRE, "agent");
            asm volatile("s_waitcnt vmcnt(0)" ::: "memory");
        }
    }
    __syncthreads();
}


__device__ __forceinline__ unsigned f2bf(float f) { unsigned u = __builtin_bit_cast(unsigned, f); return (u + 0x7fffu + ((u >> 16) & 1u)) >> 16; }
__device__ __forceinline__ unsigned pk2(float lo, float hi) { return f2bf(lo) | (f2bf(hi) << 16); }
__device__ __forceinline__ void transpose_item(const float* W, int K, int N, bf16* WT, int k0, int n0, int orow0, float scale, LAS float* scr, int lane) {
    { float v[32];
      const float* src = W + (size_t)(k0 + (lane >> 5)) * N + n0 + (lane & 31);
#pragma unroll
      for (int i = 0; i < 32; ++i) v[i] = __builtin_nontemporal_load(src + (size_t)(2 * i) * N);
#pragma unroll
      for (int i = 0; i < 32; ++i) scr[(2 * i + (lane >> 5)) * 33 + (lane & 31)] = v[i]; }
    LDS_WAIT(); asm volatile("" ::: "memory");
    const int c = lane & 7;
#pragma unroll
    for (int j = 0; j < 4; ++j) { const int n = (lane >> 3) + 8 * j; const LAS float* s = scr + (8 * c) * 33 + n;
        v4u o; o.x = pk2(s[0 * 33] * scale, s[1 * 33] * scale); o.y = pk2(s[2 * 33] * scale, s[3 * 33] * scale); o.z = pk2(s[4 * 33] * scale, s[5 * 33] * scale); o.w = pk2(s[6 * 33] * scale, s[7 * 33] * scale);
        *(GAS v4u*)(WT + (size_t)(orow0 + n) * K + k0 + 8 * c) = o; }
    LDS_WAIT(); asm volatile("" ::: "memory");
}

struct Args { const float* in[18]; float* out; unsigned char* ws; };

template <int N> __device__ __forceinline__ void load_q(float (&q)[N], const bf16* p) {
#pragma unroll
    for (int c = 0; c < N / 8; ++c) { const v4u w = *(const v4u*)(p + 8 * c);
        q[8 * c + 0] = bflo(w.x); q[8 * c + 1] = bfhi(w.x); q[8 * c + 2] = bflo(w.y); q[8 * c + 3] = bfhi(w.y); q[8 * c + 4] = bflo(w.z); q[8 * c + 5] = bfhi(w.z); q[8 * c + 6] = bflo(w.w); q[8 * c + 7] = bfhi(w.w); }
}
template <int N> __device__ __forceinline__ float dot_q(const float (&q)[N], const bf16* k) {
    float s0 = 0.f, s1 = 0.f;
#pragma unroll
    for (int c = 0; c < N / 8; ++c) { const v4u w = *(const v4u*)(k + 8 * c);
        s0 += q[8 * c + 0] * bflo(w.x); s1 += q[8 * c + 1] * bfhi(w.x); s0 += q[8 * c + 2] * bflo(w.y); s1 += q[8 * c + 3] * bfhi(w.y);
        s0 += q[8 * c + 4] * bflo(w.z); s1 += q[8 * c + 5] * bfhi(w.z); s0 += q[8 * c + 6] * bflo(w.w); s1 += q[8 * c + 7] * bfhi(w.w); }
    return s0 + s1;
}
__device__ __forceinline__ float softmax_buf(LAS float* buf, int nk, float mx, int lane) {
    mx = wave_max(mx); float sum = 0.f;
    for (int j = lane; j < nk; j += 64) { const float e = __builtin_amdgcn_exp2f(buf[j] - mx); buf[j] = e; sum += e; }
    sum = wave_sum(sum); LDS_WAIT();
    return 1.0f / sum;
}

namespace att {
using bf16x8 = __attribute__((ext_vector_type(8))) short;
using s16x4  = __attribute__((ext_vector_type(4))) short;
using f32x16 = __attribute__((ext_vector_type(16))) float;
constexpr int LDP = INC;
constexpr int L_V = 0, L_K = 32768, L_WS = 65536, L_RPB = 67584, L_STASH = 69632, L_OEPI = 16896;
static_assert(L_STASH + 8 * 8192 <= RING_BYTES && 8 * L_OEPI <= RING_BYTES, "attention LDS map");
constexpr float THR2 = 11.541560327111707f;
#define SBAR() __builtin_amdgcn_sched_barrier(0)
#ifndef A_RING3
#define A_RING3 1
#endif
#ifndef B_RING3
#define B_RING3 1
#endif
__device__ __forceinline__ int crow(int r, int hi) { return (r & 3) + 8 * (r >> 2) + 4 * hi; }
template <int DK> __device__ __forceinline__ int kswz(int row, int colB) { return row * (2 * DK) + (colB ^ ((DK == 64 ? ((row >> 1) & 7) : (row & 15)) << 4)); }
__device__ __forceinline__ int v_st(int k, int c) { const int kk = (k & ~0xC) | ((k & 4) << 1) | ((k & 8) >> 1); return ((kk >> 3) * 4 + (c >> 5)) * 512 + ((kk & 7) * 32 + (c & 31)) * 2; }
__device__ __forceinline__ int v_rd_base(int lane) { return ((lane & 3) << 3) | (((lane >> 2) & 3) << 6) | (((lane >> 4) & 1) << 5) | (((lane >> 5) & 1) << 8); }
constexpr int v_rd_off(int d0, int ks, int half) { return d0 * 512 + ks * 4096 + half * 2048; }
template <int OFF> __device__ __forceinline__ s16x4 tr_read(int vb) { s16x4 r; asm volatile("ds_read_b64_tr_b16 %0, %1 offset:%2" : "=&v"(r) : "v"(vb), "i"(OFF) : "memory"); return r; }
template <int D0> __device__ __forceinline__ void pv_one(f32x16& od, int vb, bf16x8 pa0, bf16x8 pa1, bf16x8 pa2, bf16x8 pa3) {
    const s16x4 l0 = tr_read<v_rd_off(D0, 0, 0)>(vb), h0 = tr_read<v_rd_off(D0, 0, 1)>(vb), l1 = tr_read<v_rd_off(D0, 1, 0)>(vb), h1 = tr_read<v_rd_off(D0, 1, 1)>(vb);
    const s16x4 l2 = tr_read<v_rd_off(D0, 2, 0)>(vb), h2 = tr_read<v_rd_off(D0, 2, 1)>(vb), l3 = tr_read<v_rd_off(D0, 3, 0)>(vb), h3 = tr_read<v_rd_off(D0, 3, 1)>(vb);
    asm volatile("s_waitcnt lgkmcnt(0)" ::: "memory"); SBAR();
#define PK(L, H) (bf16x8){L[0], L[1], L[2], L[3], H[0], H[1], H[2], H[3]}
    od = __builtin_amdgcn_mfma_f32_32x32x16_bf16(pa0, PK(l0, h0), od, 0, 0, 0);
    od = __builtin_amdgcn_mfma_f32_32x32x16_bf16(pa1, PK(l1, h1), od, 0, 0, 0);
    od = __builtin_amdgcn_mfma_f32_32x32x16_bf16(pa2, PK(l2, h2), od, 0, 0, 0);
    od = __builtin_amdgcn_mfma_f32_32x32x16_bf16(pa3, PK(l3, h3), od, 0, 0, 0);
#undef PK
}
#ifndef PV_PIPE
#define PV_PIPE 1
#endif
template <int D0> __device__ __forceinline__ void pv_reads(int vb, s16x4 (&f)[8]) {
    f[0] = tr_read<v_rd_off(D0, 0, 0)>(vb); f[1] = tr_read<v_rd_off(D0, 0, 1)>(vb); f[2] = tr_read<v_rd_off(D0, 1, 0)>(vb); f[3] = tr_read<v_rd_off(D0, 1, 1)>(vb);
    f[4] = tr_read<v_rd_off(D0, 2, 0)>(vb); f[5] = tr_read<v_rd_off(D0, 2, 1)>(vb); f[6] = tr_read<v_rd_off(D0, 3, 0)>(vb); f[7] = tr_read<v_rd_off(D0, 3, 1)>(vb);
}
__device__ __forceinline__ void pv_mma(f32x16& od, const s16x4 (&f)[8], bf16x8 pa0, bf16x8 pa1, bf16x8 pa2, bf16x8 pa3) {
#define PK(L, H) (bf16x8){L[0], L[1], L[2], L[3], H[0], H[1], H[2], H[3]}
    od = __builtin_amdgcn_mfma_f32_32x32x16_bf16(pa0, PK(f[0], f[1]), od, 0, 0, 0);
    od = __builtin_amdgcn_mfma_f32_32x32x16_bf16(pa1, PK(f[2], f[3]), od, 0, 0, 0);
    od = __builtin_amdgcn_mfma_f32_32x32x16_bf16(pa2, PK(f[4], f[5]), od, 0, 0, 0);
    od = __builtin_amdgcn_mfma_f32_32x32x16_bf16(pa3, PK(f[6], f[7]), od, 0, 0, 0);
#undef PK
}
__device__ __forceinline__ void pv_d0(f32x16* o, int vb, bf16x8 pa0, bf16x8 pa1, bf16x8 pa2, bf16x8 pa3) {
#if PV_PIPE
    s16x4 fa[8], fb[8];
    pv_reads<0>(vb, fa); pv_reads<1>(vb, fb);
    asm volatile("s_waitcnt lgkmcnt(8)" ::: "memory"); SBAR(); pv_mma(o[0], fa, pa0, pa1, pa2, pa3); SBAR();
    pv_reads<2>(vb, fa);
    asm volatile("s_waitcnt lgkmcnt(8)" ::: "memory"); SBAR(); pv_mma(o[1], fb, pa0, pa1, pa2, pa3); SBAR();
    pv_reads<3>(vb, fb);
    asm volatile("s_waitcnt lgkmcnt(8)" ::: "memory"); SBAR(); pv_mma(o[2], fa, pa0, pa1, pa2, pa3); SBAR();
    asm volatile("s_waitcnt lgkmcnt(0)" ::: "memory"); SBAR(); pv_mma(o[3], fb, pa0, pa1, pa2, pa3);
#else
    pv_one<0>(o[0], vb, pa0, pa1, pa2, pa3); pv_one<1>(o[1], vb, pa0, pa1, pa2, pa3); pv_one<2>(o[2], vb, pa0, pa1, pa2, pa3); pv_one<3>(o[3], vb, pa0, pa1, pa2, pa3);
#endif
}
#define MF1(OD, PA, L, H) OD = __builtin_amdgcn_mfma_f32_32x32x16_bf16(PA, (bf16x8){L[0], L[1], L[2], L[3], H[0], H[1], H[2], H[3]}, OD, 0, 0, 0)
__device__ __forceinline__ void pv_sm(f32x16* o, int vb, bf16x8 pa0, bf16x8 pa1, bf16x8 pa2, bf16x8 pa3, f32x16& p0, f32x16& p1, float& m_reg, float& mn, float& alpha) {
    s16x4 fa[8], fb[8];
    pv_reads<0>(vb, fa); pv_reads<1>(vb, fb);
    asm volatile("s_waitcnt lgkmcnt(8)" ::: "memory"); SBAR();
    float pmax = p0[0];
    MF1(o[0], pa0, fa[0], fa[1]); SBAR();
#pragma unroll
    for (int r = 1; r < 8; ++r) pmax = fmaxf(pmax, p0[r]);
    SBAR(); MF1(o[0], pa1, fa[2], fa[3]); SBAR();
#pragma unroll
    for (int r = 8; r < 16; ++r) pmax = fmaxf(pmax, p0[r]);
    SBAR(); MF1(o[0], pa2, fa[4], fa[5]); SBAR();
#pragma unroll
    for (int r = 0; r < 8; ++r) pmax = fmaxf(pmax, p1[r]);
    SBAR(); MF1(o[0], pa3, fa[6], fa[7]); SBAR();
#pragma unroll
    for (int r = 8; r < 16; ++r) pmax = fmaxf(pmax, p1[r]);
    SBAR();
    pv_reads<2>(vb, fa);
    { auto rr = __builtin_amdgcn_permlane32_swap(__float_as_uint(pmax), __float_as_uint(pmax), false, false); pmax = fmaxf(__uint_as_float(rr[0]), __uint_as_float(rr[1])); }
    if (__builtin_expect(__all(pmax - m_reg <= THR2), 1)) { mn = m_reg; alpha = 1.f; }
    else { mn = fmaxf(m_reg, pmax); alpha = __builtin_amdgcn_exp2f(m_reg - mn); m_reg = mn; }
    asm volatile("s_waitcnt lgkmcnt(8)" ::: "memory"); SBAR();
#define EX2(R) do { float t_ = __builtin_amdgcn_exp2f(p0[R] - mn); asm volatile("" : "+v"(t_)); p0[R] = t_; } while (0)
#define SB2(R) do { float t_ = p1[R] - mn; asm volatile("" : "+v"(t_)); p1[R] = t_; } while (0)
    MF1(o[1], pa0, fb[0], fb[1]); SBAR(); EX2(0); EX2(1); SBAR();
    MF1(o[1], pa1, fb[2], fb[3]); SBAR(); EX2(2); EX2(3); SBAR();
    MF1(o[1], pa2, fb[4], fb[5]); SBAR(); EX2(4); EX2(5); SBAR();
    MF1(o[1], pa3, fb[6], fb[7]); SBAR(); EX2(6); EX2(7); SBAR();
    pv_reads<3>(vb, fb);
    asm volatile("s_waitcnt lgkmcnt(8)" ::: "memory"); SBAR();
    MF1(o[2], pa0, fa[0], fa[1]); SBAR(); EX2(8); SB2(0); SB2(1); SBAR();
    MF1(o[2], pa1, fa[2], fa[3]); SBAR(); EX2(9); SB2(2); SB2(3); SBAR();
    MF1(o[2], pa2, fa[4], fa[5]); SBAR(); EX2(10); SB2(4); SB2(5); SBAR();
    MF1(o[2], pa3, fa[6], fa[7]); SBAR(); EX2(11); SB2(6); SB2(7); SBAR();
    asm volatile("s_waitcnt lgkmcnt(0)" ::: "memory"); SBAR();
    MF1(o[3], pa0, fb[0], fb[1]); SBAR(); EX2(12); SB2(8); SB2(9); SBAR();
    MF1(o[3], pa1, fb[2], fb[3]); SBAR(); EX2(13); SB2(10); SB2(11); SBAR();
    MF1(o[3], pa2, fb[4], fb[5]); SBAR(); EX2(14); SB2(12); SB2(13); SBAR();
    MF1(o[3], pa3, fb[6], fb[7]); SBAR(); EX2(15); SB2(14); SB2(15); SBAR();
#undef EX2
#undef SB2
}
#undef MF1
template <int DK> __device__ __forceinline__ void qkt(f32x16& p0, f32x16& p1, const LAS unsigned char* Ks, const bf16x8* qr, int r32, int hi) {
    p0 = f32x16{}; p1 = f32x16{};
#pragma unroll
    for (int d0 = 0; d0 < DK / 16; ++d0) { const int cb = (d0 * 16 + hi * 8) * 2;
        const bf16x8 b0 = *(const LAS bf16x8*)(Ks + kswz<DK>(r32, cb)), b1 = *(const LAS bf16x8*)(Ks + kswz<DK>(32 + r32, cb));
        p0 = __builtin_amdgcn_mfma_f32_32x32x16_bf16(b0, qr[d0], p0, 0, 0, 0);
        p1 = __builtin_amdgcn_mfma_f32_32x32x16_bf16(b1, qr[d0], p1, 0, 0, 0); }
}
__device__ __forceinline__ void pack_p(const f32x16& p0, const f32x16& p1, bf16x8& pa0, bf16x8& pa1, bf16x8& pa2, bf16x8& pa3) {
#define PK4(P, BASE, OUT) do { unsigned a0 = cvt_pk_bf16(P[BASE + 0], P[BASE + 1]), a1 = cvt_pk_bf16(P[BASE + 2], P[BASE + 3]);   \
    unsigned b0 = cvt_pk_bf16(P[BASE + 4], P[BASE + 5]), b1 = cvt_pk_bf16(P[BASE + 6], P[BASE + 7]);                              \
    auto r0 = __builtin_amdgcn_permlane32_swap(a0, b0, false, false); auto r1 = __builtin_amdgcn_permlane32_swap(a1, b1, false, false); \
    v4u w = {r0[0], r1[0], r0[1], r1[1]}; OUT = *reinterpret_cast<bf16x8*>(&w); } while (0)
    PK4(p0, 0, pa0); PK4(p0, 8, pa1); PK4(p1, 0, pa2); PK4(p1, 8, pa3);
#undef PK4
}
__device__ __forceinline__ void sm_part(f32x16& p0, f32x16& p1, float& m_reg, float& mn, float& alpha) {
    float pmax = p0[0];
#pragma unroll
    for (int r = 1; r < 16; ++r) pmax = fmaxf(pmax, p0[r]);
#pragma unroll
    for (int r = 0; r < 16; ++r) pmax = fmaxf(pmax, p1[r]);
    { auto rr = __builtin_amdgcn_permlane32_swap(__float_as_uint(pmax), __float_as_uint(pmax), false, false); pmax = fmaxf(__uint_as_float(rr[0]), __uint_as_float(rr[1])); }
    if (__builtin_expect(__all(pmax - m_reg <= THR2), 1)) { mn = m_reg; alpha = 1.f; }
    else { mn = fmaxf(m_reg, pmax); alpha = __builtin_amdgcn_exp2f(m_reg - mn); m_reg = mn; }
#pragma unroll
    for (int r = 0; r < 16; ++r) { p0[r] = __builtin_amdgcn_exp2f(p0[r] - mn); p1[r] = p1[r] - mn; }
}
__device__ __forceinline__ void sm_fin(f32x16& p0, f32x16& p1, float alpha, float& l_reg, bf16x8& pa0, bf16x8& pa1, bf16x8& pa2, bf16x8& pa3) {
#pragma unroll
    for (int r = 0; r < 16; ++r) p1[r] = __builtin_amdgcn_exp2f(p1[r]);
    float ps = 0.f;
#pragma unroll
    for (int r = 0; r < 16; ++r) ps += p0[r];
#pragma unroll
    for (int r = 0; r < 16; ++r) ps += p1[r];
    { auto rr = __builtin_amdgcn_permlane32_swap(__float_as_uint(ps), __float_as_uint(ps), false, false); ps = __uint_as_float(rr[0]) + __uint_as_float(rr[1]); }
    l_reg = l_reg * alpha + ps;
    pack_p(p0, p1, pa0, pa1, pa2, pa3);
}
__device__ __forceinline__ void b_mask(f32x16& p0, f32x16& p1, int j, const LAS float* tab, int kr0, int nkr, int qrow, int rs, int qc, int cst, int hi) {
    const int jj = j - 4, kr = kr0 + (jj < nkr ? jj : nkr - 1);
    const bool rowok = (jj < nkr) && (kr >= rs) && (kr < rs + 8);
    const float NEG = -INFINITY;
    if (!rowok) {
#pragma unroll
        for (int r = 0; r < 16; ++r) { p0[r] = NEG; p1[r] = NEG; }
        return; }
    const int base = (kr - qrow + 7) * 31 + 15 - qc + 4 * hi, cb = 4 * hi - cst;
#pragma unroll
    for (int q = 0; q < 4; ++q) {
        float b0[4], b1[4];
#pragma unroll
        for (int e = 0; e < 4; ++e) { b0[e] = tab[base + 8 * q + e]; b1[e] = tab[base + 8 * q + e + 32]; }
        asm volatile("" : "+v"(b0[0]), "+v"(b0[1]), "+v"(b0[2]), "+v"(b0[3]), "+v"(b1[0]), "+v"(b1[1]), "+v"(b1[2]), "+v"(b1[3]));
#pragma unroll
        for (int e = 0; e < 4; ++e) { const int r = 4 * q + e, cr = 8 * q + e;
            p0[r] = ((unsigned)(cr + cb) < 16u) ? p0[r] + b0[e] : NEG;
            p1[r] = ((unsigned)(cr + 32 + cb) < 16u) ? p1[r] + b1[e] : NEG; }
    }
}
__device__ __forceinline__ void c_weight(f32x16& p, int half, int kind, float base, float lf, float lb, const LAS float* tab) {
    if (kind == 3) {
#pragma unroll
        for (int r = 0; r < 16; ++r) { const float df = base - (float)((r & 3) + 8 * (r >> 2) + 32 * half), db = -df;
            const float w = (df >= 0.f ? __builtin_amdgcn_exp2f(lf * df) : 0.f) + (db >= 0.f ? __builtin_amdgcn_exp2f(lb * db) : 0.f); p[r] *= w; }
        return; }
    if (kind == 1) { const float af = __builtin_amdgcn_exp2f(lf * base);
#pragma unroll
        for (int q = 0; q < 4; ++q) { const f32x4 t = *(const LAS f32x4*)(tab + half * 16 + 4 * q);
#pragma unroll
            for (int e = 0; e < 4; ++e) p[4 * q + e] *= af * t[e]; } }
    else if (kind == 2) { const float ab = __builtin_amdgcn_exp2f(-lb * base);
#pragma unroll
        for (int q = 0; q < 4; ++q) { const f32x4 t = *(const LAS f32x4*)(tab + 32 + half * 16 + 4 * q);
#pragma unroll
            for (int e = 0; e < 4; ++e) p[4 * q + e] *= ab * t[e]; } }
    else { const float af = __builtin_amdgcn_exp2f(lf * base), ab = __builtin_amdgcn_exp2f(lb * ((float)SB - base));
#pragma unroll
        for (int q = 0; q < 4; ++q) { const f32x4 t = *(const LAS f32x4*)(tab + half * 16 + 4 * q), u = *(const LAS f32x4*)(tab + 32 + half * 16 + 4 * q);
#pragma unroll
            for (int e = 0; e < 4; ++e) p[4 * q + e] *= af * t[e] + ab * u[e]; } }
}

struct UnitD { const bf16* Q; const bf16* K; const bf16* V; int row_base, off, cap, NT; };
struct ModeP { int plain, kr0, nkr, qr0; const float* rpb; float lf, lb; int sq0, latq; };

template <int DK, int MODE, int SDEPTH>
__device__ __forceinline__ void attn_core(LAS unsigned char* lds, const UnitD& ud, const ModeP& mp, f32x16 (&o)[4], int tid) {
    const int wid = __builtin_amdgcn_readfirstlane(tid >> 6), lane = tid & 63, r32 = lane & 31, hi = lane >> 5;
    LAS unsigned char* Vl = lds + L_V; LAS unsigned char* Kl = lds + L_K;
    LAS float* wsf = (LAS float*)(lds + L_WS) + wid * 64; LAS float* li_l = wsf; LAS float* al_l = wsf + 32;
    const LAS float* rtab = (const LAS float*)(lds + L_RPB);
    float m_reg = -1e30f, l_reg = 0.f;
#pragma unroll
    for (int d = 0; d < 4; ++d) o[d] = f32x16{};
    bf16x8 qr[DK / 16];
    { const bf16* Qw = ud.Q + (size_t)(wid * 32 + r32) * LDP + hi * 8;
#pragma unroll
      for (int d0 = 0; d0 < DK / 16; ++d0) qr[d0] = *(const bf16x8*)(Qw + d0 * 16); }
    const int sr = tid >> 4, sc = (tid & 15) * 8, vst0 = v_st(sr, sc), vst1 = v_st(32 + sr, sc);
    const int kr64 = tid >> 3, kc64 = (tid & 7) * 8;
    const int vb0 = (int)(unsigned)(unsigned long)Vl + v_rd_base(lane);
    const int qc = 32 * (wid & 1) + r32, qrow = mp.qr0 + (wid >> 1), rs = min(max(qrow - 4, 0), 24), cst = min(max(qc - 8, 0), 48);
    const int s_lo = mp.sq0 + wid * 32, si = s_lo + r32;
    bf16x8 vs0[SDEPTH], vs1[SDEPTH], ks0[SDEPTH], ks1[SDEPTH];
#define TROW(j_) (ud.row_base + 64 * ((j_) < 4 ? (j_) : ud.off + min((j_) - 4, ud.cap)))
#define SLOAD(i, j_) do { const int tr_ = TROW(j_); \
        vs0[i] = *(const bf16x8*)(ud.V + (size_t)(tr_ + sr) * LDP + sc); vs1[i] = *(const bf16x8*)(ud.V + (size_t)(tr_ + 32 + sr) * LDP + sc); \
        if constexpr (DK == 128) { ks0[i] = *(const bf16x8*)(ud.K + (size_t)(tr_ + sr) * LDP + sc); ks1[i] = *(const bf16x8*)(ud.K + (size_t)(tr_ + 32 + sr) * LDP + sc); } \
        else { ks0[i] = *(const bf16x8*)(ud.K + (size_t)(tr_ + kr64) * LDP + kc64); } } while (0)
#define SWRITE(b, i) do { *(LAS bf16x8*)(Vl + (b) * 16384 + vst0) = vs0[i]; *(LAS bf16x8*)(Vl + (b) * 16384 + vst1) = vs1[i]; \
        if constexpr (DK == 128) { *(LAS bf16x8*)(Kl + (b) * 16384 + kswz<128>(sr, sc * 2)) = ks0[i]; *(LAS bf16x8*)(Kl + (b) * 16384 + kswz<128>(32 + sr, sc * 2)) = ks1[i]; } \
        else { *(LAS bf16x8*)(Kl + (b) * 16384 + kswz<64>(kr64, kc64 * 2)) = ks0[i]; } } while (0)
#define SWAIT() do { if constexpr (SDEPTH == 2) { if constexpr (DK == 128) asm volatile("s_waitcnt vmcnt(4)" ::: "memory"); else asm volatile("s_waitcnt vmcnt(3)" ::: "memory"); } \
        else asm volatile("s_waitcnt vmcnt(0)" ::: "memory"); } while (0)
#define RESC(a) do { if constexpr (MODE != 2) { if (__any((a) < 1.f)) { if (hi == 0) al_l[r32] = (a); asm volatile("s_waitcnt lgkmcnt(0)" ::: "memory"); \
        _Pragma("unroll") for (int d = 0; d < 4; ++d) _Pragma("unroll") for (int r = 0; r < 16; ++r) o[d][r] *= al_l[crow(r, hi)]; } } } while (0)
#define PART1(P0, P1, j_, MN, AL) do { \
        if constexpr (MODE == 2) { const int ck_ = (mp.latq && (j_) < 4) ? 0 : (64 * (j_) + 63 < s_lo) ? 1 : (64 * (j_) > s_lo + 31) ? 2 : 3; c_weight(P0, 0, ck_, (float)(si - 64 * (j_) - 4 * hi), mp.lf, mp.lb, rtab); AL = 1.f; MN = 0.f; } \
        else { if constexpr (MODE == 1) { if (!mp.plain && (j_) >= 4) b_mask(P0, P1, (j_), rtab, mp.kr0, mp.nkr, qrow, rs, qc, cst, hi); } sm_part(P0, P1, m_reg, MN, AL); } } while (0)
#define PART2(P0, P1, j_, AL) do { \
        if constexpr (MODE == 2) { const int ck_ = (mp.latq && (j_) < 4) ? 0 : (64 * (j_) + 63 < s_lo) ? 1 : (64 * (j_) > s_lo + 31) ? 2 : 3; c_weight(P1, 1, ck_, (float)(si - 64 * (j_) - 4 * hi), mp.lf, mp.lb, rtab); pack_p(P0, P1, pa0, pa1, pa2, pa3); } \
        else sm_fin(P0, P1, AL, l_reg, pa0, pa1, pa2, pa3); } while (0)
#define PVSM(VB, P0, P1, j_, MN, AL) do { \
        if constexpr (MODE != 0) { pv_d0(o, (VB), pa0, pa1, pa2, pa3); PART1(P0, P1, (j_), MN, AL); } \
        else pv_sm(o, (VB), pa0, pa1, pa2, pa3, P0, P1, m_reg, MN, AL); } while (0)
    f32x16 pA0, pA1, pB0, pB1; float mnA, mnB, alA, alB; bf16x8 pa0, pa1, pa2, pa3; const int NT = ud.NT;
    constexpr int SE = 0, SO = SDEPTH - 1;
    __syncthreads();
    if constexpr (MODE == 1) { if (!mp.plain) { if (tid < 465) ((LAS float*)(lds + L_RPB))[tid] = mp.rpb[tid] * LOG2E; } }
    if constexpr (MODE == 2) { if (tid < 64) { const int t_ = tid & 31, cr_ = (t_ & 3) + 8 * ((t_ & 15) >> 2) + 32 * (t_ >> 4);
        ((LAS float*)(lds + L_RPB))[tid] = __builtin_amdgcn_exp2f((tid < 32 ? -mp.lf : mp.lb) * (float)cr_); } }
    SLOAD(SE, 0); asm volatile("s_waitcnt vmcnt(0)" ::: "memory"); SWRITE(0, SE); __syncthreads();
    qkt<DK>(pA0, pA1, Kl, qr, r32, hi); PART1(pA0, pA1, 0, mnA, alA);
    SLOAD(SO, 1); if constexpr (SDEPTH == 2) { if (2 < NT) SLOAD(SE, 2); }
    SWAIT(); SWRITE(1, SO); __syncthreads();
    for (int j = 1; j + 1 < NT; j += 2) {
        SBAR(); qkt<DK>(pB0, pB1, Kl + 16384, qr, r32, hi);
        PART2(pA0, pA1, j - 1, alA); SBAR();
        SLOAD(SO, j + SDEPTH); SBAR();
        PVSM(vb0, pB0, pB1, j, mnB, alB);
        __syncthreads(); SWAIT(); SWRITE(0, SE);
        RESC(alB); __syncthreads();
        SBAR(); qkt<DK>(pA0, pA1, Kl, qr, r32, hi);
        PART2(pB0, pB1, j, alB); SBAR();
        if (SDEPTH == 1 || j + 3 < NT) SLOAD(SE, j + 1 + SDEPTH); SBAR();
        PVSM(vb0 + 16384, pA0, pA1, j + 1, mnA, alA);
        __syncthreads(); SWAIT(); SWRITE(1, SO);
        RESC(alA); __syncthreads();
    }
    SBAR(); qkt<DK>(pB0, pB1, Kl + 16384, qr, r32, hi);
    PART2(pA0, pA1, NT - 2, alA); SBAR();
    PVSM(vb0, pB0, pB1, NT - 1, mnB, alB);
    __syncthreads(); RESC(alB);
    PART2(pB0, pB1, NT - 1, alB); SBAR();
    pv_d0(o, vb0 + 16384, pa0, pa1, pa2, pa3);
    if constexpr (MODE != 2) {
        if (hi == 0) li_l[r32] = l_reg; asm volatile("s_waitcnt lgkmcnt(0)" ::: "memory");
#pragma unroll
        for (int r = 0; r < 16; ++r) { const float rl = __builtin_amdgcn_rcpf(li_l[crow(r, hi)]);
#pragma unroll
            for (int d = 0; d < 4; ++d) o[d][r] *= rl; }
    }
    (void)mnA; (void)mnB;
#undef TROW
#undef SLOAD
#undef SWRITE
#undef SWAIT
#undef RESC
#undef PART1
#undef PVSM
#undef PART2
}

constexpr int A3_K = 0, A3_V = 24576, A3_WS = 73728, L_STASH3 = 75776;
static_assert(L_STASH3 + 7 * 8192 <= RING_BYTES, "attention LDS map (ring-3): stash slots 0..6 inside the ring, slot 7 overlays LTAB");
typedef LAS const char* lds_cptr;
typedef short v4i16_t __attribute__((ext_vector_type(4)));
typedef unsigned u32x4_t __attribute__((ext_vector_type(4)));
#define A3_PIN(x) asm volatile("" : "+v"(x))
#define A3_WAIT_BAR(N) asm volatile("s_waitcnt vmcnt(" #N ") lgkmcnt(0)\n\ts_barrier" ::: "memory")
__device__ __forceinline__ void glds16(const void* g, unsigned lds_base) {
    unsigned sv; asm volatile("s_mov_b32 %0, m0\n\ts_mov_b32 m0, %2\n\ts_nop 0\n\tglobal_load_lds_dwordx4 %1, off\n\ts_mov_b32 m0, %0" : "=&s"(sv) : "v"(g), "s"(lds_base) : "memory"); }
__device__ __forceinline__ void glds16s(const void* sbase, unsigned voff, unsigned lds_base) {
    asm volatile("s_mov_b32 m0, %2\n\ts_nop 0\n\tglobal_load_lds_dwordx4 %0, %1" :: "v"(voff), "s"(sbase), "s"(lds_base) : "memory", "m0"); }
__device__ __forceinline__ void kload2(bf16x8* kf, lds_cptr kp, int d0) { kf[2 * d0] = *(const LAS bf16x8*)(kp + d0 * 2048); kf[2 * d0 + 1] = *(const LAS bf16x8*)(kp + d0 * 2048 + 512); }
__device__ __forceinline__ s16x4 vtr(lds_cptr p) { return __builtin_bit_cast(s16x4, __builtin_amdgcn_ds_read_tr16_b64_v4i16((LAS v4i16_t*)p)); }
#define A3_MX3(a, b, c) fmaxf(fmaxf((a), (b)), (c))
__device__ __forceinline__ float rowmax3(const f32x16& p0, const f32x16& p1) {
    float a = A3_MX3(p0[0], p0[1], p1[0]), b = A3_MX3(p0[2], p0[3], p1[1]); a = A3_MX3(a, p1[2], p1[3]);
#pragma unroll
    for (int r = 4; r < 16; r += 4) { a = A3_MX3(a, p0[r], p0[r + 1]); b = A3_MX3(b, p0[r + 2], p0[r + 3]); a = A3_MX3(a, p1[r], p1[r + 1]); b = A3_MX3(b, p1[r + 2], p1[r + 3]); }
    float m = fmaxf(a, b); auto rr = __builtin_amdgcn_permlane32_swap(__float_as_uint(m), __float_as_uint(m), false, false);
    return fmaxf(__uint_as_float(rr[0]), __uint_as_float(rr[1])); }
__device__ __forceinline__ void attn_a3(LAS unsigned char* lds, const bf16* Q, const bf16* K, const bf16* V, int row_base, int NT, f32x16 (&o)[4], int tid) {
    const int lane = tid & 63, r32 = lane & 31, hi = lane >> 5; const int wid = __builtin_amdgcn_readfirstlane(tid >> 6);
    const unsigned lds0 = (unsigned)(unsigned long)lds; LAS float* wsf = (LAS float*)(lds + A3_WS) + wid * 64;
    const unsigned koff = (unsigned)(((size_t)(row_base + lane) * LDP + wid * 8) * 2);
    const unsigned voff = (unsigned)(((size_t)(row_base + 16 * (wid & 3) + (lane >> 2)) * LDP + (wid >> 2) * 32 + (lane & 3) * 8) * 2);
    const unsigned kdst = lds0 + A3_K + wid * 1024, vdst = lds0 + A3_V + wid * 1024;
#define DMA_K(t, sl) glds16s(K + (size_t)(t) * (64 * LDP), koff, (unsigned)__builtin_amdgcn_readfirstlane((int)(kdst + (sl))))
#define DMA_V(t, sl) do { const bf16* v_ = V + (size_t)(t) * (64 * LDP); const unsigned d_ = (unsigned)__builtin_amdgcn_readfirstlane((int)(vdst + 2 * (sl))); glds16s(v_, voff, d_); glds16s(v_ + 64, voff, d_ + 8192); } while (0)
    const lds_cptr vp0 = (lds_cptr)lds + A3_V + ((lane >> 4) & 1) * 32 + (lane & 3) * 8 + (4 * hi + ((lane & 15) >> 2)) * 64;
    const lds_cptr kp0 = (lds_cptr)lds + A3_K + hi * 1024 + r32 * 16;
    __syncthreads();
    DMA_K(0, 0); DMA_V(0, 0); DMA_K(1, 8192);
    bf16x8 qr[4];
    { const bf16* Qw = Q + (size_t)(wid * 32 + r32) * LDP + hi * 8;
#pragma unroll
      for (int d0 = 0; d0 < 4; ++d0) qr[d0] = *(const bf16x8*)(Qw + d0 * 16); }
    float mhat = 0.f, l_reg = 0.f;
#pragma unroll
    for (int d = 0; d < 4; ++d) o[d] = f32x16{};
    bool resc = false; f32x16 negm;
    f32x16 pA0, pA1, pB0, pB1; bf16x8 kf[8]; s16x4 vlo[4], vhi[4]; u32x4_t pw0, pw1, pw2, pw3;
    int sl_prev = 0, sl_cur = 0, sl_next = 8192;
#define ROT() do { sl_prev = sl_cur; sl_cur = sl_next; sl_next = (sl_next == 16384) ? 0 : sl_next + 8192; } while (0)
#define MFMA_(a, b, c) __builtin_amdgcn_mfma_f32_32x32x16_bf16(a, b, c, 0, 0, 0)
#define EX(v) __builtin_amdgcn_exp2f(v)
#define RESC3() do { if (resc) { _Pragma("unroll") for (int d_ = 0; d_ < 4; ++d_) _Pragma("unroll") for (int r = 0; r < 16; ++r) o[d_][r] *= wsf[crow(r, hi)]; } } while (0)
    DMA_K(2, 16384);
    A3_WAIT_BAR(4);
#pragma unroll
    for (int d0 = 0; d0 < 4; ++d0) kload2(kf, kp0, d0);
    pA0 = f32x16{}; pA1 = f32x16{};
#pragma unroll
    for (int d0 = 0; d0 < 4; ++d0) { pA0 = MFMA_(kf[2 * d0], qr[d0], pA0); pA1 = MFMA_(kf[2 * d0 + 1], qr[d0], pA1); }
    { mhat = rowmax3(pA0, pA1); const float nmh = -mhat;
#pragma unroll
      for (int r = 0; r < 16; ++r) { pA0[r] = EX(pA0[r] + nmh); pA1[r] = EX(pA1[r] + nmh); negm[r] = nmh; }
      A3_PIN(negm); }
    A3_WAIT_BAR(0);
    DMA_K(3, 0); DMA_V(1, 8192); ROT();
#pragma unroll
    for (int d0 = 0; d0 < 4; ++d0) kload2(kf, kp0 + sl_cur, d0);
    A3_WAIT_BAR(3);
#define PKW(P, i) cvt_pk_bf16(P[i], P[i + 1])
#define VFR(s) (bf16x8){vlo[s][0], vlo[s][1], vlo[s][2], vlo[s][3], vhi[s][0], vhi[s][1], vhi[s][2], vhi[s][3]}
#define VRD(s, g) do { vlo[s] = vtr(vp_ + (((g) & 3) * 4096 + ((g) >> 2) * 1024)); vhi[s] = vtr(vp_ + (((g) & 3) * 4096 + ((g) >> 2) * 1024 + 512)); } while (0)
#define KRD(G, d0) do { if (G) kload2(kf, kp0 + sl_next, d0); } while (0)
#define GAPA(MF, a0, a1, a2, a3, W0, W1, PW, RD) do { MF; RD; sacc += a0; sacc += a1; sacc += a2; sacc += a3; W0; W1; A3_PIN(PW); A3_PIN(sacc); SBAR(); } while (0)
#define GAPB(g, PA, X, i, RD) do { o[(g) & 3] = MFMA_(__builtin_bit_cast(bf16x8, PA), VFR((g) & 3), o[(g) & 3]); RD; X[i] = EX(X[i]); X[i + 1] = EX(X[i + 1]); A3_PIN(X); SBAR(); } while (0)
#define NORD do { } while (0)
#define STEP(C0, C1, P0, P1, t, GK, GV, GL) do { SBAR(); \
    const lds_cptr vp_ = vp0 + 2 * sl_prev; float sacc = P0[0] + P0[1]; \
    GAPA(C0 = MFMA_(kf[0], qr[0], negm),     P0[2], P0[3], P0[4], P0[5],     pw0[0] = PKW(P0, 0),  pw0[1] = PKW(P0, 2),  pw0, NORD); \
    GAPA(C1 = MFMA_(kf[1], qr[0], negm),     P0[6], P0[7], P0[8], P0[9],     pw0[2] = PKW(P0, 4),  pw0[3] = PKW(P0, 6),  pw0, NORD); \
    GAPA(C0 = MFMA_(kf[2], qr[1], C0),       P0[10], P0[11], P0[12], P0[13], pw1[0] = PKW(P0, 8),  pw1[1] = PKW(P0, 10), pw1, NORD); \
    GAPA(C1 = MFMA_(kf[3], qr[1], C1),       P0[14], P0[15], P1[0], P1[1],   pw1[2] = PKW(P0, 12), pw1[3] = PKW(P0, 14), pw1, NORD); \
    GAPA(C0 = MFMA_(kf[4], qr[2], C0),       P1[2], P1[3], P1[4], P1[5],     pw2[0] = PKW(P1, 0),  pw2[1] = PKW(P1, 2),  pw2, VRD(0, 0)); \
    GAPA(C1 = MFMA_(kf[5], qr[2], C1),       P1[6], P1[7], P1[8], P1[9],     pw2[2] = PKW(P1, 4),  pw2[3] = PKW(P1, 6),  pw2, VRD(1, 1)); \
    GAPA(C0 = MFMA_(kf[6], qr[3], C0),       P1[10], P1[11], P1[12], P1[13], pw3[0] = PKW(P1, 8),  pw3[1] = PKW(P1, 10), pw3, VRD(2, 2)); \
    GAPA(C1 = MFMA_(kf[7], qr[3], C1),       P1[14], P1[15], 0.f, 0.f,       pw3[2] = PKW(P1, 12), pw3[3] = PKW(P1, 14), pw3, VRD(3, 3)); \
    l_reg += sacc; \
    if (GK) DMA_K((t) + 3, sl_cur); if (GV) DMA_V((t) + 1, sl_next);                                                       \
    { const float rm = rowmax3(C0, C1); resc = false;                                                                      \
      if (__builtin_expect(__any(rm > THR2), 0)) { const float dl = fmaxf(rm, 0.f); mhat += dl;                            \
          const float f = __builtin_amdgcn_exp2f(-dl); l_reg *= f; if (hi == 0) wsf[r32] = f; resc = true; \
          _Pragma("unroll") for (int r = 0; r < 16; ++r) { C0[r] -= dl; C1[r] -= dl; negm[r] = -mhat; } } } \
    SBAR(); \
    GAPB(0,  pw0, C0, 0,  VRD(0, 4));  GAPB(1,  pw0, C0, 2,  VRD(1, 5));  GAPB(2,  pw0, C0, 4,  VRD(2, 6));  GAPB(3,  pw0, C0, 6,  VRD(3, 7)); \
    GAPB(4,  pw1, C0, 8,  VRD(0, 8));  GAPB(5,  pw1, C0, 10, VRD(1, 9));  GAPB(6,  pw1, C0, 12, VRD(2, 10)); GAPB(7,  pw1, C0, 14, VRD(3, 11)); \
    GAPB(8,  pw2, C1, 0,  VRD(0, 12)); GAPB(9,  pw2, C1, 2,  VRD(1, 13)); GAPB(10, pw2, C1, 4,  VRD(2, 14)); GAPB(11, pw2, C1, 6,  VRD(3, 15)); \
    GAPB(12, pw3, C1, 8,  KRD(GL, 0)); GAPB(13, pw3, C1, 10, KRD(GL, 1)); GAPB(14, pw3, C1, 12, KRD(GL, 2)); GAPB(15, pw3, C1, 14, KRD(GL, 3)); \
    } while (0)
#define ENDW(tt) do { if ((tt) + 3 < NT) { A3_WAIT_BAR(3); } else if ((tt) + 2 < NT) { A3_WAIT_BAR(2); } else { A3_WAIT_BAR(0); } } while (0)
    int t = 1;
    for (; t + 5 < NT; t += 2) {
        STEP(pB0, pB1, pA0, pA1, t, true, true, true);     A3_WAIT_BAR(3); RESC3(); ROT();
        STEP(pA0, pA1, pB0, pB1, t + 1, true, true, true); A3_WAIT_BAR(3); RESC3(); ROT();
    }
    for (; t + 1 < NT; t += 2) {
        STEP(pB0, pB1, pA0, pA1, t, (t + 3 < NT), (t + 1 < NT), (t + 1 < NT));         ENDW(t);     RESC3(); ROT();
        STEP(pA0, pA1, pB0, pB1, t + 1, (t + 4 < NT), (t + 2 < NT), (t + 2 < NT));     ENDW(t + 1); RESC3(); ROT();
    }
    STEP(pB0, pB1, pA0, pA1, NT - 1, false, false, false); RESC3();
    { float sacc = pB0[0] + pB0[1];
#pragma unroll
      for (int r = 2; r < 16; ++r) sacc += pB0[r];
#pragma unroll
      for (int r = 0; r < 16; ++r) sacc += pB1[r];
      l_reg += sacc;
      pw0 = (u32x4_t){PKW(pB0, 0), PKW(pB0, 2), PKW(pB0, 4), PKW(pB0, 6)}; pw1 = (u32x4_t){PKW(pB0, 8), PKW(pB0, 10), PKW(pB0, 12), PKW(pB0, 14)};
      pw2 = (u32x4_t){PKW(pB1, 0), PKW(pB1, 2), PKW(pB1, 4), PKW(pB1, 6)}; pw3 = (u32x4_t){PKW(pB1, 8), PKW(pB1, 10), PKW(pB1, 12), PKW(pB1, 14)};
      const lds_cptr vp_ = vp0 + 2 * sl_cur;
#define DR4(ks, PA) do { VRD(0, 4 * (ks)); VRD(1, 4 * (ks) + 1); VRD(2, 4 * (ks) + 2); VRD(3, 4 * (ks) + 3); \
      o[0] = MFMA_(__builtin_bit_cast(bf16x8, PA), VFR(0), o[0]); o[1] = MFMA_(__builtin_bit_cast(bf16x8, PA), VFR(1), o[1]); \
      o[2] = MFMA_(__builtin_bit_cast(bf16x8, PA), VFR(2), o[2]); o[3] = MFMA_(__builtin_bit_cast(bf16x8, PA), VFR(3), o[3]); } while (0)
      DR4(0, pw0); DR4(1, pw1); DR4(2, pw2); DR4(3, pw3);
#undef DR4
    }
    { auto rr = __builtin_amdgcn_permlane32_swap(__float_as_uint(l_reg), __float_as_uint(l_reg), false, false); l_reg = __uint_as_float(rr[0]) + __uint_as_float(rr[1]); }
    if (hi == 0) wsf[32 + r32] = l_reg; asm volatile("s_waitcnt lgkmcnt(0)" ::: "memory");
#pragma unroll
    for (int r = 0; r < 16; ++r) { const float rl = __builtin_amdgcn_rcpf(wsf[32 + crow(r, hi)]);
#pragma unroll
        for (int d = 0; d < 4; ++d) o[d][r] *= rl; }
#undef DMA_K
#undef DMA_V
#undef ROT
#undef MFMA_
#undef EX
#undef RESC3
#undef PKW
#undef VFR
#undef VRD
#undef KRD
#undef GAPA
#undef GAPB
#undef NORD
#undef STEP
#undef ENDW
}

constexpr int B3_V = 0, B3_K = 49152, B3_WS = 98304, B3_RPB = 100352;
static_assert(B3_RPB + 2048 <= RING_BYTES, "attention LDS map (B ring-3)");
#ifndef B_SMSPLIT
#define B_SMSPLIT 1
#endif
__device__ __forceinline__ void attn_b3(LAS unsigned char* lds, const UnitD& ud, const ModeP& mp, f32x16 (&o)[4], int tid) {
    constexpr int DK = 128;
    const int wid = __builtin_amdgcn_readfirstlane(tid >> 6), lane = tid & 63, r32 = lane & 31, hi = lane >> 5;
    LAS unsigned char* Vl = lds + B3_V; LAS unsigned char* Kl = lds + B3_K; const unsigned lds0 = (unsigned)(unsigned long)lds;
    LAS float* wsf = (LAS float*)(lds + B3_WS) + wid * 64; LAS float* li_l = wsf; LAS float* al_l = wsf + 32;
    const LAS float* rtab = (const LAS float*)(lds + B3_RPB);
    float m_reg = -1e30f, l_reg = 0.f;
#pragma unroll
    for (int d = 0; d < 4; ++d) o[d] = f32x16{};
    bf16x8 qr[DK / 16];
    { const bf16* Qw = ud.Q + (size_t)(wid * 32 + r32) * LDP + hi * 8;
#pragma unroll
      for (int d0 = 0; d0 < DK / 16; ++d0) qr[d0] = *(const bf16x8*)(Qw + d0 * 16); }
    const int vb0 = (int)(unsigned)(unsigned long)Vl + v_rd_base(lane);
    const int qc = 32 * (wid & 1) + r32, qrow = mp.qr0 + (wid >> 1), rs = min(max(qrow - 4, 0), 24), cst = min(max(qc - 8, 0), 48);
    const int krow = 4 * wid + (lane >> 4);
    const bf16* ksrc = ud.K + (size_t)krow * LDP + (((lane & 15) ^ (krow & 15)) * 8);
    const int bl = 2 * wid + (lane >> 5), kk = (bl >> 2) * 8 + ((lane & 31) >> 2), vk = (kk & ~0xC) | ((kk & 4) << 1) | ((kk & 8) >> 1);
    const bf16* vsrc = ud.V + (size_t)vk * LDP + (bl & 3) * 32 + (lane & 3) * 8;
    const unsigned kdst = lds0 + B3_K + wid * 1024, vdst = lds0 + B3_V + wid * 1024;
#define TROW(j_) (ud.row_base + 64 * ((j_) < 4 ? (j_) : ud.off + min((j_) - 4, ud.cap)))
#define DMA_T(j_, sl) do { const size_t ro_ = (size_t)TROW(j_) * LDP; const unsigned ks_ = (unsigned)__builtin_amdgcn_readfirstlane((int)(kdst + (sl))), vs_ = (unsigned)__builtin_amdgcn_readfirstlane((int)(vdst + (sl))); \
        glds16(ksrc + ro_, ks_); glds16(ksrc + ro_ + (size_t)32 * LDP, ks_ + 8192); glds16(vsrc + ro_, vs_); glds16(vsrc + ro_ + (size_t)32 * LDP, vs_ + 8192); } while (0)
#define WAIT0_BAR() asm volatile("s_waitcnt vmcnt(0) lgkmcnt(0)\n\ts_barrier" ::: "memory")
#define ROT() do { sp = sc; sc = sn; sn = (sn == 32768) ? 0 : sn + 16384; } while (0)
#define RESC(a) do { if (__any((a) < 1.f)) { if (hi == 0) al_l[r32] = (a); asm volatile("s_waitcnt lgkmcnt(0)" ::: "memory"); \
        _Pragma("unroll") for (int d = 0; d < 4; ++d) _Pragma("unroll") for (int r = 0; r < 16; ++r) o[d][r] *= al_l[crow(r, hi)]; } } while (0)
#define MASK(P0, P1, j_) do { if (!mp.plain && (j_) >= 4) b_mask(P0, P1, (j_), rtab, mp.kr0, mp.nkr, qrow, rs, qc, cst, hi); } while (0)
#if B_SMSPLIT
#define PVP1(VB, P0, P1, j_, MN, AL) do { MASK(P0, P1, j_); pv_sm(o, (VB), pa0, pa1, pa2, pa3, P0, P1, m_reg, MN, AL); } while (0)
#else
#define PVP1(VB, P0, P1, j_, MN, AL) do { pv_d0(o, (VB), pa0, pa1, pa2, pa3); MASK(P0, P1, j_); sm_part(P0, P1, m_reg, MN, AL); } while (0)
#endif
    f32x16 pA0, pA1, pB0, pB1; float mnA, mnB, alA, alB; bf16x8 pa0, pa1, pa2, pa3; const int NT = ud.NT;
    int sp = 0, sc = 0, sn = 16384;
    __syncthreads();
    if (!mp.plain) { if (tid < 465) ((LAS float*)(lds + B3_RPB))[tid] = mp.rpb[tid] * LOG2E; }
    DMA_T(0, 0); WAIT0_BAR();
    DMA_T(1, sn);
    qkt<DK>(pA0, pA1, Kl, qr, r32, hi); MASK(pA0, pA1, 0); sm_part(pA0, pA1, m_reg, mnA, alA);
    WAIT0_BAR(); ROT();
    for (int j = 1; j + 1 < NT; j += 2) {
        DMA_T(j + 1, sn);
        SBAR(); qkt<DK>(pB0, pB1, Kl + sc, qr, r32, hi);
        sm_fin(pA0, pA1, alA, l_reg, pa0, pa1, pa2, pa3); SBAR();
        PVP1(vb0 + sp, pB0, pB1, j, mnB, alB);
        WAIT0_BAR(); RESC(alB); ROT();
        if (j + 2 < NT) DMA_T(j + 2, sn);
        SBAR(); qkt<DK>(pA0, pA1, Kl + sc, qr, r32, hi);
        sm_fin(pB0, pB1, alB, l_reg, pa0, pa1, pa2, pa3); SBAR();
        PVP1(vb0 + sp, pA0, pA1, j + 1, mnA, alA);
        WAIT0_BAR(); RESC(alA); ROT();
    }
    SBAR(); qkt<DK>(pB0, pB1, Kl + sc, qr, r32, hi);
    sm_fin(pA0, pA1, alA, l_reg, pa0, pa1, pa2, pa3); SBAR();
    PVP1(vb0 + sp, pB0, pB1, NT - 1, mnB, alB);
    RESC(alB);
    sm_fin(pB0, pB1, alB, l_reg, pa0, pa1, pa2, pa3); SBAR();
    pv_d0(o, vb0 + sc, pa0, pa1, pa2, pa3);
    { if (hi == 0) li_l[r32] = l_reg; asm volatile("s_waitcnt lgkmcnt(0)" ::: "memory");
#pragma unroll
      for (int r = 0; r < 16; ++r) { const float rl = __builtin_amdgcn_rcpf(li_l[crow(r, hi)]);
#pragma unroll
          for (int d = 0; d < 4; ++d) o[d][r] *= rl; } }
    (void)mnA; (void)mnB;
#undef TROW
#undef DMA_T
#undef WAIT0_BAR
#undef ROT
#undef RESC
#undef MASK
#undef PVP1
}

constexpr int B4_K = 0, B4_V = 49152, B4_WS = 98304, B4_RPB = 100352;
static_assert(B4_RPB + 2048 <= RING_BYTES, "attention LDS map (B4)");
#ifndef B_STEP4
#define B_STEP4 1
#endif
__device__ __forceinline__ void attn_b4(LAS unsigned char* lds, const UnitD& ud, const ModeP& mp, f32x16 (&o)[4], int tid) {
    const int lane = tid & 63, r32 = lane & 31, hi = lane >> 5; const int wid = __builtin_amdgcn_readfirstlane(tid >> 6);
    const unsigned lds0 = (unsigned)(unsigned long)lds; LAS float* wsf = (LAS float*)(lds + B4_WS) + wid * 64;
    const LAS float* rtab = (const LAS float*)(lds + B4_RPB);
    const int qc = 32 * (wid & 1) + r32, qrow = mp.qr0 + (wid >> 1), rs = min(max(qrow - 4, 0), 24), cst = min(max(qc - 8, 0), 48);
    const unsigned koff = (unsigned)(((size_t)lane * LDP + wid * 8) * 2);
    const unsigned voff = (unsigned)(((size_t)(16 * (wid & 3) + (lane >> 2)) * LDP + (wid >> 2) * 32 + (lane & 3) * 8) * 2);
    const unsigned kdst = lds0 + B4_K + wid * 1024, vdst = lds0 + B4_V + wid * 1024;
#define TROW(j_) (ud.row_base + 64 * ((j_) < 4 ? (j_) : ud.off + min((j_) - 4, ud.cap)))
#define DMA_K(j_, sl) do { const bf16* k_ = ud.K + (size_t)TROW(j_) * LDP; const unsigned d_ = (unsigned)__builtin_amdgcn_readfirstlane((int)(kdst + (sl))); glds16s(k_, koff, d_); glds16s(k_ + 64, koff, d_ + 8192); } while (0)
#define DMA_V(j_, sl) do { const bf16* v_ = ud.V + (size_t)TROW(j_) * LDP; const unsigned d_ = (unsigned)__builtin_amdgcn_readfirstlane((int)(vdst + (sl))); glds16s(v_, voff, d_); glds16s(v_ + 64, voff, d_ + 8192); } while (0)
    const lds_cptr vp0 = (lds_cptr)lds + B4_V + ((lane >> 4) & 1) * 32 + (lane & 3) * 8 + (4 * hi + ((lane & 15) >> 2)) * 64;
    const lds_cptr kp0 = (lds_cptr)lds + B4_K + hi * 1024 + r32 * 16;
    __syncthreads();
    DMA_K(0, 0); DMA_V(0, 0); DMA_K(1, 16384); DMA_K(2, 32768);
    bf16x8 qr[8];
    { const bf16* Qw = ud.Q + (size_t)(wid * 32 + r32) * LDP + hi * 8;
#pragma unroll
      for (int d0 = 0; d0 < 8; ++d0) qr[d0] = *(const bf16x8*)(Qw + d0 * 16); }
    if (!mp.plain) { if (tid < 465) ((LAS float*)(lds + B4_RPB))[tid] = mp.rpb[tid] * LOG2E; }
    float mhat = 0.f, l_reg = 0.f;
#pragma unroll
    for (int d = 0; d < 4; ++d) o[d] = f32x16{};
    bool resc = false; const int NT = ud.NT;
    f32x16 pA0, pA1, pB0, pB1; bf16x8 kfr[4]; s16x4 vlo[4], vhi[4]; u32x4_t pw0, pw1, pw2, pw3;
    int sl_prev = 0, sl_cur = 0, sl_next = 16384;
#define ROT() do { sl_prev = sl_cur; sl_cur = sl_next; sl_next = (sl_next == 32768) ? 0 : sl_next + 16384; } while (0)
#define MFMA_(a, b, c) __builtin_amdgcn_mfma_f32_32x32x16_bf16(a, b, c, 0, 0, 0)
#define KF1(s, kp, g) kfr[s] = *(const LAS bf16x8*)((kp) + ((g) >> 1) * 2048 + ((g) & 1) * 512)
#define EX(v) __builtin_amdgcn_exp2f((v) + nmh)
#define RESC4() do { if (resc) { _Pragma("unroll") for (int d_ = 0; d_ < 4; ++d_) _Pragma("unroll") for (int r = 0; r < 16; ++r) o[d_][r] *= wsf[crow(r, hi)]; } } while (0)
#define WAIT0_BAR() asm volatile("s_waitcnt vmcnt(0) lgkmcnt(0)\n\ts_barrier" ::: "memory")
    WAIT0_BAR();
    pA0 = f32x16{}; pA1 = f32x16{};
#pragma unroll
    for (int g = 0; g < 16; g += 2) { KF1(0, kp0, g); KF1(1, kp0, g + 1); pA0 = MFMA_(kfr[0], qr[g >> 1], pA0); pA1 = MFMA_(kfr[1], qr[g >> 1], pA1); }
    { mhat = rowmax3(pA0, pA1); const float nmh = -mhat;
#pragma unroll
      for (int r = 0; r < 16; ++r) { pA0[r] = EX(pA0[r]); pA1[r] = EX(pA1[r]); } }
    asm volatile("s_waitcnt lgkmcnt(0)\n\ts_barrier" ::: "memory");
    DMA_V(1, 16384); ROT();
    KF1(0, kp0 + sl_cur, 0); KF1(1, kp0 + sl_cur, 1); KF1(2, kp0 + sl_cur, 2); KF1(3, kp0 + sl_cur, 3);
#define PKW(P, i) cvt_pk_bf16(P[i], P[i + 1])
#define VFR(s) (bf16x8){vlo[s][0], vlo[s][1], vlo[s][2], vlo[s][3], vhi[s][0], vhi[s][1], vhi[s][2], vhi[s][3]}
#define VRD(s, g) do { vlo[s] = vtr(vp_ + (((g) & 3) * 4096 + ((g) >> 2) * 1024)); vhi[s] = vtr(vp_ + (((g) & 3) * 4096 + ((g) >> 2) * 1024 + 512)); } while (0)
#define GA(g, CD, CS, a0, a1, W, PW, RD) do { CD = MFMA_(kfr[(g) & 3], qr[(g) >> 1], CS); RD; sacc += a0; sacc += a1; W; A3_PIN(PW); A3_PIN(sacc); SBAR(); } while (0)
#define GB(g, PA, X, i, RD) do { o[(g) & 3] = MFMA_(__builtin_bit_cast(bf16x8, PA), VFR((g) & 3), o[(g) & 3]); RD; X[i] = EX(X[i]); X[i + 1] = EX(X[i + 1]); A3_PIN(X); SBAR(); } while (0)
#define KNX(G, s) do { if (G) KF1(s, kp0 + sl_next, s); } while (0)
#define STEPB(C0, C1, P0, P1, t, GK, GV, GL) do { SBAR(); \
    const lds_cptr vp_ = vp0 + sl_prev; const lds_cptr kq_ = kp0 + sl_cur; float sacc = P0[0] + P0[1]; \
    GA(0,  C0, f32x16{}, P0[2],  P0[3],  pw0[0] = PKW(P0, 0),  pw0, KF1(0, kq_, 4)); \
    GA(1,  C1, f32x16{}, P0[4],  P0[5],  pw0[1] = PKW(P0, 2),  pw0, KF1(1, kq_, 5)); \
    GA(2,  C0, C0,       P0[6],  P0[7],  pw0[2] = PKW(P0, 4),  pw0, KF1(2, kq_, 6)); \
    GA(3,  C1, C1,       P0[8],  P0[9],  pw0[3] = PKW(P0, 6),  pw0, KF1(3, kq_, 7)); \
    GA(4,  C0, C0,       P0[10], P0[11], pw1[0] = PKW(P0, 8),  pw1, KF1(0, kq_, 8)); \
    GA(5,  C1, C1,       P0[12], P0[13], pw1[1] = PKW(P0, 10), pw1, KF1(1, kq_, 9)); \
    GA(6,  C0, C0,       P0[14], P0[15], pw1[2] = PKW(P0, 12), pw1, KF1(2, kq_, 10)); \
    GA(7,  C1, C1,       P1[0],  P1[1],  pw1[3] = PKW(P0, 14), pw1, KF1(3, kq_, 11)); \
    GA(8,  C0, C0,       P1[2],  P1[3],  pw2[0] = PKW(P1, 0),  pw2, KF1(0, kq_, 12)); \
    GA(9,  C1, C1,       P1[4],  P1[5],  pw2[1] = PKW(P1, 2),  pw2, KF1(1, kq_, 13)); \
    GA(10, C0, C0,       P1[6],  P1[7],  pw2[2] = PKW(P1, 4),  pw2, KF1(2, kq_, 14)); \
    GA(11, C1, C1,       P1[8],  P1[9],  pw2[3] = PKW(P1, 6),  pw2, KF1(3, kq_, 15)); \
    GA(12, C0, C0,       P1[10], P1[11], pw3[0] = PKW(P1, 8),  pw3, VRD(0, 0)); \
    GA(13, C1, C1,       P1[12], P1[13], pw3[1] = PKW(P1, 10), pw3, VRD(1, 1)); \
    GA(14, C0, C0,       P1[14], P1[15], pw3[2] = PKW(P1, 12), pw3, VRD(2, 2)); \
    GA(15, C1, C1,       0.f,    0.f,    pw3[3] = PKW(P1, 14), pw3, VRD(3, 3)); \
    l_reg += sacc; \
    if (GK) DMA_K((t) + 2, sl_prev); if (GV) DMA_V((t) + 1, sl_next);                                                      \
    if (!mp.plain && (t) >= 4) b_mask(C0, C1, (t), rtab, mp.kr0, mp.nkr, qrow, rs, qc, cst, hi); \
    { const float rm = rowmax3(C0, C1) - mhat; resc = false;                                                               \
      if (__builtin_expect(__any(rm > THR2), 0)) { const float dl = fmaxf(rm, 0.f); mhat += dl;                            \
          const float f = __builtin_amdgcn_exp2f(-dl); l_reg *= f; if (hi == 0) wsf[r32] = f; resc = true; } } \
    const float nmh = -mhat; SBAR(); \
    GB(0,  pw0, C0, 0,  VRD(0, 4));  GB(1,  pw0, C0, 2,  VRD(1, 5));  GB(2,  pw0, C0, 4,  VRD(2, 6));  GB(3,  pw0, C0, 6,  VRD(3, 7)); \
    GB(4,  pw1, C0, 8,  VRD(0, 8));  GB(5,  pw1, C0, 10, VRD(1, 9));  GB(6,  pw1, C0, 12, VRD(2, 10)); GB(7,  pw1, C0, 14, VRD(3, 11)); \
    GB(8,  pw2, C1, 0,  VRD(0, 12)); GB(9,  pw2, C1, 2,  VRD(1, 13)); GB(10, pw2, C1, 4,  VRD(2, 14)); GB(11, pw2, C1, 6,  VRD(3, 15)); \
    GB(12, pw3, C1, 8,  KNX(GL, 0)); GB(13, pw3, C1, 10, KNX(GL, 1)); GB(14, pw3, C1, 12, KNX(GL, 2)); GB(15, pw3, C1, 14, KNX(GL, 3)); \
    } while (0)
#define ACT(j_) (mp.plain || (j_) < 4 || (((j_) - 4 < mp.nkr) && (mp.kr0 + (j_) - 4 >= rs) && (mp.kr0 + (j_) - 4 < rs + 8)))
#define STEPI(C0, C1, t, GK, GV, GL) do { if (GK) DMA_K((t) + 2, sl_prev); if (GV) DMA_V((t) + 1, sl_next); resc = false; C0 = f32x16{}; C1 = f32x16{}; \
    if ((GL) && ACT((t) + 1)) { KF1(0, kp0 + sl_next, 0); KF1(1, kp0 + sl_next, 1); KF1(2, kp0 + sl_next, 2); KF1(3, kp0 + sl_next, 3); } } while (0)
#define STEPX(C0, C1, P0, P1, t, GK, GV, GL) do { if (ACT(t) || ACT((t) - 1)) STEPB(C0, C1, P0, P1, t, GK, GV, GL); else STEPI(C0, C1, t, GK, GV, GL); } while (0)
    int t = 1;
    for (; t + 3 < NT; t += 2) {
        STEPX(pB0, pB1, pA0, pA1, t, true, true, true);     WAIT0_BAR(); RESC4(); ROT();
        STEPX(pA0, pA1, pB0, pB1, t + 1, true, true, true); WAIT0_BAR(); RESC4(); ROT();
    }
    for (; t + 1 < NT; t += 2) {
        STEPX(pB0, pB1, pA0, pA1, t, (t + 2 < NT), (t + 1 < NT), (t + 1 < NT));         WAIT0_BAR(); RESC4(); ROT();
        STEPX(pA0, pA1, pB0, pB1, t + 1, (t + 3 < NT), (t + 2 < NT), (t + 2 < NT));     WAIT0_BAR(); RESC4(); ROT();
    }
    STEPX(pB0, pB1, pA0, pA1, NT - 1, false, false, false); RESC4();
    if (ACT(NT - 1)) { float sacc = pB0[0] + pB0[1];
#pragma unroll
      for (int r = 2; r < 16; ++r) sacc += pB0[r];
#pragma unroll
      for (int r = 0; r < 16; ++r) sacc += pB1[r];
      l_reg += sacc;
      pw0 = (u32x4_t){PKW(pB0, 0), PKW(pB0, 2), PKW(pB0, 4), PKW(pB0, 6)}; pw1 = (u32x4_t){PKW(pB0, 8), PKW(pB0, 10), PKW(pB0, 12), PKW(pB0, 14)};
      pw2 = (u32x4_t){PKW(pB1, 0), PKW(pB1, 2), PKW(pB1, 4), PKW(pB1, 6)}; pw3 = (u32x4_t){PKW(pB1, 8), PKW(pB1, 10), PKW(pB1, 12), PKW(pB1, 14)};
      const lds_cptr vp_ = vp0 + sl_cur;
#define DR4(ks, PA) do { VRD(0, 4 * (ks)); VRD(1, 4 * (ks) + 1); VRD(2, 4 * (ks) + 2); VRD(3, 4 * (ks) + 3); \
      o[0] = MFMA_(__builtin_bit_cast(bf16x8, PA), VFR(0), o[0]); o[1] = MFMA_(__builtin_bit_cast(bf16x8, PA), VFR(1), o[1]); \
      o[2] = MFMA_(__builtin_bit_cast(bf16x8, PA), VFR(2), o[2]); o[3] = MFMA_(__builtin_bit_cast(bf16x8, PA), VFR(3), o[3]); } while (0)
      DR4(0, pw0); DR4(1, pw1); DR4(2, pw2); DR4(3, pw3);
#undef DR4
    }
    { auto rr = __builtin_amdgcn_permlane32_swap(__float_as_uint(l_reg), __float_as_uint(l_reg), false, false); l_reg = __uint_as_float(rr[0]) + __uint_as_float(rr[1]); }
    if (hi == 0) wsf[32 + r32] = l_reg; asm volatile("s_waitcnt lgkmcnt(0)" ::: "memory");
#pragma unroll
    for (int r = 0; r < 16; ++r) { const float rl = __builtin_amdgcn_rcpf(wsf[32 + crow(r, hi)]);
#pragma unroll
        for (int d = 0; d < 4; ++d) o[d][r] *= rl; }
#undef TROW
#undef DMA_K
#undef DMA_V
#undef ROT
#undef MFMA_
#undef KF1
#undef EX
#undef RESC4
#undef WAIT0_BAR
#undef PKW
#undef VFR
#undef VRD
#undef GA
#undef GB
#undef KNX
#undef STEPB
#undef STEPI
#undef STEPX
#undef ACT
}

template <int KIND>
__device__ __forceinline__ void attn_epi(LAS unsigned char* lds, const f32x16 (&o)[4], int tid, int grow0, bf16* OUT, int ocol, const float* gw, float cm, const bf16* CG) {
    const int wid = __builtin_amdgcn_readfirstlane(tid >> 6), lane = tid & 63, r32 = lane & 31, hi = lane >> 5;
    __syncthreads();
    LAS float* Ow = (LAS float*)(lds + wid * L_OEPI);
#pragma unroll
    for (int d = 0; d < 4; ++d)
#pragma unroll
        for (int r = 0; r < 16; ++r) Ow[crow(r, hi) * 132 + d * 32 + r32] = o[d][r];
    asm volatile("s_waitcnt lgkmcnt(0)" ::: "memory");
    const int row = lane >> 1, half = lane & 1; const size_t grow = (size_t)(grow0 + wid * 32 + row);
    f32x4 x[16]; float ss = 0.f;
#pragma unroll
    for (int i = 0; i < 16; ++i) { x[i] = *(const LAS f32x4*)(Ow + row * 132 + half * 64 + 4 * i); ss += (x[i][0] * x[i][0] + x[i][1] * x[i][1]) + (x[i][2] * x[i][2] + x[i][3] * x[i][3]); }
    if constexpr (KIND != 1) {
        ss += swz_xor<1>(ss);
        const float rstd = 1.0f / sqrtf(ss * (1.0f / 128.0f) + EPS) * cm;
#pragma unroll
        for (int i = 0; i < 16; ++i) x[i] = x[i] * rstd * *(const f32x4*)(gw + half * 64 + 4 * i);
    }
    if constexpr (KIND == 2) {
        const v4u* cg = (const v4u*)(CG + grow * LDP + half * 64);
#pragma unroll
        for (int i = 0; i < 8; ++i) { const v4u g = cg[i];
            x[2 * i][0] *= silu_f(bflo(g.x)); x[2 * i][1] *= silu_f(bfhi(g.x)); x[2 * i][2] *= silu_f(bflo(g.y)); x[2 * i][3] *= silu_f(bfhi(g.y));
            x[2 * i + 1][0] *= silu_f(bflo(g.z)); x[2 * i + 1][1] *= silu_f(bfhi(g.z)); x[2 * i + 1][2] *= silu_f(bflo(g.w)); x[2 * i + 1][3] *= silu_f(bfhi(g.w)); }
    }
    v4u* op = (v4u*)(OUT + grow * 1024 + ocol + half * 64);
#pragma unroll
    for (int i = 0; i < 8; ++i) { v4u w; w.x = cvt_pk_bf16(x[2 * i][0], x[2 * i][1]); w.y = cvt_pk_bf16(x[2 * i][2], x[2 * i][3]); w.z = cvt_pk_bf16(x[2 * i + 1][0], x[2 * i + 1][1]); w.w = cvt_pk_bf16(x[2 * i + 1][2], x[2 * i + 1][3]); op[i] = w; }
}

constexpr int CST_K = 0, CST_VF = 16384, CST_VB = 32768;
__device__ __forceinline__ bf16x8 trfrag(int vb, int off) { s16x4 l, h; asm volatile("ds_read_b64_tr_b16 %0, %1" : "=&v"(l) : "v"(vb + off) : "memory"); asm volatile("ds_read_b64_tr_b16 %0, %1" : "=&v"(h) : "v"(vb + off + 2048) : "memory");
    return (bf16x8){l[0], l[1], l[2], l[3], h[0], h[1], h[2], h[3]}; }
__device__ __forceinline__ bf16x8 scale_frag(bf16x8 q, float f) { const v4u w = __builtin_bit_cast(v4u, q); v4u o;
    o.x = cvt_pk_bf16(bflo(w.x) * f, bfhi(w.x) * f); o.y = cvt_pk_bf16(bflo(w.y) * f, bfhi(w.y) * f); o.z = cvt_pk_bf16(bflo(w.z) * f, bfhi(w.z) * f); o.w = cvt_pk_bf16(bflo(w.w) * f, bfhi(w.w) * f);
    return __builtin_bit_cast(bf16x8, o); }
__device__ __forceinline__ void c_state_item(LAS unsigned char* lds, const bf16* K, const bf16* V, int row0, float lf, float lb, float* UO, int tid) {
    const int wid = __builtin_amdgcn_readfirstlane(tid >> 6), lane = tid & 63, r32 = lane & 31, hi = lane >> 5;
    const int sr = tid >> 4, sc = (tid & 15) * 8, kr64 = tid >> 3, kc64 = (tid & 7) * 8;
    const int dkh = wid >> 2, dvq = wid & 3;
    const int vbK = (int)(unsigned)(unsigned long)(lds + CST_K) + v_rd_base(lane), vbF = (int)(unsigned)(unsigned long)(lds + CST_VF) + v_rd_base(lane), vbB = (int)(unsigned)(unsigned long)(lds + CST_VB) + v_rd_base(lane);
    f32x16 aF = f32x16{}, aB = f32x16{};
    for (int t = 0; t < 4; ++t) {
        const bf16x8 kk = *(const bf16x8*)(K + (size_t)(row0 + 64 * t + kr64) * LDP + kc64);
        const bf16x8 v0 = *(const bf16x8*)(V + (size_t)(row0 + 64 * t + sr) * LDP + sc), v1 = *(const bf16x8*)(V + (size_t)(row0 + 64 * t + 32 + sr) * LDP + sc);
        const float j0 = (float)(64 * t + sr), j1 = j0 + 32.f;
        const float f0 = __builtin_amdgcn_exp2f(lf * (255.f - j0)), f1 = __builtin_amdgcn_exp2f(lf * (255.f - j1)), b0 = __builtin_amdgcn_exp2f(lb * j0), b1 = __builtin_amdgcn_exp2f(lb * j1);
        __syncthreads();
        *(LAS bf16x8*)(lds + CST_K + v_st(kr64, kc64)) = kk;
        *(LAS bf16x8*)(lds + CST_VF + v_st(sr, sc)) = scale_frag(v0, f0); *(LAS bf16x8*)(lds + CST_VF + v_st(32 + sr, sc)) = scale_frag(v1, f1);
        *(LAS bf16x8*)(lds + CST_VB + v_st(sr, sc)) = scale_frag(v0, b0); *(LAS bf16x8*)(lds + CST_VB + v_st(32 + sr, sc)) = scale_frag(v1, b1);
        __syncthreads();
#pragma unroll
        for (int ks = 0; ks < 4; ++ks) {
            const bf16x8 a = trfrag(vbK, v_rd_off(dkh, ks, 0)), bf = trfrag(vbF, v_rd_off(dvq, ks, 0)), bb = trfrag(vbB, v_rd_off(dvq, ks, 0));
            asm volatile("s_waitcnt lgkmcnt(0)" ::: "memory"); SBAR();
            aF = __builtin_amdgcn_mfma_f32_32x32x16_bf16(a, bf, aF, 0, 0, 0);
            aB = __builtin_amdgcn_mfma_f32_32x32x16_bf16(a, bb, aB, 0, 0, 0);
        }
    }
    float* o0 = UO + (size_t)(32 * dkh) * 128 + 32 * dvq + r32;
#pragma unroll
    for (int r = 0; r < 16; ++r) { o0[(size_t)crow(r, hi) * 128] = aF[r]; o0[8192 + (size_t)crow(r, hi) * 128] = aB[r]; }
    __syncthreads();
}
__device__ __forceinline__ void c_build_states(LAS unsigned char* lds, const float* UBH, int c, float lf, float lb, int tid) {
    const int d = tid >> 3, c0 = (tid & 7) * 16;
    f32x4 sf[4], sb[4];
#pragma unroll
    for (int q = 0; q < 4; ++q) { sf[q] = (f32x4){0.f, 0.f, 0.f, 0.f}; sb[q] = (f32x4){0.f, 0.f, 0.f, 0.f}; }
#pragma unroll
    for (int g = 0; g < 3; ++g) {
        f32x4 x[3][4]; float wf[3], wb[3];
#pragma unroll
        for (int u = 0; u < 3; ++u) { const int cp = 3 * g + u; const bool fw = cp < c;
            const float w = (cp == c) ? 0.f : fw ? __builtin_amdgcn_exp2f(lf * (float)(256 * (c - cp) - 255)) : __builtin_amdgcn_exp2f(lb * (float)(256 * (cp - c) - 255));
            wf[u] = fw ? w : 0.f; wb[u] = fw ? 0.f : w;
            const f32x4* src = (const f32x4*)(UBH + ((size_t)cp * 2 + (fw ? 0 : 1)) * 8192 + (size_t)d * 128 + c0);
#pragma unroll
            for (int q = 0; q < 4; ++q) x[u][q] = src[q]; }
#pragma unroll
        for (int u = 0; u < 3; ++u)
#pragma unroll
            for (int q = 0; q < 4; ++q) { sf[q] += x[u][q] * wf[u]; sb[q] += x[u][q] * wb[u]; }
    }
    { const float w = __builtin_amdgcn_exp2f(lb * (float)(2049 - 256 * c));
      const f32x4* src = (const f32x4*)(UBH + (size_t)1 * 8192 + (size_t)d * 128 + c0);
#pragma unroll
      for (int q = 0; q < 4; ++q) sb[q] += src[q] * w; }
#pragma unroll
    for (int half = 0; half < 2; ++half) {
        v4u wf, wb; wf.x = cvt_pk_bf16(sf[2 * half][0], sf[2 * half][1]); wf.y = cvt_pk_bf16(sf[2 * half][2], sf[2 * half][3]); wf.z = cvt_pk_bf16(sf[2 * half + 1][0], sf[2 * half + 1][1]); wf.w = cvt_pk_bf16(sf[2 * half + 1][2], sf[2 * half + 1][3]);
        wb.x = cvt_pk_bf16(sb[2 * half][0], sb[2 * half][1]); wb.y = cvt_pk_bf16(sb[2 * half][2], sb[2 * half][3]); wb.z = cvt_pk_bf16(sb[2 * half + 1][0], sb[2 * half + 1][1]); wb.w = cvt_pk_bf16(sb[2 * half + 1][2], sb[2 * half + 1][3]);
        *(LAS v4u*)(lds + L_STASH + v_st(d, c0 + 8 * half)) = wf; *(LAS v4u*)(lds + L_STASH + 16384 + v_st(d, c0 + 8 * half)) = wb; }
}
__device__ __forceinline__ void c_state_steps(LAS unsigned char* lds, const bf16* Q, float lf, float lb, f32x16 (&o)[4], int tid) {
    const int wid = __builtin_amdgcn_readfirstlane(tid >> 6), lane = tid & 63, r32 = lane & 31, hi = lane >> 5;
    const float il = (float)(wid * 32 + r32), ff = __builtin_amdgcn_exp2f(lf * il), fb = __builtin_amdgcn_exp2f(lb * (255.f - il));
    const bf16* Qw = Q + (size_t)(wid * 32 + r32) * LDP + hi * 8;
    bf16x8 q0 = *(const bf16x8*)(Qw), q1 = *(const bf16x8*)(Qw + 16), q2 = *(const bf16x8*)(Qw + 32), q3 = *(const bf16x8*)(Qw + 48);
    const int vbF = (int)(unsigned)(unsigned long)(lds + L_STASH) + v_rd_base(lane);
    pv_d0(o, vbF, scale_frag(q0, ff), scale_frag(q1, ff), scale_frag(q2, ff), scale_frag(q3, ff));
    pv_d0(o, vbF + 16384, scale_frag(q0, fb), scale_frag(q1, fb), scale_frag(q2, fb), scale_frag(q3, fb));
}
}

__device__ __forceinline__ void mix_simple(int l, const bf16* P, bf16* OA, bf16* OB, bf16* YR, const float* dlam, const float* dnorm, const float* rpb, const float* rdecay,
                                           const float* rnorm, float lam_init, LAS float* buf, int gw, int NGW, int lane, int modemask) {
    float lam;
    { const float v = dlam[lane] * dlam[64 + lane], w = dlam[128 + lane] * dlam[192 + lane]; lam = expf(wave_sum(v)) - expf(wave_sum(w)) + lam_init; }
    for (int it = gw; it < 3 * R * 8; it += NGW) {
        const int mode = it / (R * 8), rem = it - mode * (R * 8);
        if (!((modemask >> mode) & 1)) continue;
        const int b = rem / (8 * SB), h = (rem / SB) & 7, s = rem % SB;
        const bool cq = s < CTXL; if (cq && l == 1) continue;
        const int row = b * SB + s; const bf16* Pb = P + (size_t)b * SB * INC; const bf16* Prow = P + (size_t)row * INC;
        if (mode == 0) {
            const int nk = cq ? CTXL : SB; float oa0 = 0.f, oa1 = 0.f;
            for (int map = 0; map < 2; ++map) {
                float q[64]; load_q<64>(q, Prow + C_AQ + h * 128 + map * 64);
                float mx = -INFINITY;
                for (int j = lane; j < nk; j += 64) { const float sc = dot_q<64>(q, Pb + (size_t)j * INC + C_AK + h * 128 + map * 64); buf[j] = sc; mx = fmaxf(mx, sc); }
                const float inv = softmax_buf(buf, nk, mx, lane);
                float a0 = 0.f, a1 = 0.f; const bf16* vb = Pb + C_AV + h * 128 + lane;
#pragma unroll 8
                for (int j = 0; j < nk; ++j) { const float p = buf[j]; a0 += p * bf1(vb[(size_t)j * INC]); a1 += p * bf1(vb[(size_t)j * INC + 64]); }
                a0 *= inv; a1 *= inv;
                if (map == 0) { oa0 = a0; oa1 = a1; } else { oa0 -= lam * a0; oa1 -= lam * a1; }
                LDS_WAIT(); asm volatile("" ::: "memory");
            }
            const float rstd = 1.0f / sqrtf(wave_sum(oa0 * oa0 + oa1 * oa1) * (1.0f / 128.0f) + EPS), cm = 1.0f - lam_init;
            bf16* op = OA + (size_t)row * 1024 + h * 128 + lane;
            op[0] = (bf16)f2bf(oa0 * rstd * dnorm[lane] * cm); op[64] = (bf16)f2bf(oa1 * rstd * dnorm[64 + lane] * cm);
        } else if (mode == 1) {
            float q[128]; load_q<128>(q, Prow + C_BQ + h * 128);
            float mx = -INFINITY; int nk = CTXL, r = 0, qc = 0, rs = 0, cs = 0;
            for (int j = lane; j < CTXL; j += 64) { const float sc = dot_q<128>(q, Pb + (size_t)j * INC + C_BK + h * 128); buf[j] = sc; mx = fmaxf(mx, sc); }
            if (!cq) { const int t = s - CTXL; r = t >> 6; qc = t & 63; rs = min(max(r - 4, 0), 24); cs = min(max(qc - 8, 0), 48); nk = CTXL + 128;
                for (int i = lane; i < 128; i += 64) { const int kr = rs + (i >> 4), kc = cs + (i & 15);
                    const float sc = dot_q<128>(q, Pb + (size_t)(CTXL + kr * 64 + kc) * INC + C_BK + h * 128) + rpb[(h * 15 + (kr - r + 7)) * 31 + (kc - qc + 15)] * LOG2E;
                    buf[CTXL + i] = sc; mx = fmaxf(mx, sc); } }
            const float inv = softmax_buf(buf, nk, mx, lane);
            float a0 = 0.f, a1 = 0.f; const bf16* vb = Pb + C_BV + h * 128 + lane;
#pragma unroll 8
            for (int j = 0; j < nk; ++j) { const int kk = (j < CTXL) ? j : CTXL + (rs + ((j - CTXL) >> 4)) * 64 + cs + ((j - CTXL) & 15);
                const float p = buf[j]; a0 += p * bf1(vb[(size_t)kk * INC]); a1 += p * bf1(vb[(size_t)kk * INC + 64]); }
            bf16* op = OB + (size_t)row * 1024 + h * 128 + lane;
            op[0] = (bf16)f2bf(a0 * inv); op[64] = (bf16)f2bf(a1 * inv);
            LDS_WAIT(); asm volatile("" ::: "memory");
        } else {
            float q[64]; load_q<64>(q, Prow + C_CQ + h * 64);
            const int nk = cq ? CTXL : SB;
            const float lf = -log1pf(expf(-rdecay[h])) * LOG2E, lb = -log1pf(expf(-rdecay[8 + h])) * LOG2E;
            for (int j = lane; j < nk; j += 64) { const float sc = dot_q<64>(q, Pb + (size_t)j * INC + C_CK + h * 64);
                const int df = s - j, db = ((!cq && j < CTXL) ? SB : 0) - df;
                const float w = (df >= 0 ? __builtin_amdgcn_exp2f(lf * (float)df) : 0.f) + (db >= 0 ? __builtin_amdgcn_exp2f(lb * (float)db) : 0.f);
                buf[j] = sc * w; }
            LDS_WAIT(); asm volatile("" ::: "memory");
            float a0 = 0.f, a1 = 0.f; const bf16* vb = Pb + C_CV + h * 128 + lane;
#pragma unroll 8
            for (int j = 0; j < nk; ++j) { const float p = buf[j]; a0 += p * bf1(vb[(size_t)j * INC]); a1 += p * bf1(vb[(size_t)j * INC + 64]); }
            const float rstd = 1.0f / sqrtf(wave_sum(a0 * a0 + a1 * a1) * (1.0f / 128.0f) + EPS);
            const bf16* gp = Prow + C_CG + h * 128 + lane;
            bf16* op = YR + (size_t)row * 1024 + h * 128 + lane;
            op[0] = (bf16)f2bf(a0 * rstd * rnorm[lane] * silu_f(bf1(gp[0]))); op[64] = (bf16)f2bf(a1 * rstd * rnorm[64 + lane] * silu_f(bf1(gp[64])));
            LDS_WAIT(); asm volatile("" ::: "memory");
        }
    }
}

__device__ __forceinline__ void mix_states(LAS unsigned char* lds, const bf16* P, float* UST, const float* rdecay, int vcu, int G, int tid_in) {
    for (int it = vcu; it < 64 * 9; it += G) {
        int tid = tid_in; asm volatile("" : "+v"(tid));
        const int bh = it / 9, c = it - bh * 9, b = bh >> 3, h = bh & 7;
        const float lf = -log1pf(expf(-rdecay[h])) * LOG2E, lb = -log1pf(expf(-rdecay[8 + h])) * LOG2E;
        att::c_state_item(lds, P + C_CK + h * 64, P + C_CV + h * 128, b * SB + 256 * c, lf, lb, UST + (size_t)it * 2 * 8192, tid);
    }
}

__device__ __forceinline__ void mix_mfma(int l, LAS unsigned char* lds, const bf16* P, bf16* OA, bf16* OB, bf16* YR, const float* dlam, const float* dnorm, const float* rpb,
                                         const float* rdecay, const float* rnorm, float lam_init, const float* UST, unsigned* STG, int vcu, int G, int tid_in, int modemask) {
    const int wid = __builtin_amdgcn_readfirstlane(tid_in >> 6);
    const int nun = 512 + (l == 0 ? 64 : 0);
    if (modemask & 1) {
        float lam; { const int lane = tid_in & 63; const float v = dlam[lane] * dlam[64 + lane], w = dlam[128 + lane] * dlam[192 + lane]; lam = expf(wave_sum(v)) - expf(wave_sum(w)) + lam_init; }
        lam = __builtin_bit_cast(float, __builtin_amdgcn_readfirstlane(__builtin_bit_cast(int, lam)));
        for (int u = vcu; u < nun; u += G) {
            const bool cu = u >= 512; const int uu = cu ? u - 512 : u;
            const int b = cu ? (uu >> 3) : (uu >> 6), h = cu ? (uu & 7) : ((uu >> 3) & 7), qb = cu ? 0 : (uu & 7);
            const int grow0 = b * SB + (cu ? 0 : CTXL + 256 * qb), NT = cu ? 4 : 36;
            att::f32x16 o[4];
            for (int map = 0; map < 2; ++map) {
                int tid = tid_in; asm volatile("" : "+v"(tid)); const int lane = tid & 63;
                const att::UnitD ud{P + (size_t)grow0 * INC + C_AQ + h * 128 + map * 64, P + C_AK + h * 128 + map * 64, P + C_AV + h * 128, b * SB, 4, 1000, NT};
                const att::ModeP mp{};
#if A_RING3
                att::attn_a3(lds, ud.Q, ud.K, ud.V, ud.row_base, ud.NT, o, tid); (void)mp;
                LAS unsigned* st = (LAS unsigned*)(lds + (wid < 7 ? att::L_STASH3 + wid * 8192 : LTAB_OFF)) + lane;
#else
                att::attn_core<64, 0, 2>(lds, ud, mp, o, tid);
                LAS unsigned* st = (LAS unsigned*)(lds + att::L_STASH) + wid * 2048 + lane;
#endif
                if (map == 0) {
#pragma unroll
                    for (int d = 0; d < 4; ++d)
#pragma unroll
                        for (int r2 = 0; r2 < 8; ++r2) st[(d * 8 + r2) * 64] = cvt_pk_bf16(o[d][2 * r2], o[d][2 * r2 + 1]);
                } else {
#pragma unroll
                    for (int d = 0; d < 4; ++d)
#pragma unroll
                        for (int r2 = 0; r2 < 8; ++r2) { const unsigned w = st[(d * 8 + r2) * 64]; o[d][2 * r2] = bflo(w) - lam * o[d][2 * r2]; o[d][2 * r2 + 1] = bfhi(w) - lam * o[d][2 * r2 + 1]; }
                }
                LDS_WAIT(); asm volatile("" ::: "memory");
            }
            { int tid = tid_in; asm volatile("" : "+v"(tid)); att::attn_epi<0>(lds, o, tid, grow0, OA, h * 128, dnorm, 1.0f - lam_init, nullptr); }
        }
    }
    if (modemask & 4) {
        for (int u = (vcu + 64) % G; u < nun; u += G) {
            const bool cu = u >= 512; const int uu = cu ? u - 512 : u;
            const int b = cu ? (uu >> 3) : (uu >> 6), h = cu ? (uu & 7) : ((uu >> 3) & 7), c = cu ? 0 : (uu & 7) + 1;
            const int grow0 = b * SB + 256 * c;
            att::f32x16 o[4]; int tid = tid_in; asm volatile("" : "+v"(tid));
            const float lf = -log1pf(expf(-rdecay[h])) * LOG2E, lb = -log1pf(expf(-rdecay[8 + h])) * LOG2E;
            const bf16* Qp = P + (size_t)grow0 * INC + C_CQ + h * 64;
            __syncthreads();
            if (!cu) att::c_build_states(lds, UST + (size_t)(b * 8 + h) * 9 * 2 * 8192, c, lf, lb, tid);
            const att::UnitD ud{Qp, P + C_CK + h * 64, P + C_CV + h * 128, grow0, 4, 1000, 4};
            att::ModeP mp{}; mp.lf = lf; mp.lb = lb; mp.sq0 = 0; mp.latq = 0;
            att::attn_core<64, 2, 2>(lds, ud, mp, o, tid);
            if (!cu) att::c_state_steps(lds, Qp, lf, lb, o, tid);
            att::attn_epi<2>(lds, o, tid, grow0, YR, h * 128, rnorm, 1.0f, P + C_CG + h * 128);
        }
    }
    if (modemask & 2) {
        for (int u = (vcu + 128) % G; u < nun; u += G) {
            const bool cu = u >= 512; const int uu = cu ? u - 512 : u;
            const int b = cu ? (uu >> 3) : (uu >> 6), h = cu ? (uu & 7) : ((uu >> 3) & 7), g = cu ? 0 : (uu & 7);
            const int grow0 = b * SB + (cu ? 0 : CTXL + 256 * g);
            const int kr0 = min(max(4 * g - 4, 0), 24), kr1 = min(max(4 * g - 1, 0), 24) + 7, nkr = kr1 - kr0 + 1, NT = cu ? 4 : ((4 + nkr + 1) & ~1);
            att::f32x16 o[4]; int tid = tid_in; asm volatile("" : "+v"(tid));
            const att::UnitD ud{P + (size_t)grow0 * INC + C_BQ + h * 128, P + C_BK + h * 128, P + C_BV + h * 128, b * SB, 4 + kr0, nkr - 1, NT};
            att::ModeP mp{}; mp.plain = cu ? 1 : 0; mp.kr0 = kr0; mp.nkr = nkr; mp.qr0 = 4 * g; mp.rpb = rpb + h * 465;
#if B_STEP4
            att::attn_b4(lds, ud, mp, o, tid);
#elif B_RING3
            att::attn_b3(lds, ud, mp, o, tid);
#else
            att::attn_core<128, 1, BSD>(lds, ud, mp, o, tid);
#endif
            att::attn_epi<1>(lds, o, tid, grow0, OB, h * 128, nullptr, 1.0f, nullptr);
        }
    }
    __syncthreads();
}

struct TArgs { const float* xin; const float* cin; const bf16* hin; bf16* hout; float* fout; const bf16* Y; const bf16* YP; float wgt; const float* gate; const float* postg;
               const float* preg; const float* shift; const float* scale; bf16* U; int upd, nxt, skip_ctx; };
template <bool XIN> struct RawRow { typename std::conditional<XIN, v4u, v2u>::type v[8]; v2u y[8]; };
template <bool XIN> __device__ __forceinline__ void thin_load_row(const TArgs& T, int row, int lane, RawRow<XIN>& r) {
    const int b = row / SB, s = row - b * SB; const bool cq = s < CTXL;
    if (cq && T.skip_ctx) return;
    if constexpr (XIN) { const v4u* hi_ = (const v4u*)(cq ? T.cin + (size_t)(b * CTXL + s) * DM : T.xin + (size_t)(b * SEQ + s - CTXL) * DM) + lane;
#pragma unroll
        for (int j = 0; j < 8; ++j) r.v[j] = __builtin_nontemporal_load(hi_ + 64 * j); }
    else { const v2u* hi_ = (const v2u*)(T.hin + (size_t)row * DM) + lane;
#pragma unroll
        for (int j = 0; j < 8; ++j) r.v[j] = __builtin_nontemporal_load(hi_ + 64 * j); }
    if (T.upd) {
        if (cq && T.YP) { const v2u* yp = (const v2u*)(T.YP + (size_t)(b * CTXL + s) * DM) + lane; constexpr size_t ZS = (size_t)NBATCH * CTXL * DM / 4;
#pragma unroll
            for (int j = 0; j < 8; ++j) { const v2u w0 = yp[64 * j], w1 = yp[64 * j + ZS], w2 = yp[64 * j + 2 * ZS], w3 = yp[64 * j + 3 * ZS];
                r.y[j] = (v2u){cvt_pk_bf16((bflo(w0.x) + bflo(w1.x)) + (bflo(w2.x) + bflo(w3.x)), (bfhi(w0.x) + bfhi(w1.x)) + (bfhi(w2.x) + bfhi(w3.x))),
                               cvt_pk_bf16((bflo(w0.y) + bflo(w1.y)) + (bflo(w2.y) + bflo(w3.y)), (bfhi(w0.y) + bfhi(w1.y)) + (bfhi(w2.y) + bfhi(w3.y)))}; } }
        else { const v2u* yp = (const v2u*)(T.Y + (size_t)row * DM) + lane;
#pragma unroll
            for (int j = 0; j < 8; ++j) r.y[j] = __builtin_nontemporal_load(yp + 64 * j); }
    }
}
template <bool XIN> __device__ __forceinline__ void thin_do_row(const TArgs& T, int row, int lane, const RawRow<XIN>& r, const LAS f32x4* L) {
    const int b = row / SB, s = row - b * SB; const bool cq = s < CTXL;
    if (cq && T.skip_ctx) return;
    const int co = cq ? 512 : 0;
    f32x4 v[8];
#pragma unroll
    for (int j = 0; j < 8; ++j) { if constexpr (XIN) v[j] = __builtin_bit_cast(f32x4, r.v[j]); else v[j] = (f32x4){bflo(r.v[j].x), bfhi(r.v[j].x), bflo(r.v[j].y), bfhi(r.v[j].y)}; }
    if (T.upd) {
        f32x4 y[8]; float ss = 0.f;
#pragma unroll
        for (int j = 0; j < 8; ++j) y[j] = (f32x4){bflo(r.y[j].x), bfhi(r.y[j].x), bflo(r.y[j].y), bfhi(r.y[j].y)};
#pragma unroll
        for (int j = 0; j < 8; ++j) ss += (y[j][0] * y[j][0] + y[j][1] * y[j][1]) + (y[j][2] * y[j][2] + y[j][3] * y[j][3]);
        const float rstd = 1.0f / sqrtf(wave_sum(ss) * (1.0f / DM) + EPS) * T.wgt;
#pragma unroll
        for (int j = 0; j < 8; ++j) v[j] += L[co + lane + 64 * j] * (y[j] * rstd * L[1024 + lane + 64 * j]);
        if (T.fout) { if (!cq) { f32x4* ho_ = (f32x4*)(T.fout + (size_t)(b * SEQ + s - CTXL) * DM) + lane;
#pragma unroll
            for (int j = 0; j < 8; ++j) ho_[64 * j] = v[j]; } }
        else { v2u* ho_ = (v2u*)(T.hout + (size_t)row * DM) + lane;
#pragma unroll
            for (int j = 0; j < 8; ++j) { v2u w; w.x = cvt_pk_bf16(v[j][0], v[j][1]); w.y = cvt_pk_bf16(v[j][2], v[j][3]); ho_[64 * j] = w;
                v[j] = (f32x4){bflo(w.x), bfhi(w.x), bflo(w.y), bfhi(w.y)}; } }
    }
    if (T.nxt) {
        float ss = 0.f;
#pragma unroll
        for (int j = 0; j < 8; ++j) ss += (v[j][0] * v[j][0] + v[j][1] * v[j][1]) + (v[j][2] * v[j][2] + v[j][3] * v[j][3]);
        const float rstd = 1.0f / sqrtf(wave_sum(ss) * (1.0f / DM) + EPS);
        v2u* up = (v2u*)(T.U + (size_t)row * DM) + lane;
#pragma unroll
        for (int j = 0; j < 8; ++j) { const f32x4 u = (v[j] * rstd * L[1536 + lane + 64 * j]) * (L[2048 + co + lane + 64 * j] + 1.0f) + L[3072 + co + lane + 64 * j];
            v2u w; w.x = cvt_pk_bf16(u[0], u[1]); w.y = cvt_pk_bf16(u[2], u[3]); up[64 * j] = w; }
    }
}
template <bool XIN> __device__ __forceinline__ void thin_phase(const TArgs& T, LAS unsigned char* lds, int vcu, int G, int tid) {
    const int lane = tid & 63, wave = __builtin_amdgcn_readfirstlane(tid >> 6);
    const int rpc = R / G, base = vcu * rpc, bb = base / SB;
    LAS f32x4* L = (LAS f32x4*)lds;
    f32x4 sv[8];
#pragma unroll
    for (int vsel = 0; vsel < 8; ++vsel) { const size_t mo = (size_t)((vsel & 1) ? 8 : bb) * (9 * DM);
        const float* src = (vsel < 2) ? (T.upd ? T.gate + mo : nullptr) : (vsel == 2) ? (T.upd ? T.postg : nullptr) : (vsel == 3) ? (T.nxt ? T.preg : nullptr)
                         : (vsel < 6) ? (T.nxt ? T.scale + mo : nullptr) : (T.nxt ? T.shift + mo : nullptr);
        sv[vsel] = src ? ((const f32x4*)src)[tid] : (f32x4){0.f, 0.f, 0.f, 0.f}; }
    const int nk = rpc / NWAVES, r0 = base + wave;
    RawRow<XIN> A, B, C;
    thin_load_row<XIN>(T, r0, lane, A); if (1 < nk) thin_load_row<XIN>(T, r0 + NWAVES, lane, B);
#pragma unroll
    for (int vsel = 0; vsel < 8; ++vsel) L[vsel * 512 + tid] = sv[vsel];
    __syncthreads();
    for (int k = 0; k < nk; k += 3) {
        if (k + 2 < nk) thin_load_row<XIN>(T, r0 + NWAVES * (k + 2), lane, C);
        thin_do_row<XIN>(T, r0 + NWAVES * k, lane, A, L);
        if (k + 1 < nk) { if (k + 3 < nk) thin_load_row<XIN>(T, r0 + NWAVES * (k + 3), lane, A);
            thin_do_row<XIN>(T, r0 + NWAVES * (k + 1), lane, B, L); }
        if (k + 2 < nk) { if (k + 4 < nk) thin_load_row<XIN>(T, r0 + NWAVES * (k + 4), lane, B);
            thin_do_row<XIN>(T, r0 + NWAVES * (k + 2), lane, C, L); }
    }
    __syncthreads();
}

__device__ __forceinline__ void p0_convert(int l, const float* w1, const float* w2, const float* win, const float* wb, const float* wo, unsigned char* wt, LAS unsigned char* lds, int gw, int NGW, int wave, int lane, int it0 = 0, int it1 = 1 << 30) {
    LAS float* scr = (LAS float*)(lds + wave * 16384);
    constexpr int I_W1 = 32 * 352, I_W2 = 88 * 64, I_IN = 32 * 480, I_WB = 16 * 64, I_WO = 32 * 64, NIT = 2 * I_W1 + 2 * I_W2 + I_IN + 3 * I_WB + I_WO;
    const int itE = it1 < NIT ? it1 : NIT;
    for (int it = it0 + gw; it < itE; it += NGW) {
        int r = it;
        if (r < 2 * I_W1) { const int i = r / I_W1; r -= i * I_W1; const int kb = r / 352, n0 = (r % 352) * 32;
            const int orow0 = (n0 < FFN) ? (n0 / 128) * 256 + (n0 % 128) : ((n0 - FFN) / 128) * 256 + 128 + ((n0 - FFN) % 128);
            transpose_item(w1 + (size_t)(l * 2 + i) * DM * (2 * FFN), DM, 2 * FFN, (bf16*)(wt + (i ? WT_W1B : WT_W1A)), kb * 64, n0, orow0, (n0 < FFN) ? -LOG2E : -1.0f / LOG2E, scr, lane); continue; }
        r -= 2 * I_W1;
        if (r < 2 * I_W2) { const int i = r / I_W2; r -= i * I_W2; const int kb = r / 64, n0 = (r % 64) * 32;
            transpose_item(w2 + (size_t)(l * 2 + i) * FFN * DM, FFN, DM, (bf16*)(wt + (i ? WT_W2B : WT_W2A)), kb * 64, n0, n0, 1.0f, scr, lane); continue; }
        r -= 2 * I_W2;
        if (r < I_IN) { const int kb = r / 480, n0 = (r % 480) * 32;
            const float sc = (n0 < C_AK) ? SCALE_A : (n0 >= C_BQ && n0 < C_BK) ? SCALE_B : (n0 >= C_CK && n0 < C_CV) ? SCALE_CK : 1.0f;
            transpose_item(win + (size_t)l * DM * INC, DM, INC, (bf16*)(wt + WT_IN), kb * 64, n0, n0, sc, scr, lane); continue; }
        r -= I_IN;
        if (r < 3 * I_WB) { const int br = r / I_WB; r -= br * I_WB; const int kb = r / 64, n0 = (r % 64) * 32;
            transpose_item(wb + (size_t)(l * 3 + br) * 1024 * DM, 1024, DM, (bf16*)(wt + WT_WB) + (size_t)br * DM * 1024, kb * 64, n0, n0, 1.0f, scr, lane); continue; }
        r -= 3 * I_WB;
        { const int kb = r / 64, n0 = (r % 64) * 32; transpose_item(wo + (size_t)l * DM * DM, DM, DM, (bf16*)(wt + WT_WO), kb * 64, n0, n0, 1.0f, scr, lane); }
    }
}
__device__ __forceinline__ void p0_mod(const float* c, const float* cctx, const float* wmod, const float* bmod, float* MOD, LAS unsigned char* lds, int it0, int it1, int G, int tid, int wave, int lane) {
    LAS float* S = (LAS float*)(lds + wave * 9216);
    for (int it = it0; it < it1; it += G) {
        const int l = it / 72, n0 = (it % 72) * 256, k0 = wave * 256;
        for (int r = 0; r < 9; ++r) for (int kk = lane; kk < 256; kk += 64) { const float x = (r < 8) ? c[r * DM + k0 + kk] : cctx[k0 + kk]; S[r * 256 + kk] = x / (1.0f + expf(-x)); }
        LDS_WAIT(); asm volatile("" ::: "memory");
        f32x4 acc[9];
#pragma unroll
        for (int r = 0; r < 9; ++r) acc[r] = (f32x4){0.f, 0.f, 0.f, 0.f};
        const float* wp = wmod + ((size_t)(l * DM + k0)) * 18432 + n0 + 4 * lane;
#pragma unroll 2
        for (int kk = 0; kk < 256; kk += 4) {
            const f32x4 w0 = *(const f32x4*)(wp + (size_t)(kk + 0) * 18432), w1 = *(const f32x4*)(wp + (size_t)(kk + 1) * 18432), w2 = *(const f32x4*)(wp + (size_t)(kk + 2) * 18432), w3 = *(const f32x4*)(wp + (size_t)(kk + 3) * 18432);
#pragma unroll
            for (int r = 0; r < 9; ++r) { const f32x4 s = *(const LAS f32x4*)(S + r * 256 + kk); acc[r] += w0 * s[0] + w1 * s[1] + w2 * s[2] + w3 * s[3]; }
        }
        asm volatile("" ::: "memory");
#pragma unroll
        for (int r = 0; r < 9; ++r) *(LAS f32x4*)(S + r * 256 + 4 * lane) = acc[r];
        __syncthreads();
        for (int idx = tid; idx < 9 * 256; idx += NWAVES * 64) { const int r = idx >> 8, cc = idx & 255; float s = bmod[l * 18432 + n0 + cc];
#pragma unroll
            for (int w = 0; w < NWAVES; ++w) s += ((const LAS float*)(lds + w * 9216))[r * 256 + cc];
            MOD[(size_t)(l * 9 + r) * 18432 + n0 + cc] = s; }
        __syncthreads();
    }
}

constexpr int BG_NIT = 2 * 32 * 352 + 2 * 88 * 64 + 32 * 480 + 3 * 16 * 64 + 32 * 64;
#ifndef P0_SPLIT
#define P0_SPLIT 38000
#endif
#ifndef BG1
#define BG1 17000
#define BG2 34000
#define BG3 54272
#endif
#define BG_CONVERT(FIRST_IDLE, IT0, IT1) do { if (l == 0 && (int)blockIdx.x >= (FIRST_IDLE) && (IT1) > (IT0)) { PH_VARS \
    p0_convert(1, a.in[8], a.in[9], a.in[10], a.in[16], a.in[17], ws + WS_WT1, lds, ((int)blockIdx.x - (FIRST_IDLE)) * NWAVES + wave, (G - (FIRST_IDLE)) * NWAVES, wave, lane, (IT0), (IT1)); } } while (0)
#ifndef PROBE_DUP
#define PROBE_DUP 0
#endif
#ifndef MFMA_MODES
#define MFMA_MODES 7
#endif
#define GEMM_PHASE_Z(EPI_T, E_, Aptr, Bptr, N_, K_, LD_, ZA_, ZB_, ZN_, NM_, LAT_) do { \
    pg8::Gemm g_{(const bf16*)(Aptr), (const bf16*)(Bptr), R, (N_), (K_), (LD_), (size_t)(ZA_), (size_t)(ZB_)}; pg8::PanelOrder S_; S_.init((NM_), (N_), G, (int)blockIdx.x, (LAT_), (ZN_)); \
    pg8::gemm_phase<EPI_T, pg8::PanelOrder, true, true>(lds, g_, S_, E_); } while (0)
#define GEMM_PHASE_CTX(Aptr, Bptr, N_, KS_, LD_) do { const ep::EpiF32Part Ep_{(float*)YP}; \
    pg8::Gemm g_{(const bf16*)(Aptr), (const bf16*)(Bptr), R, (N_), (KS_), (LD_), (size_t)(KS_) * 2, (size_t)(KS_) * 2}; pg8::CtxSplitOrder S_; S_.init((N_), G, (int)blockIdx.x); \
    pg8::gemm_phase<ep::EpiF32Part, pg8::CtxSplitOrder, true, true>(lds, g_, S_, Ep_); } while (0)
#define GEMM_PHASE_LC(Aptr, Bptr, K_) do { const ep::EpiYMix Em_{Y, YP}; \
    pg8::Gemm g_{(const bf16*)(Aptr), (const bf16*)(Bptr), R, DM, (K_), (K_), (size_t)((K_) / 4) * 2, (size_t)((K_) / 4) * 2}; pg8::LatCtxOrder S_; S_.init(G, (int)blockIdx.x, (K_) / 256); \
    pg8::gemm_phase<ep::EpiYMix, pg8::LatCtxOrder, true, true>(lds, g_, S_, Em_); } while (0)
#define GEMM_PHASE(EPI_T, E_, Aptr, Bptr, N_, K_, NM_, LAT_) GEMM_PHASE_Z(EPI_T, E_, Aptr, Bptr, N_, K_, K_, 0, 0, 1, NM_, LAT_)

#define LTAB_FILL() do { __syncthreads(); { int tid0 = threadIdx.x; asm volatile("" : "+v"(tid0)); for (int e = tid0; e < 1024; e += NWAVES * 64) { const int pos = e >> 4, i = e & 15; \
        const float rev = (float)pos * __builtin_amdgcn_exp2f(-(float)i * 0.8304820237218406f) * 0.15915494309189535f; \
        ((LAS f32x2*)(lds + LTAB_OFF))[e] = (f32x2){__builtin_amdgcn_cosf(rev), __builtin_amdgcn_sinf(rev)}; } } __syncthreads(); } while (0)
__global__ void __launch_bounds__(NWAVES * 64, 2) fwd_kernel(Args a_in) {
    extern __shared__ __attribute__((aligned(16))) unsigned char lds_raw[];
    LAS unsigned char* lds = (LAS unsigned char*)lds_raw;
    constexpr int G = GRID;
    const int bx = blockIdx.x, vcu = (bx % 8) * (G / 8) + bx / 8, NGW = G * NWAVES;
    { const int tid0 = threadIdx.x; for (int u = tid0; u < (LDS_BYTES - LDSCTL_OFF) / 4; u += NWAVES * 64) ((LAS unsigned*)(lds + LDSCTL_OFF))[u] = 0u; }
    __syncthreads();
    XcdBarrier bar = xcd_barrier_post((unsigned*)(a_in.ws + WS_CTL) + CW_BAR, (volatile LAS unsigned*)(lds + MISC_OFF) + 8);
#define GRID_BAR() do { XcdBarrier b_ = bar; asm volatile("" : "+s"(b_.bar)); xcd_barrier(b_); } while (0)
#define PH_VARS \
    int tid = threadIdx.x; asm volatile("" : "+v"(tid)); const int lane = tid & 63, wave = __builtin_amdgcn_readfirstlane(tid >> 6), gw = vcu * NWAVES + wave; (void)lane; (void)gw; \
    const __attribute__((address_space(4))) Args* ap = (const __attribute__((address_space(4))) Args*)__builtin_amdgcn_kernarg_segment_ptr(); asm volatile("" : "+s"(ap)); const __attribute__((address_space(4))) Args& a = *ap;     \
    unsigned char* ws = a.ws; \
    float* MOD = (float*)(ws + WS_MOD); f32x2* TAB = (f32x2*)(ws + WS_TAB); float* HC = (float*)(ws + WS_HC); bf16* U = (bf16*)(ws + WS_U); \
    bf16* OA = (bf16*)(ws + WS_OA); bf16* OB = (bf16*)(ws + WS_OB); bf16* YR = (bf16*)(ws + WS_YR); float* MACC = (float*)(ws + WS_MACC); bf16* YP = (bf16*)MACC; bf16* HB = (bf16*)(ws + WS_MACC + 64 * MiB); \
    unsigned char* wt = ws + (l ? WS_WT1 : WS_WT); bf16* P = (bf16*)(ws + WS_R1); bf16* ACT = (bf16*)(ws + WS_R1 + R1_ACT); bf16* Y = (bf16*)(ws + WS_R1 + R1_Y); float* hlat = a.out; \
    const float* MODl = MOD + (size_t)l * 9 * 18432; const float* pre = a.in[6] + l * 3 * DM; const float* post = a.in[7] + l * 3 * DM; const int lat = (l == 1), nM = lat ? 64 : NPAN; \
    (void)MOD; (void)TAB; (void)HC; (void)U; (void)OA; (void)OB; (void)YR; (void)MACC; (void)YP; (void)HB; (void)wt; (void)P; (void)ACT; (void)Y; (void)hlat; (void)MODl; (void)pre; (void)post; (void)nM;

    for (int l = 0; l < 2; ++l) {
        if (l == 0) { PH_VARS
          if (bx < 72) p0_mod(a.in[1], a.in[3], a.in[4], a.in[5], MOD, lds, bx, 72, G, tid, wave, lane);
          else p0_convert(0, a.in[8], a.in[9], a.in[10], a.in[16], a.in[17], wt, lds, (bx - 72) * NWAVES + wave, (G - 72) * NWAVES, wave, lane, 0, P0_SPLIT);
          p0_convert(0, a.in[8], a.in[9], a.in[10], a.in[16], a.in[17], wt, lds, gw, NGW, wave, lane, P0_SPLIT, BG_NIT);
          GRID_BAR(); }
        if (l == 1 && BG3 < BG_NIT) { PH_VARS p0_convert(1, a.in[8], a.in[9], a.in[10], a.in[16], a.in[17], wt, lds, gw, NGW, wave, lane, BG3, BG_NIT); GRID_BAR(); }
        if (l == 0) {
            PH_VARS
            TArgs T{a.in[0], a.in[2], nullptr, nullptr, nullptr, nullptr, nullptr, 0.f, nullptr, nullptr, pre, MODl, MODl + DM, U, 0, 1, 0};
            if (T.xin) thin_phase<true>(T, lds, vcu, G, tid); else thin_phase<false>(T, lds, vcu, G, tid); GRID_BAR();
        }
        if (PROBE_DUP & 4096) { for (int e_ = 0; e_ < 10; ++e_) GRID_BAR(); }
        { PH_VARS const ep::EpiSwiGLU E{ACT}; GEMM_PHASE(ep::EpiSwiGLU, E, U, wt + WT_W1A, 2 * FFN, DM, NPAN, 0); } BG_CONVERT(96, 0, BG1); GRID_BAR();
        if (PROBE_DUP & 8192) { PH_VARS const ep::EpiNull E{OA}; GEMM_PHASE(ep::EpiNull, E, U, wt + WT_W1A, 2 * FFN, DM, NPAN, 0); GRID_BAR(); }
        if (PROBE_DUP & 4) { PH_VARS const ep::EpiSwiGLU E{ACT}; GEMM_PHASE(ep::EpiSwiGLU, E, U, wt + WT_W1A, 2 * FFN, DM, NPAN, 0); GRID_BAR(); }
        { PH_VARS GEMM_PHASE_LC(ACT, wt + WT_W2A, FFN); } GRID_BAR();
        if (PROBE_DUP & 8) { PH_VARS const ep::EpiBf16 E{Y, DM}; GEMM_PHASE(ep::EpiBf16, E, ACT, wt + WT_W2A, DM, FFN, 64, 1); GRID_BAR(); }
        if (PROBE_DUP & 2048) { PH_VARS GEMM_PHASE_CTX(ACT, wt + WT_W2A, DM, FFN / 4, FFN); GRID_BAR(); }
        if (PROBE_DUP & 32) { PH_VARS
            TArgs T{l == 0 ? a.in[0] : nullptr, a.in[2], HB, (bf16*)ACT, nullptr, Y, YP, 0.5f, MODl + 2 * DM, post, pre + DM, MODl + 3 * DM, MODl + 4 * DM, OA, 1, 1, 0};
            if (T.xin) thin_phase<true>(T, lds, vcu, G, tid); else thin_phase<false>(T, lds, vcu, G, tid); GRID_BAR(); }
        {
            PH_VARS
            TArgs T{l == 0 ? a.in[0] : nullptr, a.in[2], HB, HB, nullptr, Y, YP, 0.5f, MODl + 2 * DM, post, pre + DM, MODl + 3 * DM, MODl + 4 * DM, U, 1, 1, 0};
            if (T.xin) thin_phase<true>(T, lds, vcu, G, tid); else thin_phase<false>(T, lds, vcu, G, tid); } GRID_BAR();
        LTAB_FILL();
        if (l == 0) { PH_VARS const ep::EpiInProj E{P, (const LAS f32x2*)(lds + LTAB_OFF)}; GEMM_PHASE(ep::EpiInProj, E, U, wt + WT_IN, INC, DM, NPAN, 0); }
        else { { PH_VARS const ep::EpiInProj E{P, (const LAS f32x2*)(lds + LTAB_OFF)}; GEMM_PHASE(ep::EpiInProj, E, U, wt + WT_IN, INC, DM, 64, 1); }
               { PH_VARS const ep::EpiInProj E{P, (const LAS f32x2*)(lds + LTAB_OFF)}; pg8::Gemm g_{(const bf16*)U, (const bf16*)(wt + WT_IN), R, INC, DM, DM, 0, 0}; pg8::CtxColsOrder S_; S_.init(G, (int)blockIdx.x);
                 pg8::gemm_phase<ep::EpiInProj, pg8::CtxColsOrder, true, true>(lds, g_, S_, E); } }
        GRID_BAR();
        if (PROBE_DUP & 16) { LTAB_FILL(); PH_VARS const ep::EpiInProj E{P, (const LAS f32x2*)(lds + LTAB_OFF)}; GEMM_PHASE(ep::EpiInProj, E, U, wt + WT_IN, INC, DM, NPAN, 0); GRID_BAR(); }
        if (PROBE_DUP & (64 | 128 | 256)) { PH_VARS
          mix_mfma(l, lds, P, OA, OB, YR, a.in[11] + l * 256, a.in[12] + l * 128, a.in[13] + l * 8 * 465, a.in[14] + l * 16, a.in[15] + l * 128,
                   l == 0 ? 0.2f : 0.35550906759096926f, (const float*)U, (unsigned*)YP, vcu, G, tid, ((PROBE_DUP & 64) ? 1 : 0) | ((PROBE_DUP & 128) ? 4 : 0) | ((PROBE_DUP & 256) ? 2 : 0)); }
        { PH_VARS mix_states(lds, P, (float*)U, a.in[14] + l * 16, vcu, G, tid); } GRID_BAR();
        for (int rep_ = 0; rep_ < ((PROBE_DUP & 2) ? 2 : 1); ++rep_)
        { PH_VARS
          if (MFMA_MODES) mix_mfma(l, lds, P, OA, OB, YR, a.in[11] + l * 256, a.in[12] + l * 128, a.in[13] + l * 8 * 465, a.in[14] + l * 16, a.in[15] + l * 128,
                   l == 0 ? 0.2f : 0.35550906759096926f, (const float*)U, (unsigned*)YP, vcu, G, tid, MFMA_MODES);
          if ((7 & ~MFMA_MODES) != 0) mix_simple(l, P, OA, OB, YR, a.in[11] + l * 256, a.in[12] + l * 128, a.in[13] + l * 8 * 465, a.in[14] + l * 16, a.in[15] + l * 128,
                   l == 0 ? 0.2f : 0.35550906759096926f, (LAS float*)(lds + wave * 9216), gw, NGW, lane, 7 & ~MFMA_MODES); }
        GRID_BAR();
        for (int rep_ = 0; rep_ < ((PROBE_DUP & 512) ? 2 : 1); ++rep_) {
        { PH_VARS const ep::EpiMerge E{P + C_GATE, U}; GEMM_PHASE_Z(ep::EpiMerge, E, OA, wt + WT_WB, DM, 1024, 1024, WS_OB - WS_OA, (size_t)DM * 1024 * 2, 3, nM, lat); } }
        if (l == 0 && bx >= 64 && bx < 136) { PH_VARS p0_mod(a.in[1], a.in[3], a.in[4], a.in[5], MOD, lds, 72 + (bx - 64), 144, G, tid, wave, lane); }
        BG_CONVERT(136, BG2, BG3); GRID_BAR();
        if (l == 0) { PH_VARS GEMM_PHASE_LC(U, wt + WT_WO, DM); } else { PH_VARS const ep::EpiBf16 E{Y, DM}; GEMM_PHASE(ep::EpiBf16, E, U, wt + WT_WO, DM, DM, 64, 1); }
        GRID_BAR();
        if (PROBE_DUP & 1024) { PH_VARS const ep::EpiBf16 E{Y, DM}; GEMM_PHASE(ep::EpiBf16, E, U, wt + WT_WO, DM, DM, nM, lat); GRID_BAR(); }
        {
            PH_VARS
            TArgs T{nullptr, nullptr, HB, HB, nullptr, Y, YP, 1.0f, MODl + 5 * DM, post + DM, pre + 2 * DM, MODl + 6 * DM, MODl + 7 * DM, U, 1, 1, lat};
            if (T.xin) thin_phase<true>(T, lds, vcu, G, tid); else thin_phase<false>(T, lds, vcu, G, tid); } GRID_BAR();
        { PH_VARS const ep::EpiSwiGLU E{ACT}; GEMM_PHASE(ep::EpiSwiGLU, E, U, wt + WT_W1B, 2 * FFN, DM, nM, lat); } BG_CONVERT(96, BG1, BG2); GRID_BAR();
        if (l == 0) { PH_VARS GEMM_PHASE_LC(ACT, wt + WT_W2B, FFN); } else { PH_VARS const ep::EpiBf16 E{Y, DM}; GEMM_PHASE(ep::EpiBf16, E, ACT, wt + WT_W2B, DM, FFN, 64, 1); }
        GRID_BAR();
        {
            PH_VARS
            const float* MOD1 = MOD + (size_t)9 * 18432;
            TArgs T{nullptr, nullptr, HB, HB, l == 1 ? hlat : nullptr, Y, YP, 0.5f, MODl + 8 * DM, post + 2 * DM, a.in[6] + 3 * DM, MOD1, MOD1 + DM, U, 1, l == 0 ? 1 : 0, lat};
            if (T.xin) thin_phase<true>(T, lds, vcu, G, tid); else thin_phase<false>(T, lds, vcu, G, tid); }
        if (l == 0) GRID_BAR();
    }
}

extern "C" void kernel_launch(void* const* d_in, const int* in_sizes, int n_in, void* d_out, int out_size, void* d_ws, size_t ws_size, hipStream_t stream) {
    static int grid = 0;
    if (grid == 0) {
        if (n_in != 18 || in_sizes[0] != NBATCH * SEQ * DM || out_size != NBATCH * SEQ * DM || ws_size < WS_END) {
            fprintf(stderr, "kernel_launch: unexpected shapes / workspace (n_in %d, in0 %d, out %d, ws %zu, need %zu); nothing launched\n", n_in, n_in > 0 ? in_sizes[0] : -1, out_size, ws_size, (size_t)WS_END); grid = -1; return; }
        int dev = 0, cus = 0, per_cu = 0;
        if (hipGetDevice(&dev) != hipSuccess || hipDeviceGetAttribute(&cus, hipDeviceAttributeMultiprocessorCount, dev) != hipSuccess) { grid = -1; return; }
        if (hipFuncSetAttribute((const void*)fwd_kernel, hipFuncAttributeMaxDynamicSharedMemorySize, LDS_BYTES) != hipSuccess) { fprintf(stderr, "kernel_launch: hipFuncSetAttribute failed\n"); grid = -1; return; }
        if (hipOccupancyMaxActiveBlocksPerMultiprocessor(&per_cu, (const void*)fwd_kernel, NWAVES * 64, LDS_BYTES) != hipSuccess || per_cu < 1)
            fprintf(stderr, "kernel_launch: note: occupancy query says %d workgroups per CU\n", per_cu);
        (void)hipGetLastError();
        if (cus < GRID) { fprintf(stderr, "kernel_launch: this kernel needs %d CUs (device has %d); nothing launched\n", GRID, cus); grid = -1; return; }
        grid = GRID;
    }
    if (grid < 0) return;
    if (hipMemsetAsync((char*)d_ws + WS_CTL, 0, CTL_ZERO_BYTES, stream) != hipSuccess) { fprintf(stderr, "kernel_launch: memset failed\n"); return; }
    Args a{};
    for (int i = 0; i < 18; ++i) a.in[i] = (const float*)d_in[i];
    a.out = (float*)d_out; a.ws = (unsigned char*)d_ws;
    hipLaunchKernelGGL(fwd_kernel, dim3(grid), dim3(NWAVES * 64), LDS_BYTES, stream, a);
    const hipError_t le = hipPeekAtLastError();
    if (le != hipSuccess) fprintf(stderr, "kernel_launch: launch failed: %s\n", hipGetErrorName(le));
}
```

```cpp
#include <hip/hip_runtime.h>
#include <cstdio>
#include <cstdint>
#include <type_traits>
namespace pg8 {
#define PG8_LAS __attribute__((address_space(3)))
typedef unsigned short bf16_t;
typedef short bf16x8 __attribute__((ext_vector_type(8)));
typedef float f32x4 __attribute__((ext_vector_type(4)));
typedef unsigned u32x4 __attribute__((ext_vector_type(4)));
constexpr int BM = 256, BK = 64, HALF = 128, HTB = HALF * BK * 2  , STAGE_BYTES = 8 * HTB, NXCD = 8, WGM = 4;

__host__ __device__ __forceinline__ int lds_byte(int r, int c) { const int st = (r >> 4) * 2 + (c >> 5), rr = r & 15, cc = c & 31, ob = rr * 64 + cc * 2; return st * 1024 + (ob ^ (((ob >> 9) & 1) << 5)); }
__host__ __device__ __forceinline__ void stage_rc(int b, int& R, int& C) { const int st = b / 1024, sb = b % 1024, swz = sb ^ (((sb >> 9) & 1) << 5); R = (st >> 1) * 16 + swz / 64; C = (st & 1) * 32 + (swz % 64) / 2; }
__host__ __device__ __forceinline__ int perm32(int rho) { const int n = rho >> 4, i = rho & 15; return 8 * (i >> 2) + 4 * n + (i & 3); }

struct Unit { int pm, pn, z, kt; };
struct Gemm { const bf16_t* A; const bf16_t* Bt; int M, N, K, ld; size_t zA, zB; };

struct PanelOrder {
    int nM, nN, nwg, G, c, lat, zn;
    __host__ __device__ void init(int nM_, int N, int G_, int c_, int lat_, int zn_ = 1) { nM = nM_; nN = N / BM; nwg = nM * nN; G = G_; c = c_; lat = lat_; zn = zn_; }
    __host__ __device__ bool next(int i, Unit& u) const {
        const int ti = i / zn; u.z = i - ti * zn; u.kt = 0;
        const long L = (long)ti * G + c; if (L >= nwg) return false;
        int wgid = (int)L; { const int q = nwg / NXCD, r = nwg % NXCD, xcd = wgid % NXCD, off = wgid / NXCD; wgid = (xcd < r ? xcd * (q + 1) : r * (q + 1) + (xcd - r) * q) + off; }
        const int nig = WGM * nN, gid = wgid / nig, fm = gid * WGM, gsz = (nM - fm) < WGM ? (nM - fm) : WGM;
        const int pm = fm + ((wgid % nig) % gsz); u.pn = (wgid % nig) / gsz; u.pm = lat ? pm + pm / 8 + 1 : pm; return true;
    }
    __device__ __forceinline__ void a_ready(const Unit&) const {}
    __device__ __forceinline__ void done(const Unit&) const {}
};
struct CtxSplitOrder {
    int nN, G, c;
    __host__ __device__ void init(int N, int G_, int c_) { nN = N / BM; G = G_; c = c_; }
    __host__ __device__ bool next(int i, Unit& u) const {
        const long L = (long)i * G + c; if (L >= 8 * nN * 4) return false;
        const int t = (int)(L >> 2); u.z = (int)(L & 3); u.kt = 0; u.pm = 9 * (t / nN); u.pn = t % nN; return true;
    }
    __device__ __forceinline__ void a_ready(const Unit&) const {}
    __device__ __forceinline__ void done(const Unit&) const {}
};
struct CtxColsOrder {
    int G, c;
    __host__ __device__ void init(int G_, int c_) { G = G_; c = c_; }
    __host__ __device__ bool next(int i, Unit& u) const {
        const long L = (long)i * G + c; if (L >= 8 * 22) return false;
        const int p = (int)L / 22, k = (int)L % 22; u.z = 0; u.kt = 0; u.pm = 9 * p; u.pn = k < 8 ? 4 + k : k < 16 ? 8 + k : 10 + k; return true;
    }
    __device__ __forceinline__ void a_ready(const Unit&) const {}
    __device__ __forceinline__ void done(const Unit&) const {}
};
struct LatCtxOrder {
    PanelOrder lat; int G, c, ktq;
    __host__ __device__ void init(int G_, int c_, int ktq_) { lat.init(64, 2048, G_, c_, 1, 1); G = G_; c = c_; ktq = ktq_; }
    __host__ __device__ bool next(int i, Unit& u) const {
        if (i == 0) { const int q = c, t = q >> 2; u.z = q & 3; u.kt = ktq; u.pm = 9 * (t >> 3); u.pn = t & 7; return q < 256; }
        return lat.next(i - 1, u);
    }
    __device__ __forceinline__ void a_ready(const Unit&) const {}
    __device__ __forceinline__ void done(const Unit&) const {}
};

template <class Epi, class Sched, bool ALIGN_EPI = false, bool SP2 = false>
__device__ __forceinline__ void gemm_phase(PG8_LAS unsigned char* lds, const Gemm g, const Sched& S, const Epi& E) {
    int tid_l = threadIdx.x; asm volatile("" : "+v"(tid_l));
    const int tid = tid_l, wid = __builtin_amdgcn_readfirstlane(tid >> 6), lane = tid & 63, wr = wid >> 2, wc = wid & 3, fr = lane & 15, fq = lane >> 4;
    const int K = g.K, nt = K / BK, LD = g.ld;
    unsigned voffA[2], voffB[2];
#pragma unroll
    for (int i = 0; i < 2; ++i) { int R, C; stage_rc(tid * 16 + i * 8192, R, C); const int Rb = Epi::PERM ? ((R & ~31) + perm32(R & 31)) : R;
        voffA[i] = (unsigned)(R * LD + C) * 2u; voffB[i] = (unsigned)(Rb * LD + C) * 2u; }
    const size_t kstep = (size_t)(BK * 2);
    const size_t hstep = (size_t)HALF * LD * 2;
    const size_t tstep = 2 * hstep;
    const unsigned ldsbase = (unsigned)__builtin_amdgcn_readfirstlane((int)((unsigned)(unsigned long)lds + (unsigned)wid * 1024u));
    const unsigned ldsw = (unsigned)wid * 1024u;
    const int aoff = lds_byte(wr * 64 + fr, fq * 8), boff = lds_byte(wc * 32 + fr, fq * 8);
#define PG8_SA(b, h) (((b) * 2 + (h)) * HTB)
#define PG8_SB(b, h) ((4 + (b) * 2 + (h)) * HTB)
#define PG8_STAGE(bufoff, gbase, voff) do { _Pragma("unroll") for (int _i = 0; _i < 2; ++_i) \
        asm volatile("s_mov_b32 m0, %2\n\ts_nop 0\n\tglobal_load_lds_dwordx4 %0, %1" :: "v"((voff)[_i]), "s"((const char*)(gbase)), "s"(ldsbase + (unsigned)((bufoff) + _i * 8192)) : "memory", "m0"); } while (0)
#define PG8_LDA(dst, b, h) do { _Pragma("unroll") for (int m = 0; m < 4; ++m) _Pragma("unroll") for (int k = 0; k < 2; ++k) dst[m][k] = *(const PG8_LAS bf16x8*)(lds + PG8_SA(b, h) + aoff + m * 2048 + k * 1024); } while (0)
#define PG8_LDB(dst, b, h) do { _Pragma("unroll") for (int n = 0; n < 2; ++n) _Pragma("unroll") for (int k = 0; k < 2; ++k) dst[n][k] = *(const PG8_LAS bf16x8*)(lds + PG8_SB(b, h) + boff + n * 2048 + k * 1024); } while (0)
#define PG8_MMA(ai, bj, At, Bt) do { __builtin_amdgcn_s_setprio(1); _Pragma("unroll") for (int m = 0; m < 4; ++m) _Pragma("unroll") for (int n = 0; n < 2; ++n) _Pragma("unroll") for (int k = 0; k < 2; ++k) \
        acc[ai][bj][m][n] = __builtin_amdgcn_mfma_f32_16x16x32_bf16(Bt[n][k], At[m][k], acc[ai][bj][m][n], 0, 0, 0); __builtin_amdgcn_s_setprio(0); } while (0)
#define PG8_WAIT_V(n) asm volatile("s_waitcnt vmcnt(" #n ")" ::: "memory")
#define PG8_WAIT_L(n) do { __builtin_amdgcn_s_waitcnt(0xC07F | ((n) << 8)); asm volatile("" ::: "memory"); } while (0)
#define PG8_WAIT_VL8 do { __builtin_amdgcn_s_waitcnt(0x0078); asm volatile("" ::: "memory"); } while (0)
#define PG8_BAR __builtin_amdgcn_s_barrier()
#define PG8_SCHED __builtin_amdgcn_sched_barrier(0)
    Unit cur, nxt; int ui = 0;
    if (!S.next(0, cur)) return;
    f32x4 acc[2][2][4][2];
#pragma unroll
    for (int a = 0; a < 2; ++a)
#pragma unroll
        for (int b = 0; b < 2; ++b)
#pragma unroll
            for (int m = 0; m < 4; ++m)
#pragma unroll
                for (int n = 0; n < 2; ++n) acc[a][b][m][n] = (f32x4){0.f, 0.f, 0.f, 0.f};
    bf16x8 At[4][2], B0[2][2], B1[2][2];
    const char* cA = (const char*)g.A + (size_t)cur.z * g.zA + (size_t)cur.pm * tstep; const char* cB = (const char*)g.Bt + (size_t)cur.z * g.zB + (size_t)cur.pn * tstep;
    S.a_ready(cur);
    if constexpr (SP2) {
        PG8_STAGE(PG8_SB(0, 0), cB, voffB); PG8_STAGE(PG8_SB(0, 1), cB + hstep, voffB); PG8_STAGE(PG8_SA(0, 0), cA, voffA); PG8_STAGE(PG8_SA(0, 1), cA + hstep, voffA);
        if (wr == 1) PG8_BAR;
        PG8_WAIT_V(2); PG8_BAR;
        PG8_STAGE(PG8_SB(1, 0), cB + kstep, voffB); PG8_STAGE(PG8_SA(1, 0), cA + kstep, voffA); PG8_STAGE(PG8_SB(1, 1), cB + hstep + kstep, voffB);
        PG8_WAIT_V(6); PG8_BAR;
    } else {
        PG8_STAGE(PG8_SB(0, 0), cB, voffB); PG8_STAGE(PG8_SA(0, 0), cA, voffA); PG8_STAGE(PG8_SB(0, 1), cB + hstep, voffB); PG8_STAGE(PG8_SA(0, 1), cA + hstep, voffA);
        if (wr == 1) PG8_BAR;
        PG8_WAIT_V(4); PG8_BAR;
        PG8_STAGE(PG8_SB(1, 0), cB + kstep, voffB); PG8_STAGE(PG8_SA(1, 0), cA + kstep, voffA); PG8_STAGE(PG8_SB(1, 1), cB + hstep + kstep, voffB);
        PG8_WAIT_V(6); PG8_BAR;
    }
    for (;;) {
        const bool has_next = S.next(ui + 1, nxt);
        const char* nA = has_next ? (const char*)g.A + (size_t)nxt.z * g.zA + (size_t)nxt.pm * tstep : cA; const char* nB = has_next ? (const char*)g.Bt + (size_t)nxt.z * g.zB + (size_t)nxt.pn * tstep : cB;
        const int ntu = cur.kt ? cur.kt : nt;
        for (int t = 0; t < ntu; t += 2) {
            const bool last = (t == ntu - 2);
            const char* a1 = cA + (size_t)(t + 1) * kstep;
            const char* a2 = last ? nA : cA + (size_t)(t + 2) * kstep; const char* b2 = last ? nB : cB + (size_t)(t + 2) * kstep;
            const char* a3 = a2 + kstep; const char* b3 = b2 + kstep;
            if (last && has_next) S.a_ready(nxt);
            if constexpr (SP2) {
            PG8_LDB(B0, 0, 0); PG8_LDB(B1, 0, 1); PG8_SCHED; PG8_LDA(At, 0, 0); PG8_STAGE(PG8_SA(1, 1), a1 + hstep, voffA);
            PG8_WAIT_VL8; PG8_BAR; PG8_MMA(0, 0, At, B0); PG8_MMA(0, 1, At, B1); PG8_BAR; PG8_SCHED;
            PG8_LDA(At, 0, 1); PG8_STAGE(PG8_SB(0, 0), b2, voffB); PG8_STAGE(PG8_SB(0, 1), b2 + hstep, voffB); PG8_STAGE(PG8_SA(0, 0), a2, voffA);
            PG8_WAIT_VL8; PG8_BAR; PG8_MMA(1, 0, At, B0); PG8_MMA(1, 1, At, B1); PG8_BAR; PG8_SCHED;
            PG8_LDB(B0, 1, 0); PG8_LDB(B1, 1, 1); PG8_SCHED; PG8_LDA(At, 1, 0); PG8_STAGE(PG8_SA(0, 1), a2 + hstep, voffA);
            PG8_WAIT_VL8; PG8_BAR; PG8_MMA(0, 0, At, B0); PG8_MMA(0, 1, At, B1); PG8_BAR; PG8_SCHED;
            PG8_LDA(At, 1, 1); PG8_STAGE(PG8_SB(1, 0), b3, voffB); PG8_STAGE(PG8_SB(1, 1), b3 + hstep, voffB); PG8_STAGE(PG8_SA(1, 0), a3, voffA);
            PG8_WAIT_VL8; PG8_BAR; PG8_MMA(1, 0, At, B0); PG8_MMA(1, 1, At, B1); PG8_BAR; PG8_SCHED;
            } else {
            PG8_LDB(B0, 0, 0); PG8_SCHED; PG8_LDA(At, 0, 0); PG8_STAGE(PG8_SA(1, 1), a1 + hstep, voffA);
            PG8_WAIT_L(8); PG8_BAR; PG8_WAIT_L(0); PG8_MMA(0, 0, At, B0); PG8_BAR; PG8_SCHED;
            PG8_LDB(B1, 0, 1); PG8_STAGE(PG8_SB(0, 0), b2, voffB);
            PG8_BAR; PG8_WAIT_L(0); PG8_MMA(0, 1, At, B1); PG8_BAR;
            PG8_LDA(At, 0, 1); PG8_STAGE(PG8_SA(0, 0), a2, voffA);
            PG8_BAR; PG8_WAIT_L(0); PG8_MMA(1, 0, At, B0); PG8_BAR; PG8_SCHED;
            PG8_STAGE(PG8_SB(0, 1), b2 + hstep, voffB);
            PG8_WAIT_V(6); PG8_BAR; PG8_MMA(1, 1, At, B1); PG8_BAR;
            PG8_LDB(B0, 1, 0); PG8_SCHED; PG8_LDA(At, 1, 0); PG8_STAGE(PG8_SA(0, 1), a2 + hstep, voffA);
            PG8_WAIT_L(8); PG8_BAR; PG8_WAIT_L(0); PG8_MMA(0, 0, At, B0); PG8_BAR; PG8_SCHED;
            PG8_LDB(B1, 1, 1); PG8_STAGE(PG8_SB(1, 0), b3, voffB);
            PG8_BAR; PG8_WAIT_L(0); PG8_MMA(0, 1, At, B1); PG8_BAR;
            PG8_LDA(At, 1, 1); PG8_STAGE(PG8_SA(1, 0), a3, voffA);
            PG8_BAR; PG8_WAIT_L(0); PG8_MMA(1, 0, At, B0); PG8_BAR; PG8_SCHED;
            PG8_STAGE(PG8_SB(1, 1), b3 + hstep, voffB);
            PG8_WAIT_V(6); PG8_BAR; PG8_MMA(1, 1, At, B1); PG8_BAR;
            }
        }
        if constexpr (ALIGN_EPI) { if (wr == 0) PG8_BAR; }
        if constexpr (!Epi::AFTER_DRAIN) { E(acc, cur, wr, wc, fr, fq); S.done(cur); }
        if (!has_next) break;
        if (!Epi::KEEP_ACC || nxt.z == 0) {
#pragma unroll
        for (int a = 0; a < 2; ++a)
#pragma unroll
            for (int b = 0; b < 2; ++b)
#pragma unroll
                for (int m = 0; m < 4; ++m)
#pragma unroll
                    for (int n = 0; n < 2; ++n) acc[a][b][m][n] = (f32x4){0.f, 0.f, 0.f, 0.f};
        }
        cur = nxt; cA = nA; cB = nB; ++ui;
        if constexpr (ALIGN_EPI) { if (wr == 1) PG8_BAR; }
    }
    PG8_WAIT_V(0);
    if constexpr (!ALIGN_EPI) { if (wr == 0) PG8_BAR; }
    PG8_BAR;
    if constexpr (Epi::AFTER_DRAIN) { E.fused(acc, cur, wr, wc, fr, fq, lds, wid, lane); S.done(cur); }
#undef PG8_SA
#undef PG8_SB
#undef PG8_STAGE
#undef PG8_LDA
#undef PG8_LDB
#undef PG8_MMA
#undef PG8_WAIT_V
#undef PG8_WAIT_L
#undef PG8_BAR
#undef PG8_SCHED
}
}


constexpr int DM = 2048, NBATCH = 8, SEQ = 2048, CTXL = 256, SB = SEQ + CTXL  , R = NBATCH * SB  ;
constexpr int FFN = 5632, INC = 15360, NPAN = R / 256  ;
constexpr int C_AQ = 0, C_AK = 1024, C_AV = 2048, C_BQ = 3072, C_BK = 4096, C_BV = 5120, C_CQ = 6144, C_CK = 6656, C_CV = 7168, C_CG = 8192, C_GATE = 9216;
constexpr float EPS = 1e-6f, LOG2E = 1.4426950408889634f;
constexpr float SCALE_A = 0.125f * LOG2E, SCALE_B = 0.08838834764831845f * LOG2E, SCALE_CK = 0.125f;

#define GAS __attribute__((address_space(1)))
#define LAS __attribute__((address_space(3)))
typedef unsigned short bf16;
typedef unsigned v4u __attribute__((ext_vector_type(4)));
typedef unsigned v2u __attribute__((ext_vector_type(2)));
typedef float f32x4 __attribute__((ext_vector_type(4)));
typedef float f32x2 __attribute__((ext_vector_type(2)));
#define LDS_WAIT() asm volatile("s_waitcnt lgkmcnt(0)" ::: "memory")
#define VM_WAIT() asm volatile("s_waitcnt vmcnt(0)" ::: "memory")
__device__ __forceinline__ unsigned cvt_pk_bf16(float lo, float hi) { unsigned r; asm volatile("v_cvt_pk_bf16_f32 %0, %1, %2" : "=v"(r) : "v"(lo), "v"(hi)); return r; }
__device__ __forceinline__ float bflo(unsigned w) { return __uint_as_float(w << 16); }
__device__ __forceinline__ float bfhi(unsigned w) { return __uint_as_float(w & 0xffff0000u); }
__device__ __forceinline__ float bf1(bf16 w) { return __uint_as_float(((unsigned)w) << 16); }
__device__ __forceinline__ float sigm_f(float x) { return __builtin_amdgcn_rcpf(1.0f + __builtin_amdgcn_exp2f(-LOG2E * x)); }
__device__ __forceinline__ float silu_f(float x) { return x * sigm_f(x); }
__device__ __forceinline__ f32x4 swiglu4(f32x4 a, f32x4 b) {
    f32x4 e;
    e[0] = __builtin_amdgcn_exp2f(a[0]); e[1] = __builtin_amdgcn_exp2f(a[1]); e[2] = __builtin_amdgcn_exp2f(a[2]); e[3] = __builtin_amdgcn_exp2f(a[3]);
    e = e + 1.0f; f32x4 r;
    r[0] = __builtin_amdgcn_rcpf(e[0]); r[1] = __builtin_amdgcn_rcpf(e[1]); r[2] = __builtin_amdgcn_rcpf(e[2]); r[3] = __builtin_amdgcn_rcpf(e[3]);
    return (a * b) * r;
}
template <int M> __device__ __forceinline__ float swz_xor(float v) { return __builtin_bit_cast(float, __builtin_amdgcn_ds_swizzle(__builtin_bit_cast(int, v), 0x1f | (M << 10))); }
__device__ __forceinline__ float wave_sum(float v) {
    v += swz_xor<1>(v); v += swz_xor<2>(v); v += swz_xor<4>(v); v += swz_xor<8>(v); v += swz_xor<16>(v);
    auto rr = __builtin_amdgcn_permlane32_swap(__float_as_uint(v), __float_as_uint(v), false, false); return __uint_as_float(rr[0]) + __uint_as_float(rr[1]);
}
__device__ __forceinline__ float wave_max(float v) {
    v = fmaxf(v, swz_xor<1>(v)); v = fmaxf(v, swz_xor<2>(v)); v = fmaxf(v, swz_xor<4>(v)); v = fmaxf(v, swz_xor<8>(v)); v = fmaxf(v, swz_xor<16>(v));
    auto rr = __builtin_amdgcn_permlane32_swap(__float_as_uint(v), __float_as_uint(v), false, false); return fmaxf(__uint_as_float(rr[0]), __uint_as_float(rr[1]));
}
__device__ __forceinline__ float other_half(float v, bool lower) { auto rr = __builtin_amdgcn_permlane32_swap(__float_as_uint(v), __float_as_uint(v), false, false); return __uint_as_float(lower ? rr[1] : rr[0]); }

namespace ep {
using pg8::Unit; using pg8::BM; using pg8::HALF;
struct EpiF32 {
    static constexpr bool PERM = false, AFTER_DRAIN = false, KEEP_ACC = false;
    float* C; int ldc;
    __device__ __forceinline__ void operator()(const f32x4 (&acc)[2][2][4][2], const Unit& u, int wr, int wc, int fr, int fq) const {
        const int row0 = u.pm * BM + wr * 64 + fr, col0 = u.pn * BM + wc * 32 + 4 * fq;
#pragma unroll
        for (int ai = 0; ai < 2; ++ai)
#pragma unroll
            for (int m = 0; m < 4; ++m) { float* rowp = C + (size_t)(row0 + ai * HALF + m * 16) * ldc + col0;
#pragma unroll
                for (int bj = 0; bj < 2; ++bj)
#pragma unroll
                    for (int n = 0; n < 2; ++n) *(f32x4*)(rowp + bj * HALF + n * 16) = acc[ai][bj][m][n]; }
    }
};
struct EpiSwiGLU {
    static constexpr bool PERM = true, AFTER_DRAIN = false, KEEP_ACC = false;
    bf16* O;
    __device__ __forceinline__ void operator()(const f32x4 (&acc)[2][2][4][2], const Unit& u, int wr, int wc, int fr, int fq) const {
        const int row0 = u.pm * BM + wr * 64 + fr, col0 = u.pn * 128 + wc * 32 + 8 * fq;
#pragma unroll
        for (int ai = 0; ai < 2; ++ai)
#pragma unroll
            for (int m = 0; m < 4; ++m) { bf16* rowp = O + (size_t)(row0 + ai * HALF + m * 16) * FFN + col0;
                const f32x4 a0 = acc[ai][0][m][0], a1 = acc[ai][0][m][1], b0 = acc[ai][1][m][0], b1 = acc[ai][1][m][1];
                const f32x4 r0 = swiglu4(a0, b0), r1 = swiglu4(a1, b1);
                v4u w; w.x = cvt_pk_bf16(r0[0], r0[1]); w.y = cvt_pk_bf16(r0[2], r0[3]); w.z = cvt_pk_bf16(r1[0], r1[1]); w.w = cvt_pk_bf16(r1[2], r1[3]);
                *(v4u*)rowp = w; }
    }
};
struct EpiInProj {
    static constexpr bool PERM = true, AFTER_DRAIN = false, KEEP_ACC = false;
    bf16* O; const LAS f32x2* tab;
    __device__ __forceinline__ void operator()(const f32x4 (&acc)[2][2][4][2], const Unit& u, int wr, int wc, int fr, int fq) const {
        const int pj = u.pm % 9;
        const bool rope = ((u.pn < 8) || (u.pn >= 24 && u.pn < 28)) && (pj != 0);
        const bool gate = u.pn >= C_GATE / 256;
        const int row0 = u.pm * BM + wr * 64 + fr, col0 = u.pn * BM + wc * 32 + 8 * fq;
        const int t0 = (pj - 1) * 256 + wr * 64 + fr;
#pragma unroll
        for (int ai = 0; ai < 2; ++ai)
#pragma unroll
            for (int m = 0; m < 4; ++m) { bf16* rowp = O + (size_t)(row0 + ai * HALF + m * 16) * INC + col0;
                f32x2 cs[8];
                if (rope) { const int t = t0 + ai * HALF + m * 16, pos = (wc & 1) ? (t & 63) : (t >> 6); const LAS f32x4* tp = (const LAS f32x4*)(tab + pos * 16 + 8 * (fq & 1));
#pragma unroll
                    for (int q = 0; q < 4; ++q) { const f32x4 v = tp[q]; cs[2 * q] = (f32x2){v[0], v[1]}; cs[2 * q + 1] = (f32x2){v[2], v[3]}; } }
#pragma unroll
                for (int bj = 0; bj < 2; ++bj) { float v[8];
#pragma unroll
                    for (int j = 0; j < 4; ++j) { v[j] = acc[ai][bj][m][0][j]; v[4 + j] = acc[ai][bj][m][1][j]; }
                    if (rope) {
#pragma unroll
                        for (int j = 0; j < 8; ++j) { const float p = other_half(v[j], fq < 2); v[j] = (fq < 2) ? (v[j] * cs[j].x - p * cs[j].y) : (p * cs[j].y + v[j] * cs[j].x); } }
                    if (gate) {
#pragma unroll
                        for (int j = 0; j < 8; ++j) v[j] = 1.0f + __builtin_amdgcn_exp2f(-LOG2E * fminf(fmaxf(v[j], -60.f), 60.f)); }
                    v4u w; w.x = cvt_pk_bf16(v[0], v[1]); w.y = cvt_pk_bf16(v[2], v[3]); w.z = cvt_pk_bf16(v[4], v[5]); w.w = cvt_pk_bf16(v[6], v[7]);
                    *(v4u*)(rowp + bj * HALF) = w; } }
    }
};
struct EpiBf16 {
    static constexpr bool PERM = true, AFTER_DRAIN = false, KEEP_ACC = false;
    bf16* O; int ldc;
    __device__ __forceinline__ void operator()(const f32x4 (&acc)[2][2][4][2], const Unit& u, int wr, int wc, int fr, int fq) const {
        const int row0 = u.pm * BM + wr * 64 + fr, col0 = u.pn * BM + wc * 32 + 8 * fq;
#pragma unroll
        for (int ai = 0; ai < 2; ++ai)
#pragma unroll
            for (int m = 0; m < 4; ++m) { bf16* rowp = O + (size_t)(row0 + ai * HALF + m * 16) * ldc + col0;
#pragma unroll
                for (int bj = 0; bj < 2; ++bj) { const f32x4 v0 = acc[ai][bj][m][0], v1 = acc[ai][bj][m][1];
                    v4u w; w.x = cvt_pk_bf16(v0[0], v0[1]); w.y = cvt_pk_bf16(v0[2], v0[3]); w.z = cvt_pk_bf16(v1[0], v1[1]); w.w = cvt_pk_bf16(v1[2], v1[3]);
                    *(v4u*)(rowp + bj * HALF) = w; } }
    }
};
struct EpiMerge {
    static constexpr bool PERM = true, AFTER_DRAIN = false, KEEP_ACC = true;
    const bf16* G; bf16* MERGED;
    static __device__ __forceinline__ float e1(float x) { return 1.0f + __builtin_amdgcn_exp2f(-LOG2E * fminf(fmaxf(x, -60.f), 60.f)); }
    __device__ __forceinline__ void operator()(f32x4 (&acc)[2][2][4][2], const Unit& u, int wr, int wc, int fr, int fq) const {
        const int row0 = u.pm * BM + wr * 64 + fr, col0 = u.pn * BM + wc * 32 + 8 * fq, z = u.z;
        const bf16* Ga = G + z * DM + col0; const bf16* Gb = Ga + DM; bf16* Oz = MERGED + col0;
        v4u ga[2][2], gb[2][2];
#define MRG_ROW(b) ((size_t)(row0 + ((b) >> 2) * HALF + ((b) & 3) * 16))
#define MRG_LOAD(b, s) do { _Pragma("unroll") for (int bj = 0; bj < 2; ++bj) { ga[s][bj] = *(const v4u*)(Ga + MRG_ROW(b) * INC + bj * HALF); \
            if (z != 2) gb[s][bj] = *(const v4u*)(Gb + MRG_ROW(b) * INC + bj * HALF); } } while (0)
        MRG_LOAD(0, 0);
#pragma unroll
        for (int b = 0; b < 8; ++b) { const int cur = b & 1, ai = b >> 2, m = b & 3;
            if (b + 1 < 8) MRG_LOAD(b + 1, cur ^ 1);
#pragma unroll
            for (int bj = 0; bj < 2; ++bj) { const v4u A = ga[cur][bj];
                float f[8] = {bflo(A.x), bfhi(A.x), bflo(A.y), bfhi(A.y), bflo(A.z), bfhi(A.z), bflo(A.w), bfhi(A.w)};
#pragma unroll
                for (int j = 0; j < 8; ++j) f[j] = __builtin_amdgcn_rcpf(f[j]);
                if (z != 2) { const v4u B = gb[cur][bj];
                    f[0] *= bflo(B.x); f[1] *= bfhi(B.x); f[2] *= bflo(B.y); f[3] *= bfhi(B.y); f[4] *= bflo(B.z); f[5] *= bfhi(B.z); f[6] *= bflo(B.w); f[7] *= bfhi(B.w); }
                f32x4 v0 = acc[ai][bj][m][0], v1 = acc[ai][bj][m][1];
                v0[0] *= f[0]; v0[1] *= f[1]; v0[2] *= f[2]; v0[3] *= f[3]; v1[0] *= f[4]; v1[1] *= f[5]; v1[2] *= f[6]; v1[3] *= f[7];
                if (z != 2) { acc[ai][bj][m][0] = v0; acc[ai][bj][m][1] = v1; }
                else { v4u w; w.x = cvt_pk_bf16(v0[0], v0[1]); w.y = cvt_pk_bf16(v0[2], v0[3]); w.z = cvt_pk_bf16(v1[0], v1[1]); w.w = cvt_pk_bf16(v1[2], v1[3]);
                    *(v4u*)(Oz + MRG_ROW(b) * DM + bj * HALF) = w; } } }
#undef MRG_ROW
#undef MRG_LOAD
    }
};
struct EpiF32Part {
    static constexpr bool PERM = false, AFTER_DRAIN = false, KEEP_ACC = false;
    float* YP;
    __device__ __forceinline__ void operator()(const f32x4 (&acc)[2][2][4][2], const Unit& u, int wr, int wc, int fr, int fq) const {
        const int row0 = (u.pm / 9) * BM + wr * 64 + fr, col0 = u.pn * BM + wc * 32 + 4 * fq;
        float* base = YP + (size_t)u.z * ((size_t)NBATCH * CTXL * DM);
#pragma unroll
        for (int ai = 0; ai < 2; ++ai)
#pragma unroll
            for (int m = 0; m < 4; ++m) { float* rowp = base + (size_t)(row0 + ai * HALF + m * 16) * DM + col0;
#pragma unroll
                for (int bj = 0; bj < 2; ++bj)
#pragma unroll
                    for (int n = 0; n < 2; ++n) *(f32x4*)(rowp + bj * HALF + n * 16) = acc[ai][bj][m][n]; }
    }
};
struct EpiNull {
    static constexpr bool PERM = true, AFTER_DRAIN = false, KEEP_ACC = false;
    bf16* O;
    __device__ __forceinline__ void operator()(const f32x4 (&acc)[2][2][4][2], const Unit& u, int wr, int wc, int fr, int fq) const {
        float s = 0.f;
#pragma unroll
        for (int ai = 0; ai < 2; ++ai)
#pragma unroll
            for (int bj = 0; bj < 2; ++bj)
#pragma unroll
                for (int m = 0; m < 4; ++m)
#pragma unroll
                    for (int n = 0; n < 2; ++n) s += acc[ai][bj][m][n][0] + acc[ai][bj][m][n][1] + acc[ai][bj][m][n][2] + acc[ai][bj][m][n][3];
        if (s == 1234.56789f) O[u.pm * 4096 + u.pn + wr + wc + fr + fq] = 1;
    }
};
struct EpiYMix {
    static constexpr bool PERM = true, AFTER_DRAIN = false, KEEP_ACC = false;
    bf16* O; bf16* YP;
    __device__ __forceinline__ void operator()(const f32x4 (&acc)[2][2][4][2], const Unit& u, int wr, int wc, int fr, int fq) const {
        const int col0 = u.pn * BM + wc * 32 + 8 * fq;
        if (u.kt == 0) { const int row0 = u.pm * BM + wr * 64 + fr;
#pragma unroll
            for (int ai = 0; ai < 2; ++ai)
#pragma unroll
                for (int m = 0; m < 4; ++m) { bf16* rowp = O + (size_t)(row0 + ai * HALF + m * 16) * DM + col0;
#pragma unroll
                    for (int bj = 0; bj < 2; ++bj) { const f32x4 v0 = acc[ai][bj][m][0], v1 = acc[ai][bj][m][1];
                        v4u w; w.x = cvt_pk_bf16(v0[0], v0[1]); w.y = cvt_pk_bf16(v0[2], v0[3]); w.z = cvt_pk_bf16(v1[0], v1[1]); w.w = cvt_pk_bf16(v1[2], v1[3]);
                        *(v4u*)(rowp + bj * HALF) = w; } } }
        else { const int row0 = (u.pm / 9) * BM + wr * 64 + fr; bf16* base = YP + (size_t)u.z * ((size_t)NBATCH * CTXL * DM);
#pragma unroll
            for (int ai = 0; ai < 2; ++ai)
#pragma unroll
                for (int m = 0; m < 4; ++m) { bf16* rowp = base + (size_t)(row0 + ai * HALF + m * 16) * DM + col0;
#pragma unroll
                    for (int bj = 0; bj < 2; ++bj) { const f32x4 v0 = acc[ai][bj][m][0], v1 = acc[ai][bj][m][1];
                        v4u w; w.x = cvt_pk_bf16(v0[0], v0[1]); w.y = cvt_pk_bf16(v0[2], v0[3]); w.z = cvt_pk_bf16(v1[0], v1[1]); w.w = cvt_pk_bf16(v1[2], v1[3]);
                        *(v4u*)(rowp + bj * HALF) = w; } } }
    }
};
}

constexpr size_t MiB = 1u << 20;
constexpr size_t WS_CTL = 0, CTL_ZERO_BYTES = 1 * MiB;
constexpr size_t WS_MOD = 1 * MiB;
constexpr size_t WS_TAB = 3 * MiB;
constexpr size_t WS_HC = 4 * MiB;
constexpr size_t WS_U = 20 * MiB;
constexpr size_t WS_OA = 92 * MiB, WS_OB = 128 * MiB, WS_YR = 164 * MiB;
constexpr size_t WS_MACC = 200 * MiB;
constexpr size_t WS_WT = 344 * MiB;
constexpr size_t WT_W1A = 0, WT_W1B = 44 * MiB, WT_W2A = 88 * MiB, WT_W2B = 110 * MiB, WT_IN = 132 * MiB, WT_WB = 192 * MiB, WT_WO = 204 * MiB, WT_BYTES = 212 * MiB;
constexpr size_t WS_R1 = 556 * MiB;
constexpr size_t R1_ACT = 0, R1_Y = 198 * MiB;
constexpr size_t WS_WT1 = 1096 * MiB;
constexpr size_t WS_END = 1308 * MiB;
static_assert((size_t)R * DM * 2 == 72 * MiB && (size_t)R * 1024 * 2 == 36 * MiB && (size_t)R * DM * 4 == 144 * MiB && (size_t)R * INC * 2 == 540 * MiB && (size_t)R * FFN * 2 == 198 * MiB, "sizes");
static_assert((size_t)2 * FFN * DM * 2 == 44 * MiB && (size_t)INC * DM * 2 == 60 * MiB && (size_t)3 * DM * 1024 * 2 == 12 * MiB, "weight sizes");
constexpr int CW_TMO = 0, CW_BAR = 4096;

constexpr int RING_BYTES = 135168;
constexpr int LDSCTL_OFF = RING_BYTES, MISC_OFF = LDSCTL_OFF + 320, LTAB_OFF = LDSCTL_OFF + 1024;
constexpr int LDS_BYTES = 147456;
static_assert(LTAB_OFF + 8192 <= LDS_BYTES && LDS_BYTES <= 163840, "LDS map");
constexpr int NWAVES = 8, GRID = 256;
#ifndef BSD
#define BSD 1
#endif

#define XB_TMO      128
#define XB_XCNT(j)  (256  + 64 * (j))
#define XB_XSUB(j)  (1280 + 64 * (j))
#define XB_XGEN(j)  (2304 + 64 * (j))
#define XB_TOP      3328
#define XB_TOPGEN   3392
#define XCD_BAR_WORDS 3456
#define XB_SPIN_CAP (1u << 21)

__device__ __forceinline__ unsigned xb_ld(unsigned* p)              { return __hip_atomic_load(p, __ATOMIC_RELAXED, __HIP_MEMORY_SCOPE_AGENT); }
__device__ __forceinline__ unsigned xb_add(unsigned* p, unsigned v) { return __hip_atomic_fetch_add(p, v, __ATOMIC_RELAXED, __HIP_MEMORY_SCOPE_AGENT); }
__device__ __forceinline__ unsigned xb_xcc_id() { return (unsigned)__builtin_amdgcn_s_getreg((3 << 11) | 20) & 0xFu; }
#define XB_SPIN(cond, bar) do { unsigned _sp = 0; while (cond) { __builtin_amdgcn_s_sleep(1); \
    if ((++_sp & 255u) == 0u) { if (xb_ld(&(bar)[XB_TMO])) break; if (_sp > XB_SPIN_CAP) { atomicAdd(&(bar)[XB_TMO], 1u); break; } } } } while (0)

struct XcdBarrier {
    unsigned* bar; unsigned x;
    volatile LAS unsigned* st;
};

__device__ __forceinline__ XcdBarrier xcd_barrier_post(unsigned* bar, volatile LAS unsigned* st) {
    XcdBarrier b; b.bar = bar; b.x = xb_xcc_id(); b.st = st;
    if (threadIdx.x == 0) (void)xb_add(&bar[XB_XCNT(b.x)], 1u);
    return b;
}
__device__ __forceinline__ void xcd_barrier_complete(unsigned* bar, unsigned x, unsigned& nloc, unsigned& nx) {
    const unsigned G = gridDim.x * gridDim.y * gridDim.z;
    unsigned sum, cnt, mine, sp = 0u;
    for (;;) {
        sum = 0u; cnt = 0u; mine = 0u;
#pragma unroll
        for (unsigned j = 0; j < 16; ++j) { const unsigned c = xb_ld(&bar[XB_XCNT(j)]); sum += c; cnt += (c > 0u) ? 1u : 0u; mine = (j == x) ? c : mine; }
        if (sum == G) break;
        __builtin_amdgcn_s_sleep(1);
        if ((++sp & 255u) == 0u) { if (xb_ld(&bar[XB_TMO])) break; if (sp > XB_SPIN_CAP) { atomicAdd(&bar[XB_TMO], 1u); break; } }
    }
    nloc = mine > 0u ? mine : 1u; nx = cnt > 0u ? cnt : 1u;
}

__device__ __forceinline__ void xcd_barrier(const XcdBarrier& b) {
    asm volatile("s_waitcnt vmcnt(0)" ::: "memory");
    __syncthreads();
    if (threadIdx.x == 0) {
        unsigned* bar = b.bar;
        __builtin_amdgcn_s_waitcnt(0);
        unsigned nloc = b.st[0], nx = b.st[1];
        if (nloc == 0u) { xcd_barrier_complete(bar, b.x, nloc, nx); b.st[0] = nloc; b.st[1] = nx; }
        const unsigned old = xb_add(&bar[XB_XSUB(b.x)], 1u);
        const unsigned gen = old / nloc;
        if (old + 1u == (gen + 1u) * nloc) {
            __builtin_amdgcn_fence(__ATOMIC_RELEASE, "agent");
            asm volatile("s_waitcnt vmcnt(0)" ::: "memory");
            const unsigned og = xb_add(&bar[XB_TOP], 1u);
            const unsigned tg = og / nx;
            if (og + 1u == (tg + 1u) * nx) xb_add(&bar[XB_TOPGEN], 1u);
            else XB_SPIN(xb_ld(&bar[XB_TOPGEN]) == tg, bar);
            __builtin_amdgcn_fence(__ATOMIC_ACQUIRE, "agent");
            xb_add(&bar[XB_XGEN(b.x)], 1u);
            asm volatile("s_waitcnt vmcnt(0)" ::: "memory");
        } else {
            XB_SPIN(xb_ld(&bar[XB_XGEN(b.x)]) == gen, bar);
            __builtin_amdgcn_fence(__ATOMIC_ACQUIRE, "agent");
            asm volatile("s_waitcnt vmcnt(0)" ::: "memory");
        }
    }
    __syncthreads();
}


__device__ __forceinline__ unsigned f2bf(float f) { unsigned u = __builtin_bit_cast(unsigned, f); return (u + 0x7fffu + ((u >> 16) & 1u)) >> 16; }
__device__ __forceinline__ unsigned pk2(float lo, float hi) { return f2bf(lo) | (f2bf(hi) << 16); }
__device__ __forceinline__ void transpose_item(const float* W, int K, int N, bf16* WT, int k0, int n0, int orow0, float scale, LAS float* scr, int lane) {
    { float v[32];
      const float* src = W + (size_t)(k0 + (lane >> 5)) * N + n0 + (lane & 31);
#pragma unroll
      for (int i = 0; i < 32; ++i) v[i] = __builtin_nontemporal_load(src + (size_t)(2 * i) * N);
#pragma unroll
      for (int i = 0; i < 32; ++i) scr[(2 * i + (lane >> 5)) * 33 + (lane & 31)] = v[i]; }
    LDS_WAIT(); asm volatile("" ::: "memory");
    const int c = lane & 7;
#pragma unroll
    for (int j = 0; j < 4; ++j) { const int n = (lane >> 3) + 8 * j; const LAS float* s = scr + (8 * c) * 33 + n;
        v4u o; o.x = pk2(s[0 * 33] * scale, s[1 * 33] * scale); o.y = pk2(s[2 * 33] * scale, s[3 * 33] * scale); o.z = pk2(s[4 * 33] * scale, s[5 * 33] * scale); o.w = pk2(s[6 * 33] * scale, s[7 * 33] * scale);
        *(GAS v4u*)(WT + (size_t)(orow0 + n) * K + k0 + 8 * c) = o; }
    LDS_WAIT(); asm volatile("" ::: "memory");
}

struct Args { const float* in[18]; float* out; unsigned char* ws; };

template <int N> __device__ __forceinline__ void load_q(float (&q)[N], const bf16* p) {
#pragma unroll
    for (int c = 0; c < N / 8; ++c) { const v4u w = *(const v4u*)(p + 8 * c);
        q[8 * c + 0] = bflo(w.x); q[8 * c + 1] = bfhi(w.x); q[8 * c + 2] = bflo(w.y); q[8 * c + 3] = bfhi(w.y); q[8 * c + 4] = bflo(w.z); q[8 * c + 5] = bfhi(w.z); q[8 * c + 6] = bflo(w.w); q[8 * c + 7] = bfhi(w.w); }
}
template <int N> __device__ __forceinline__ float dot_q(const float (&q)[N], const bf16* k) {
    float s0 = 0.f, s1 = 0.f;
#pragma unroll
    for (int c = 0; c < N / 8; ++c) { const v4u w = *(const v4u*)(k + 8 * c);
        s0 += q[8 * c + 0] * bflo(w.x); s1 += q[8 * c + 1] * bfhi(w.x); s0 += q[8 * c + 2] * bflo(w.y); s1 += q[8 * c + 3] * bfhi(w.y);
        s0 += q[8 * c + 4] * bflo(w.z); s1 += q[8 * c + 5] * bfhi(w.z); s0 += q[8 * c + 6] * bflo(w.w); s1 += q[8 * c + 7] * bfhi(w.w); }
    return s0 + s1;
}
__device__ __forceinline__ float softmax_buf(LAS float* buf, int nk, float mx, int lane) {
    mx = wave_max(mx); float sum = 0.f;
    for (int j = lane; j < nk; j += 64) { const float e = __builtin_amdgcn_exp2f(buf[j] - mx); buf[j] = e; sum += e; }
    sum = wave_sum(sum); LDS_WAIT();
    return 1.0f / sum;
}

namespace att {
using bf16x8 = __attribute__((ext_vector_type(8))) short;
using s16x4  = __attribute__((ext_vector_type(4))) short;
using f32x16 = __attribute__((ext_vector_type(16))) float;
constexpr int LDP = INC;
constexpr int L_V = 0, L_K = 32768, L_WS = 65536, L_RPB = 67584, L_STASH = 69632, L_OEPI = 16896;
static_assert(L_STASH + 8 * 8192 <= RING_BYTES && 8 * L_OEPI <= RING_BYTES, "attention LDS map");
constexpr float THR2 = 11.541560327111707f;
#define SBAR() __builtin_amdgcn_sched_barrier(0)
#ifndef A_RING3
#define A_RING3 1
#endif
#ifndef B_RING3
#define B_RING3 1
#endif
__device__ __forceinline__ int crow(int r, int hi) { return (r & 3) + 8 * (r >> 2) + 4 * hi; }
template <int DK> __device__ __forceinline__ int kswz(int row, int colB) { return row * (2 * DK) + (colB ^ ((DK == 64 ? ((row >> 1) & 7) : (row & 15)) << 4)); }
__device__ __forceinline__ int v_st(int k, int c) { const int kk = (k & ~0xC) | ((k & 4) << 1) | ((k & 8) >> 1); return ((kk >> 3) * 4 + (c >> 5)) * 512 + ((kk & 7) * 32 + (c & 31)) * 2; }
__device__ __forceinline__ int v_rd_base(int lane) { return ((lane & 3) << 3) | (((lane >> 2) & 3) << 6) | (((lane >> 4) & 1) << 5) | (((lane >> 5) & 1) << 8); }
constexpr int v_rd_off(int d0, int ks, int half) { return d0 * 512 + ks * 4096 + half * 2048; }
template <int OFF> __device__ __forceinline__ s16x4 tr_read(int vb) { s16x4 r; asm volatile("ds_read_b64_tr_b16 %0, %1 offset:%2" : "=&v"(r) : "v"(vb), "i"(OFF) : "memory"); return r; }
template <int D0> __device__ __forceinline__ void pv_one(f32x16& od, int vb, bf16x8 pa0, bf16x8 pa1, bf16x8 pa2, bf16x8 pa3) {
    const s16x4 l0 = tr_read<v_rd_off(D0, 0, 0)>(vb), h0 = tr_read<v_rd_off(D0, 0, 1)>(vb), l1 = tr_read<v_rd_off(D0, 1, 0)>(vb), h1 = tr_read<v_rd_off(D0, 1, 1)>(vb);
    const s16x4 l2 = tr_read<v_rd_off(D0, 2, 0)>(vb), h2 = tr_read<v_rd_off(D0, 2, 1)>(vb), l3 = tr_read<v_rd_off(D0, 3, 0)>(vb), h3 = tr_read<v_rd_off(D0, 3, 1)>(vb);
    asm volatile("s_waitcnt lgkmcnt(0)" ::: "memory"); SBAR();
#define PK(L, H) (bf16x8){L[0], L[1], L[2], L[3], H[0], H[1], H[2], H[3]}
    od = __builtin_amdgcn_mfma_f32_32x32x16_bf16(pa0, PK(l0, h0), od, 0, 0, 0);
    od = __builtin_amdgcn_mfma_f32_32x32x16_bf16(pa1, PK(l1, h1), od, 0, 0, 0);
    od = __builtin_amdgcn_mfma_f32_32x32x16_bf16(pa2, PK(l2, h2), od, 0, 0, 0);
    od = __builtin_amdgcn_mfma_f32_32x32x16_bf16(pa3, PK(l3, h3), od, 0, 0, 0);
#undef PK
}
#ifndef PV_PIPE
#define PV_PIPE 1
#endif
template <int D0> __device__ __forceinline__ void pv_reads(int vb, s16x4 (&f)[8]) {
    f[0] = tr_read<v_rd_off(D0, 0, 0)>(vb); f[1] = tr_read<v_rd_off(D0, 0, 1)>(vb); f[2] = tr_read<v_rd_off(D0, 1, 0)>(vb); f[3] = tr_read<v_rd_off(D0, 1, 1)>(vb);
    f[4] = tr_read<v_rd_off(D0, 2, 0)>(vb); f[5] = tr_read<v_rd_off(D0, 2, 1)>(vb); f[6] = tr_read<v_rd_off(D0, 3, 0)>(vb); f[7] = tr_read<v_rd_off(D0, 3, 1)>(vb);
}
__device__ __forceinline__ void pv_mma(f32x16& od, const s16x4 (&f)[8], bf16x8 pa0, bf16x8 pa1, bf16x8 pa2, bf16x8 pa3) {
#define PK(L, H) (bf16x8){L[0], L[1], L[2], L[3], H[0], H[1], H[2], H[3]}
    od = __builtin_amdgcn_mfma_f32_32x32x16_bf16(pa0, PK(f[0], f[1]), od, 0, 0, 0);
    od = __builtin_amdgcn_mfma_f32_32x32x16_bf16(pa1, PK(f[2], f[3]), od, 0, 0, 0);
    od = __builtin_amdgcn_mfma_f32_32x32x16_bf16(pa2, PK(f[4], f[5]), od, 0, 0, 0);
    od = __builtin_amdgcn_mfma_f32_32x32x16_bf16(pa3, PK(f[6], f[7]), od, 0, 0, 0);
#undef PK
}
__device__ __forceinline__ void pv_d0(f32x16* o, int vb, bf16x8 pa0, bf16x8 pa1, bf16x8 pa2, bf16x8 pa3) {
#if PV_PIPE
    s16x4 fa[8], fb[8];
    pv_reads<0>(vb, fa); pv_reads<1>(vb, fb);
    asm volatile("s_waitcnt lgkmcnt(8)" ::: "memory"); SBAR(); pv_mma(o[0], fa, pa0, pa1, pa2, pa3); SBAR();
    pv_reads<2>(vb, fa);
    asm volatile("s_waitcnt lgkmcnt(8)" ::: "memory"); SBAR(); pv_mma(o[1], fb, pa0, pa1, pa2, pa3); SBAR();
    pv_reads<3>(vb, fb);
    asm volatile("s_waitcnt lgkmcnt(8)" ::: "memory"); SBAR(); pv_mma(o[2], fa, pa0, pa1, pa2, pa3); SBAR();
    asm volatile("s_waitcnt lgkmcnt(0)" ::: "memory"); SBAR(); pv_mma(o[3], fb, pa0, pa1, pa2, pa3);
#else
    pv_one<0>(o[0], vb, pa0, pa1, pa2, pa3); pv_one<1>(o[1], vb, pa0, pa1, pa2, pa3); pv_one<2>(o[2], vb, pa0, pa1, pa2, pa3); pv_one<3>(o[3], vb, pa0, pa1, pa2, pa3);
#endif
}
#define MF1(OD, PA, L, H) OD = __builtin_amdgcn_mfma_f32_32x32x16_bf16(PA, (bf16x8){L[0], L[1], L[2], L[3], H[0], H[1], H[2], H[3]}, OD, 0, 0, 0)
__device__ __forceinline__ void pv_sm(f32x16* o, int vb, bf16x8 pa0, bf16x8 pa1, bf16x8 pa2, bf16x8 pa3, f32x16& p0, f32x16& p1, float& m_reg, float& mn, float& alpha) {
    s16x4 fa[8], fb[8];
    pv_reads<0>(vb, fa); pv_reads<1>(vb, fb);
    asm volatile("s_waitcnt lgkmcnt(8)" ::: "memory"); SBAR();
    float pmax = p0[0];
    MF1(o[0], pa0, fa[0], fa[1]); SBAR();
#pragma unroll
    for (int r = 1; r < 8; ++r) pmax = fmaxf(pmax, p0[r]);
    SBAR(); MF1(o[0], pa1, fa[2], fa[3]); SBAR();
#pragma unroll
    for (int r = 8; r < 16; ++r) pmax = fmaxf(pmax, p0[r]);
    SBAR(); MF1(o[0], pa2, fa[4], fa[5]); SBAR();
#pragma unroll
    for (int r = 0; r < 8; ++r) pmax = fmaxf(pmax, p1[r]);
    SBAR(); MF1(o[0], pa3, fa[6], fa[7]); SBAR();
#pragma unroll
    for (int r = 8; r < 16; ++r) pmax = fmaxf(pmax, p1[r]);
    SBAR();
    pv_reads<2>(vb, fa);
    { auto rr = __builtin_amdgcn_permlane32_swap(__float_as_uint(pmax), __float_as_uint(pmax), false, false); pmax = fmaxf(__uint_as_float(rr[0]), __uint_as_float(rr[1])); }
    if (__builtin_expect(__all(pmax - m_reg <= THR2), 1)) { mn = m_reg; alpha = 1.f; }
    else { mn = fmaxf(m_reg, pmax); alpha = __builtin_amdgcn_exp2f(m_reg - mn); m_reg = mn; }
    asm volatile("s_waitcnt lgkmcnt(8)" ::: "memory"); SBAR();
#define EX2(R) do { float t_ = __builtin_amdgcn_exp2f(p0[R] - mn); asm volatile("" : "+v"(t_)); p0[R] = t_; } while (0)
#define SB2(R) do { float t_ = p1[R] - mn; asm volatile("" : "+v"(t_)); p1[R] = t_; } while (0)
    MF1(o[1], pa0, fb[0], fb[1]); SBAR(); EX2(0); EX2(1); SBAR();
    MF1(o[1], pa1, fb[2], fb[3]); SBAR(); EX2(2); EX2(3); SBAR();
    MF1(o[1], pa2, fb[4], fb[5]); SBAR(); EX2(4); EX2(5); SBAR();
    MF1(o[1], pa3, fb[6], fb[7]); SBAR(); EX2(6); EX2(7); SBAR();
    pv_reads<3>(vb, fb);
    asm volatile("s_waitcnt lgkmcnt(8)" ::: "memory"); SBAR();
    MF1(o[2], pa0, fa[0], fa[1]); SBAR(); EX2(8); SB2(0); SB2(1); SBAR();
    MF1(o[2], pa1, fa[2], fa[3]); SBAR(); EX2(9); SB2(2); SB2(3); SBAR();
    MF1(o[2], pa2, fa[4], fa[5]); SBAR(); EX2(10); SB2(4); SB2(5); SBAR();
    MF1(o[2], pa3, fa[6], fa[7]); SBAR(); EX2(11); SB2(6); SB2(7); SBAR();
    asm volatile("s_waitcnt lgkmcnt(0)" ::: "memory"); SBAR();
    MF1(o[3], pa0, fb[0], fb[1]); SBAR(); EX2(12); SB2(8); SB2(9); SBAR();
    MF1(o[3], pa1, fb[2], fb[3]); SBAR(); EX2(13); SB2(10); SB2(11); SBAR();
    MF1(o[3], pa2, fb[4], fb[5]); SBAR(); EX2(14); SB2(12); SB2(13); SBAR();
    MF1(o[3], pa3, fb[6], fb[7]); SBAR(); EX2(15); SB2(14); SB2(15); SBAR();
#undef EX2
#undef SB2
}
#undef MF1
template <int DK> __device__ __forceinline__ void qkt(f32x16& p0, f32x16& p1, const LAS unsigned char* Ks, const bf16x8* qr, int r32, int hi) {
    p0 = f32x16{}; p1 = f32x16{};
#pragma unroll
    for (int d0 = 0; d0 < DK / 16; ++d0) { const int cb = (d0 * 16 + hi * 8) * 2;
        const bf16x8 b0 = *(const LAS bf16x8*)(Ks + kswz<DK>(r32, cb)), b1 = *(const LAS bf16x8*)(Ks + kswz<DK>(32 + r32, cb));
        p0 = __builtin_amdgcn_mfma_f32_32x32x16_bf16(b0, qr[d0], p0, 0, 0, 0);
        p1 = __builtin_amdgcn_mfma_f32_32x32x16_bf16(b1, qr[d0], p1, 0, 0, 0); }
}
__device__ __forceinline__ void pack_p(const f32x16& p0, const f32x16& p1, bf16x8& pa0, bf16x8& pa1, bf16x8& pa2, bf16x8& pa3) {
#define PK4(P, BASE, OUT) do { unsigned a0 = cvt_pk_bf16(P[BASE + 0], P[BASE + 1]), a1 = cvt_pk_bf16(P[BASE + 2], P[BASE + 3]);   \
    unsigned b0 = cvt_pk_bf16(P[BASE + 4], P[BASE + 5]), b1 = cvt_pk_bf16(P[BASE + 6], P[BASE + 7]);                              \
    auto r0 = __builtin_amdgcn_permlane32_swap(a0, b0, false, false); auto r1 = __builtin_amdgcn_permlane32_swap(a1, b1, false, false); \
    v4u w = {r0[0], r1[0], r0[1], r1[1]}; OUT = *reinterpret_cast<bf16x8*>(&w); } while (0)
    PK4(p0, 0, pa0); PK4(p0, 8, pa1); PK4(p1, 0, pa2); PK4(p1, 8, pa3);
#undef PK4
}
__device__ __forceinline__ void sm_part(f32x16& p0, f32x16& p1, float& m_reg, float& mn, float& alpha) {
    float pmax = p0[0];
#pragma unroll
    for (int r = 1; r < 16; ++r) pmax = fmaxf(pmax, p0[r]);
#pragma unroll
    for (int r = 0; r < 16; ++r) pmax = fmaxf(pmax, p1[r]);
    { auto rr = __builtin_amdgcn_permlane32_swap(__float_as_uint(pmax), __float_as_uint(pmax), false, false); pmax = fmaxf(__uint_as_float(rr[0]), __uint_as_float(rr[1])); }
    if (__builtin_expect(__all(pmax - m_reg <= THR2), 1)) { mn = m_reg; alpha = 1.f; }
    else { mn = fmaxf(m_reg, pmax); alpha = __builtin_amdgcn_exp2f(m_reg - mn); m_reg = mn; }
#pragma unroll
    for (int r = 0; r < 16; ++r) { p0[r] = __builtin_amdgcn_exp2f(p0[r] - mn); p1[r] = p1[r] - mn; }
}
__device__ __forceinline__ void sm_fin(f32x16& p0, f32x16& p1, float alpha, float& l_reg, bf16x8& pa0, bf16x8& pa1, bf16x8& pa2, bf16x8& pa3) {
#pragma unroll
    for (int r = 0; r < 16; ++r) p1[r] = __builtin_amdgcn_exp2f(p1[r]);
    float ps = 0.f;
#pragma unroll
    for (int r = 0; r < 16; ++r) ps += p0[r];
#pragma unroll
    for (int r = 0; r < 16; ++r) ps += p1[r];
    { auto rr = __builtin_amdgcn_permlane32_swap(__float_as_uint(ps), __float_as_uint(ps), false, false); ps = __uint_as_float(rr[0]) + __uint_as_float(rr[1]); }
    l_reg = l_reg * alpha + ps;
    pack_p(p0, p1, pa0, pa1, pa2, pa3);
}
__device__ __forceinline__ void b_mask(f32x16& p0, f32x16& p1, int j, const LAS float* tab, int kr0, int nkr, int qrow, int rs, int qc, int cst, int hi) {
    const int jj = j - 4, kr = kr0 + (jj < nkr ? jj : nkr - 1);
    const bool rowok = (jj < nkr) && (kr >= rs) && (kr < rs + 8);
    const float NEG = -INFINITY;
    if (!rowok) {
#pragma unroll
        for (int r = 0; r < 16; ++r) { p0[r] = NEG; p1[r] = NEG; }
        return; }
    const int base = (kr - qrow + 7) * 31 + 15 - qc + 4 * hi, cb = 4 * hi - cst;
#pragma unroll
    for (int q = 0; q < 4; ++q) {
        float b0[4], b1[4];
#pragma unroll
        for (int e = 0; e < 4; ++e) { b0[e] = tab[base + 8 * q + e]; b1[e] = tab[base + 8 * q + e + 32]; }
        asm volatile("" : "+v"(b0[0]), "+v"(b0[1]), "+v"(b0[2]), "+v"(b0[3]), "+v"(b1[0]), "+v"(b1[1]), "+v"(b1[2]), "+v"(b1[3]));
#pragma unroll
        for (int e = 0; e < 4; ++e) { const int r = 4 * q + e, cr = 8 * q + e;
            p0[r] = ((unsigned)(cr + cb) < 16u) ? p0[r] + b0[e] : NEG;
            p1[r] = ((unsigned)(cr + 32 + cb) < 16u) ? p1[r] + b1[e] : NEG; }
    }
}
__device__ __forceinline__ void c_weight(f32x16& p, int half, int kind, float base, float lf, float lb, const LAS float* tab) {
    if (kind == 3) {
#pragma unroll
        for (int r = 0; r < 16; ++r) { const float df = base - (float)((r & 3) + 8 * (r >> 2) + 32 * half), db = -df;
            const float w = (df >= 0.f ? __builtin_amdgcn_exp2f(lf * df) : 0.f) + (db >= 0.f ? __builtin_amdgcn_exp2f(lb * db) : 0.f); p[r] *= w; }
        return; }
    if (kind == 1) { const float af = __builtin_amdgcn_exp2f(lf * base);
#pragma unroll
        for (int q = 0; q < 4; ++q) { const f32x4 t = *(const LAS f32x4*)(tab + half * 16 + 4 * q);
#pragma unroll
            for (int e = 0; e < 4; ++e) p[4 * q + e] *= af * t[e]; } }
    else if (kind == 2) { const float ab = __builtin_amdgcn_exp2f(-lb * base);
#pragma unroll
        for (int q = 0; q < 4; ++q) { const f32x4 t = *(const LAS f32x4*)(tab + 32 + half * 16 + 4 * q);
#pragma unroll
            for (int e = 0; e < 4; ++e) p[4 * q + e] *= ab * t[e]; } }
    else { const float af = __builtin_amdgcn_exp2f(lf * base), ab = __builtin_amdgcn_exp2f(lb * ((float)SB - base));
#pragma unroll
        for (int q = 0; q < 4; ++q) { const f32x4 t = *(const LAS f32x4*)(tab + half * 16 + 4 * q), u = *(const LAS f32x4*)(tab + 32 + half * 16 + 4 * q);
#pragma unroll
            for (int e = 0; e < 4; ++e) p[4 * q + e] *= af * t[e] + ab * u[e]; } }
}

struct UnitD { const bf16* Q; const bf16* K; const bf16* V; int row_base, off, cap, NT; };
struct ModeP { int plain, kr0, nkr, qr0; const float* rpb; float lf, lb; int sq0, latq; };

template <int DK, int MODE, int SDEPTH>
__device__ __forceinline__ void attn_core(LAS unsigned char* lds, const UnitD& ud, const ModeP& mp, f32x16 (&o)[4], int tid) {
    const int wid = __builtin_amdgcn_readfirstlane(tid >> 6), lane = tid & 63, r32 = lane & 31, hi = lane >> 5;
    LAS unsigned char* Vl = lds + L_V; LAS unsigned char* Kl = lds + L_K;
    LAS float* wsf = (LAS float*)(lds + L_WS) + wid * 64; LAS float* li_l = wsf; LAS float* al_l = wsf + 32;
    const LAS float* rtab = (const LAS float*)(lds + L_RPB);
    float m_reg = -1e30f, l_reg = 0.f;
#pragma unroll
    for (int d = 0; d < 4; ++d) o[d] = f32x16{};
    bf16x8 qr[DK / 16];
    { const bf16* Qw = ud.Q + (size_t)(wid * 32 + r32) * LDP + hi * 8;
#pragma unroll
      for (int d0 = 0; d0 < DK / 16; ++d0) qr[d0] = *(const bf16x8*)(Qw + d0 * 16); }
    const int sr = tid >> 4, sc = (tid & 15) * 8, vst0 = v_st(sr, sc), vst1 = v_st(32 + sr, sc);
    const int kr64 = tid >> 3, kc64 = (tid & 7) * 8;
    const int vb0 = (int)(unsigned)(unsigned long)Vl + v_rd_base(lane);
    const int qc = 32 * (wid & 1) + r32, qrow = mp.qr0 + (wid >> 1), rs = min(max(qrow - 4, 0), 24), cst = min(max(qc - 8, 0), 48);
    const int s_lo = mp.sq0 + wid * 32, si = s_lo + r32;
    bf16x8 vs0[SDEPTH], vs1[SDEPTH], ks0[SDEPTH], ks1[SDEPTH];
#define TROW(j_) (ud.row_base + 64 * ((j_) < 4 ? (j_) : ud.off + min((j_) - 4, ud.cap)))
#define SLOAD(i, j_) do { const int tr_ = TROW(j_); \
        vs0[i] = *(const bf16x8*)(ud.V + (size_t)(tr_ + sr) * LDP + sc); vs1[i] = *(const bf16x8*)(ud.V + (size_t)(tr_ + 32 + sr) * LDP + sc); \
        if constexpr (DK == 128) { ks0[i] = *(const bf16x8*)(ud.K + (size_t)(tr_ + sr) * LDP + sc); ks1[i] = *(const bf16x8*)(ud.K + (size_t)(tr_ + 32 + sr) * LDP + sc); } \
        else { ks0[i] = *(const bf16x8*)(ud.K + (size_t)(tr_ + kr64) * LDP + kc64); } } while (0)
#define SWRITE(b, i) do { *(LAS bf16x8*)(Vl + (b) * 16384 + vst0) = vs0[i]; *(LAS bf16x8*)(Vl + (b) * 16384 + vst1) = vs1[i]; \
        if constexpr (DK == 128) { *(LAS bf16x8*)(Kl + (b) * 16384 + kswz<128>(sr, sc * 2)) = ks0[i]; *(LAS bf16x8*)(Kl + (b) * 16384 + kswz<128>(32 + sr, sc * 2)) = ks1[i]; } \
        else { *(LAS bf16x8*)(Kl + (b) * 16384 + kswz<64>(kr64, kc64 * 2)) = ks0[i]; } } while (0)
#define SWAIT() do { if constexpr (SDEPTH == 2) { if constexpr (DK == 128) asm volatile("s_waitcnt vmcnt(4)" ::: "memory"); else asm volatile("s_waitcnt vmcnt(3)" ::: "memory"); } \
        else asm volatile("s_waitcnt vmcnt(0)" ::: "memory"); } while (0)
#define RESC(a) do { if constexpr (MODE != 2) { if (__any((a) < 1.f)) { if (hi == 0) al_l[r32] = (a); asm volatile("s_waitcnt lgkmcnt(0)" ::: "memory"); \
        _Pragma("unroll") for (int d = 0; d < 4; ++d) _Pragma("unroll") for (int r = 0; r < 16; ++r) o[d][r] *= al_l[crow(r, hi)]; } } } while (0)
#define PART1(P0, P1, j_, MN, AL) do { \
        if constexpr (MODE == 2) { const int ck_ = (mp.latq && (j_) < 4) ? 0 : (64 * (j_) + 63 < s_lo) ? 1 : (64 * (j_) > s_lo + 31) ? 2 : 3; c_weight(P0, 0, ck_, (float)(si - 64 * (j_) - 4 * hi), mp.lf, mp.lb, rtab); AL = 1.f; MN = 0.f; } \
        else { if constexpr (MODE == 1) { if (!mp.plain && (j_) >= 4) b_mask(P0, P1, (j_), rtab, mp.kr0, mp.nkr, qrow, rs, qc, cst, hi); } sm_part(P0, P1, m_reg, MN, AL); } } while (0)
#define PART2(P0, P1, j_, AL) do { \
        if constexpr (MODE == 2) { const int ck_ = (mp.latq && (j_) < 4) ? 0 : (64 * (j_) + 63 < s_lo) ? 1 : (64 * (j_) > s_lo + 31) ? 2 : 3; c_weight(P1, 1, ck_, (float)(si - 64 * (j_) - 4 * hi), mp.lf, mp.lb, rtab); pack_p(P0, P1, pa0, pa1, pa2, pa3); } \
        else sm_fin(P0, P1, AL, l_reg, pa0, pa1, pa2, pa3); } while (0)
#define PVSM(VB, P0, P1, j_, MN, AL) do { \
        if constexpr (MODE != 0) { pv_d0(o, (VB), pa0, pa1, pa2, pa3); PART1(P0, P1, (j_), MN, AL); } \
        else pv_sm(o, (VB), pa0, pa1, pa2, pa3, P0, P1, m_reg, MN, AL); } while (0)
    f32x16 pA0, pA1, pB0, pB1; float mnA, mnB, alA, alB; bf16x8 pa0, pa1, pa2, pa3; const int NT = ud.NT;
    constexpr int SE = 0, SO = SDEPTH - 1;
    __syncthreads();
    if constexpr (MODE == 1) { if (!mp.plain) { if (tid < 465) ((LAS float*)(lds + L_RPB))[tid] = mp.rpb[tid] * LOG2E; } }
    if constexpr (MODE == 2) { if (tid < 64) { const int t_ = tid & 31, cr_ = (t_ & 3) + 8 * ((t_ & 15) >> 2) + 32 * (t_ >> 4);
        ((LAS float*)(lds + L_RPB))[tid] = __builtin_amdgcn_exp2f((tid < 32 ? -mp.lf : mp.lb) * (float)cr_); } }
    SLOAD(SE, 0); asm volatile("s_waitcnt vmcnt(0)" ::: "memory"); SWRITE(0, SE); __syncthreads();
    qkt<DK>(pA0, pA1, Kl, qr, r32, hi); PART1(pA0, pA1, 0, mnA, alA);
    SLOAD(SO, 1); if constexpr (SDEPTH == 2) { if (2 < NT) SLOAD(SE, 2); }
    SWAIT(); SWRITE(1, SO); __syncthreads();
    for (int j = 1; j + 1 < NT; j += 2) {
        SBAR(); qkt<DK>(pB0, pB1, Kl + 16384, qr, r32, hi);
        PART2(pA0, pA1, j - 1, alA); SBAR();
        SLOAD(SO, j + SDEPTH); SBAR();
        PVSM(vb0, pB0, pB1, j, mnB, alB);
        __syncthreads(); SWAIT(); SWRITE(0, SE);
        RESC(alB); __syncthreads();
        SBAR(); qkt<DK>(pA0, pA1, Kl, qr, r32, hi);
        PART2(pB0, pB1, j, alB); SBAR();
        if (SDEPTH == 1 || j + 3 < NT) SLOAD(SE, j + 1 + SDEPTH); SBAR();
        PVSM(vb0 + 16384, pA0, pA1, j + 1, mnA, alA);
        __syncthreads(); SWAIT(); SWRITE(1, SO);
        RESC(alA); __syncthreads();
    }
    SBAR(); qkt<DK>(pB0, pB1, Kl + 16384, qr, r32, hi);
    PART2(pA0, pA1, NT - 2, alA); SBAR();
    PVSM(vb0, pB0, pB1, NT - 1, mnB, alB);
    __syncthreads(); RESC(alB);
    PART2(pB0, pB1, NT - 1, alB); SBAR();
    pv_d0(o, vb0 + 16384, pa0, pa1, pa2, pa3);
    if constexpr (MODE != 2) {
        if (hi == 0) li_l[r32] = l_reg; asm volatile("s_waitcnt lgkmcnt(0)" ::: "memory");
#pragma unroll
        for (int r = 0; r < 16; ++r) { const float rl = __builtin_amdgcn_rcpf(li_l[crow(r, hi)]);
#pragma unroll
            for (int d = 0; d < 4; ++d) o[d][r] *= rl; }
    }
    (void)mnA; (void)mnB;
#undef TROW
#undef SLOAD
#undef SWRITE
#undef SWAIT
#undef RESC
#undef PART1
#undef PVSM
#undef PART2
}

constexpr int A3_K = 0, A3_V = 24576, A3_WS = 73728, L_STASH3 = 75776;
static_assert(L_STASH3 + 7 * 8192 <= RING_BYTES, "attention LDS map (ring-3): stash slots 0..6 inside the ring, slot 7 overlays LTAB");
typedef LAS const char* lds_cptr;
typedef short v4i16_t __attribute__((ext_vector_type(4)));
typedef unsigned u32x4_t __attribute__((ext_vector_type(4)));
#define A3_PIN(x) asm volatile("" : "+v"(x))
#define A3_WAIT_BAR(N) asm volatile("s_waitcnt vmcnt(" #N ") lgkmcnt(0)\n\ts_barrier" ::: "memory")
__device__ __forceinline__ void glds16(const void* g, unsigned lds_base) {
    unsigned sv; asm volatile("s_mov_b32 %0, m0\n\ts_mov_b32 m0, %2\n\ts_nop 0\n\tglobal_load_lds_dwordx4 %1, off\n\ts_mov_b32 m0, %0" : "=&s"(sv) : "v"(g), "s"(lds_base) : "memory"); }
__device__ __forceinline__ void glds16s(const void* sbase, unsigned voff, unsigned lds_base) {
    asm volatile("s_mov_b32 m0, %2\n\ts_nop 0\n\tglobal_load_lds_dwordx4 %0, %1" :: "v"(voff), "s"(sbase), "s"(lds_base) : "memory", "m0"); }
__device__ __forceinline__ void kload2(bf16x8* kf, lds_cptr kp, int d0) { kf[2 * d0] = *(const LAS bf16x8*)(kp + d0 * 2048); kf[2 * d0 + 1] = *(const LAS bf16x8*)(kp + d0 * 2048 + 512); }
__device__ __forceinline__ s16x4 vtr(lds_cptr p) { return __builtin_bit_cast(s16x4, __builtin_amdgcn_ds_read_tr16_b64_v4i16((LAS v4i16_t*)p)); }
#define A3_MX3(a, b, c) fmaxf(fmaxf((a), (b)), (c))
__device__ __forceinline__ float rowmax3(const f32x16& p0, const f32x16& p1) {
    float a = A3_MX3(p0[0], p0[1], p1[0]), b = A3_MX3(p0[2], p0[3], p1[1]); a = A3_MX3(a, p1[2], p1[3]);
#pragma unroll
    for (int r = 4; r < 16; r += 4) { a = A3_MX3(a, p0[r], p0[r + 1]); b = A3_MX3(b, p0[r + 2], p0[r + 3]); a = A3_MX3(a, p1[r], p1[r + 1]); b = A3_MX3(b, p1[r + 2], p1[r + 3]); }
    float m = fmaxf(a, b); auto rr = __builtin_amdgcn_permlane32_swap(__float_as_uint(m), __float_as_uint(m), false, false);
    return fmaxf(__uint_as_float(rr[0]), __uint_as_float(rr[1])); }
__device__ __forceinline__ void attn_a3(LAS unsigned char* lds, const bf16* Q, const bf16* K, const bf16* V, int row_base, int NT, f32x16 (&o)[4], int tid) {
    const int lane = tid & 63, r32 = lane & 31, hi = lane >> 5; const int wid = __builtin_amdgcn_readfirstlane(tid >> 6);
    const unsigned lds0 = (unsigned)(unsigned long)lds; LAS float* wsf = (LAS float*)(lds + A3_WS) + wid * 64;
    const unsigned koff = (unsigned)(((size_t)(row_base + lane) * LDP + wid * 8) * 2);
    const unsigned voff = (unsigned)(((size_t)(row_base + 16 * (wid & 3) + (lane >> 2)) * LDP + (wid >> 2) * 32 + (lane & 3) * 8) * 2);
    const unsigned kdst = lds0 + A3_K + wid * 1024, vdst = lds0 + A3_V + wid * 1024;
#define DMA_K(t, sl) glds16s(K + (size_t)(t) * (64 * LDP), koff, (unsigned)__builtin_amdgcn_readfirstlane((int)(kdst + (sl))))
#define DMA_V(t, sl) do { const bf16* v_ = V + (size_t)(t) * (64 * LDP); const unsigned d_ = (unsigned)__builtin_amdgcn_readfirstlane((int)(vdst + 2 * (sl))); glds16s(v_, voff, d_); glds16s(v_ + 64, voff, d_ + 8192); } while (0)
    const lds_cptr vp0 = (lds_cptr)lds + A3_V + ((lane >> 4) & 1) * 32 + (lane & 3) * 8 + (4 * hi + ((lane & 15) >> 2)) * 64;
    const lds_cptr kp0 = (lds_cptr)lds + A3_K + hi * 1024 + r32 * 16;
    __syncthreads();
    DMA_K(0, 0); DMA_V(0, 0); DMA_K(1, 8192);
    bf16x8 qr[4];
    { const bf16* Qw = Q + (size_t)(wid * 32 + r32) * LDP + hi * 8;
#pragma unroll
      for (int d0 = 0; d0 < 4; ++d0) qr[d0] = *(const bf16x8*)(Qw + d0 * 16); }
    float mhat = 0.f, l_reg = 0.f;
#pragma unroll
    for (int d = 0; d < 4; ++d) o[d] = f32x16{};
    bool resc = false; f32x16 negm;
    f32x16 pA0, pA1, pB0, pB1; bf16x8 kf[8]; s16x4 vlo[4], vhi[4]; u32x4_t pw0, pw1, pw2, pw3;
    int sl_prev = 0, sl_cur = 0, sl_next = 8192;
#define ROT() do { sl_prev = sl_cur; sl_cur = sl_next; sl_next = (sl_next == 16384) ? 0 : sl_next + 8192; } while (0)
#define MFMA_(a, b, c) __builtin_amdgcn_mfma_f32_32x32x16_bf16(a, b, c, 0, 0, 0)
#define EX(v) __builtin_amdgcn_exp2f(v)
#define RESC3() do { if (resc) { _Pragma("unroll") for (int d_ = 0; d_ < 4; ++d_) _Pragma("unroll") for (int r = 0; r < 16; ++r) o[d_][r] *= wsf[crow(r, hi)]; } } while (0)
    DMA_K(2, 16384);
    A3_WAIT_BAR(4);
#pragma unroll
    for (int d0 = 0; d0 < 4; ++d0) kload2(kf, kp0, d0);
    pA0 = f32x16{}; pA1 = f32x16{};
#pragma unroll
    for (int d0 = 0; d0 < 4; ++d0) { pA0 = MFMA_(kf[2 * d0], qr[d0], pA0); pA1 = MFMA_(kf[2 * d0 + 1], qr[d0], pA1); }
    { mhat = rowmax3(pA0, pA1); const float nmh = -mhat;
#pragma unroll
      for (int r = 0; r < 16; ++r) { pA0[r] = EX(pA0[r] + nmh); pA1[r] = EX(pA1[r] + nmh); negm[r] = nmh; }
      A3_PIN(negm); }
    A3_WAIT_BAR(0);
    DMA_K(3, 0); DMA_V(1, 8192); ROT();
#pragma unroll
    for (int d0 = 0; d0 < 4; ++d0) kload2(kf, kp0 + sl_cur, d0);
    A3_WAIT_BAR(3);
#define PKW(P, i) cvt_pk_bf16(P[i], P[i + 1])
#define VFR(s) (bf16x8){vlo[s][0], vlo[s][1], vlo[s][2], vlo[s][3], vhi[s][0], vhi[s][1], vhi[s][2], vhi[s][3]}
#define VRD(s, g) do { vlo[s] = vtr(vp_ + (((g) & 3) * 4096 + ((g) >> 2) * 1024)); vhi[s] = vtr(vp_ + (((g) & 3) * 4096 + ((g) >> 2) * 1024 + 512)); } while (0)
#define KRD(G, d0) do { if (G) kload2(kf, kp0 + sl_next, d0); } while (0)
#define GAPA(MF, a0, a1, a2, a3, W0, W1, PW, RD) do { MF; RD; sacc += a0; sacc += a1; sacc += a2; sacc += a3; W0; W1; A3_PIN(PW); A3_PIN(sacc); SBAR(); } while (0)
#define GAPB(g, PA, X, i, RD) do { o[(g) & 3] = MFMA_(__builtin_bit_cast(bf16x8, PA), VFR((g) & 3), o[(g) & 3]); RD; X[i] = EX(X[i]); X[i + 1] = EX(X[i + 1]); A3_PIN(X); SBAR(); } while (0)
#define NORD do { } while (0)
#define STEP(C0, C1, P0, P1, t, GK, GV, GL) do { SBAR(); \
    const lds_cptr vp_ = vp0 + 2 * sl_prev; float sacc = P0[0] + P0[1]; \
    GAPA(C0 = MFMA_(kf[0], qr[0], negm),     P0[2], P0[3], P0[4], P0[5],     pw0[0] = PKW(P0, 0),  pw0[1] = PKW(P0, 2),  pw0, NORD); \
    GAPA(C1 = MFMA_(kf[1], qr[0], negm),     P0[6], P0[7], P0[8], P0[9],     pw0[2] = PKW(P0, 4),  pw0[3] = PKW(P0, 6),  pw0, NORD); \
    GAPA(C0 = MFMA_(kf[2], qr[1], C0),       P0[10], P0[11], P0[12], P0[13], pw1[0] = PKW(P0, 8),  pw1[1] = PKW(P0, 10), pw1, NORD); \
    GAPA(C1 = MFMA_(kf[3], qr[1], C1),       P0[14], P0[15], P1[0], P1[1],   pw1[2] = PKW(P0, 12), pw1[3] = PKW(P0, 14), pw1, NORD); \
    GAPA(C0 = MFMA_(kf[4], qr[2], C0),       P1[2], P1[3], P1[4], P1[5],     pw2[0] = PKW(P1, 0),  pw2[1] = PKW(P1, 2),  pw2, VRD(0, 0)); \
    GAPA(C1 = MFMA_(kf[5], qr[2], C1),       P1[6], P1[7], P1[8], P1[9],     pw2[2] = PKW(P1, 4),  pw2[3] = PKW(P1, 6),  pw2, VRD(1, 1)); \
    GAPA(C0 = MFMA_(kf[6], qr[3], C0),       P1[10], P1[11], P1[12], P1[13], pw3[0] = PKW(P1, 8),  pw3[1] = PKW(P1, 10), pw3, VRD(2, 2)); \
    GAPA(C1 = MFMA_(kf[7], qr[3], C1),       P1[14], P1[15], 0.f, 0.f,       pw3[2] = PKW(P1, 12), pw3[3] = PKW(P1, 14), pw3, VRD(3, 3)); \
    l_reg += sacc; \
    if (GK) DMA_K((t) + 3, sl_cur); if (GV) DMA_V((t) + 1, sl_next);                                                       \
    { const float rm = rowmax3(C0, C1); resc = false;                                                                      \
      if (__builtin_expect(__any(rm > THR2), 0)) { const float dl = fmaxf(rm, 0.f); mhat += dl;                            \
          const float f = __builtin_amdgcn_exp2f(-dl); l_reg *= f; if (hi == 0) wsf[r32] = f; resc = true; \
          _Pragma("unroll") for (int r = 0; r < 16; ++r) { C0[r] -= dl; C1[r] -= dl; negm[r] = -mhat; } } } \
    SBAR(); \
    GAPB(0,  pw0, C0, 0,  VRD(0, 4));  GAPB(1,  pw0, C0, 2,  VRD(1, 5));  GAPB(2,  pw0, C0, 4,  VRD(2, 6));  GAPB(3,  pw0, C0, 6,  VRD(3, 7)); \
    GAPB(4,  pw1, C0, 8,  VRD(0, 8));  GAPB(5,  pw1, C0, 10, VRD(1, 9));  GAPB(6,  pw1, C0, 12, VRD(2, 10)); GAPB(7,  pw1, C0, 14, VRD(3, 11)); \
    GAPB(8,  pw2, C1, 0,  VRD(0, 12)); GAPB(9,  pw2, C1, 2,  VRD(1, 13)); GAPB(10, pw2, C1, 4,  VRD(2, 14)); GAPB(11, pw2, C1, 6,  VRD(3, 15)); \
    GAPB(12, pw3, C1, 8,  KRD(GL, 0)); GAPB(13, pw3, C1, 10, KRD(GL, 1)); GAPB(14, pw3, C1, 12, KRD(GL, 2)); GAPB(15, pw3, C1, 14, KRD(GL, 3)); \
    } while (0)
#define ENDW(tt) do { if ((tt) + 3 < NT) { A3_WAIT_BAR(3); } else if ((tt) + 2 < NT) { A3_WAIT_BAR(2); } else { A3_WAIT_BAR(0); } } while (0)
    int t = 1;
    for (; t + 5 < NT; t += 2) {
        STEP(pB0, pB1, pA0, pA1, t, true, true, true);     A3_WAIT_BAR(3); RESC3(); ROT();
        STEP(pA0, pA1, pB0, pB1, t + 1, true, true, true); A3_WAIT_BAR(3); RESC3(); ROT();
    }
    for (; t + 1 < NT; t += 2) {
        STEP(pB0, pB1, pA0, pA1, t, (t + 3 < NT), (t + 1 < NT), (t + 1 < NT));         ENDW(t);     RESC3(); ROT();
        STEP(pA0, pA1, pB0, pB1, t + 1, (t + 4 < NT), (t + 2 < NT), (t + 2 < NT));     ENDW(t + 1); RESC3(); ROT();
    }
    STEP(pB0, pB1, pA0, pA1, NT - 1, false, false, false); RESC3();
    { float sacc = pB0[0] + pB0[1];
#pragma unroll
      for (int r = 2; r < 16; ++r) sacc += pB0[r];
#pragma unroll
      for (int r = 0; r < 16; ++r) sacc += pB1[r];
      l_reg += sacc;
      pw0 = (u32x4_t){PKW(pB0, 0), PKW(pB0, 2), PKW(pB0, 4), PKW(pB0, 6)}; pw1 = (u32x4_t){PKW(pB0, 8), PKW(pB0, 10), PKW(pB0, 12), PKW(pB0, 14)};
      pw2 = (u32x4_t){PKW(pB1, 0), PKW(pB1, 2), PKW(pB1, 4), PKW(pB1, 6)}; pw3 = (u32x4_t){PKW(pB1, 8), PKW(pB1, 10), PKW(pB1, 12), PKW(pB1, 14)};
      const lds_cptr vp_ = vp0 + 2 * sl_cur;
#define DR4(ks, PA) do { VRD(0, 4 * (ks)); VRD(1, 4 * (ks) + 1); VRD(2, 4 * (ks) + 2); VRD(3, 4 * (ks) + 3); \
      o[0] = MFMA_(__builtin_bit_cast(bf16x8, PA), VFR(0), o[0]); o[1] = MFMA_(__builtin_bit_cast(bf16x8, PA), VFR(1), o[1]); \
      o[2] = MFMA_(__builtin_bit_cast(bf16x8, PA), VFR(2), o[2]); o[3] = MFMA_(__builtin_bit_cast(bf16x8, PA), VFR(3), o[3]); } while (0)
      DR4(0, pw0); DR4(1, pw1); DR4(2, pw2); DR4(3, pw3);
#undef DR4
    }
    { auto rr = __builtin_amdgcn_permlane32_swap(__float_as_uint(l_reg), __float_as_uint(l_reg), false, false); l_reg = __uint_as_float(rr[0]) + __uint_as_float(rr[1]); }
    if (hi == 0) wsf[32 + r32] = l_reg; asm volatile("s_waitcnt lgkmcnt(0)" ::: "memory");
#pragma unroll
    for (int r = 0; r < 16; ++r) { const float rl = __builtin_amdgcn_rcpf(wsf[32 + crow(r, hi)]);
#pragma unroll
        for (int d = 0; d < 4; ++d) o[d][r] *= rl; }
#undef DMA_K
#undef DMA_V
#undef ROT
#undef MFMA_
#undef EX
#undef RESC3
#undef PKW
#undef VFR
#undef VRD
#undef KRD
#undef GAPA
#undef GAPB
#undef NORD
#undef STEP
#undef ENDW
}

constexpr int B3_V = 0, B3_K = 49152, B3_WS = 98304, B3_RPB = 100352;
static_assert(B3_RPB + 2048 <= RING_BYTES, "attention LDS map (B ring-3)");
#ifndef B_SMSPLIT
#define B_SMSPLIT 1
#endif
__device__ __forceinline__ void attn_b3(LAS unsigned char* lds, const UnitD& ud, const ModeP& mp, f32x16 (&o)[4], int tid) {
    constexpr int DK = 128;
    const int wid = __builtin_amdgcn_readfirstlane(tid >> 6), lane = tid & 63, r32 = lane & 31, hi = lane >> 5;
    LAS unsigned char* Vl = lds + B3_V; LAS unsigned char* Kl = lds + B3_K; const unsigned lds0 = (unsigned)(unsigned long)lds;
    LAS float* wsf = (LAS float*)(lds + B3_WS) + wid * 64; LAS float* li_l = wsf; LAS float* al_l = wsf + 32;
    const LAS float* rtab = (const LAS float*)(lds + B3_RPB);
    float m_reg = -1e30f, l_reg = 0.f;
#pragma unroll
    for (int d = 0; d < 4; ++d) o[d] = f32x16{};
    bf16x8 qr[DK / 16];
    { const bf16* Qw = ud.Q + (size_t)(wid * 32 + r32) * LDP + hi * 8;
#pragma unroll
      for (int d0 = 0; d0 < DK / 16; ++d0) qr[d0] = *(const bf16x8*)(Qw + d0 * 16); }
    const int vb0 = (int)(unsigned)(unsigned long)Vl + v_rd_base(lane);
    const int qc = 32 * (wid & 1) + r32, qrow = mp.qr0 + (wid >> 1), rs = min(max(qrow - 4, 0), 24), cst = min(max(qc - 8, 0), 48);
    const int krow = 4 * wid + (lane >> 4);
    const bf16* ksrc = ud.K + (size_t)krow * LDP + (((lane & 15) ^ (krow & 15)) * 8);
    const int bl = 2 * wid + (lane >> 5), kk = (bl >> 2) * 8 + ((lane & 31) >> 2), vk = (kk & ~0xC) | ((kk & 4) << 1) | ((kk & 8) >> 1);
    const bf16* vsrc = ud.V + (size_t)vk * LDP + (bl & 3) * 32 + (lane & 3) * 8;
    const unsigned kdst = lds0 + B3_K + wid * 1024, vdst = lds0 + B3_V + wid * 1024;
#define TROW(j_) (ud.row_base + 64 * ((j_) < 4 ? (j_) : ud.off + min((j_) - 4, ud.cap)))
#define DMA_T(j_, sl) do { const size_t ro_ = (size_t)TROW(j_) * LDP; const unsigned ks_ = (unsigned)__builtin_amdgcn_readfirstlane((int)(kdst + (sl))), vs_ = (unsigned)__builtin_amdgcn_readfirstlane((int)(vdst + (sl))); \
        glds16(ksrc + ro_, ks_); glds16(ksrc + ro_ + (size_t)32 * LDP, ks_ + 8192); glds16(vsrc + ro_, vs_); glds16(vsrc + ro_ + (size_t)32 * LDP, vs_ + 8192); } while (0)
#define WAIT0_BAR() asm volatile("s_waitcnt vmcnt(0) lgkmcnt(0)\n\ts_barrier" ::: "memory")
#define ROT() do { sp = sc; sc = sn; sn = (sn == 32768) ? 0 : sn + 16384; } while (0)
#define RESC(a) do { if (__any((a) < 1.f)) { if (hi == 0) al_l[r32] = (a); asm volatile("s_waitcnt lgkmcnt(0)" ::: "memory"); \
        _Pragma("unroll") for (int d = 0; d < 4; ++d) _Pragma("unroll") for (int r = 0; r < 16; ++r) o[d][r] *= al_l[crow(r, hi)]; } } while (0)
#define MASK(P0, P1, j_) do { if (!mp.plain && (j_) >= 4) b_mask(P0, P1, (j_), rtab, mp.kr0, mp.nkr, qrow, rs, qc, cst, hi); } while (0)
#if B_SMSPLIT
#define PVP1(VB, P0, P1, j_, MN, AL) do { MASK(P0, P1, j_); pv_sm(o, (VB), pa0, pa1, pa2, pa3, P0, P1, m_reg, MN, AL); } while (0)
#else
#define PVP1(VB, P0, P1, j_, MN, AL) do { pv_d0(o, (VB), pa0, pa1, pa2, pa3); MASK(P0, P1, j_); sm_part(P0, P1, m_reg, MN, AL); } while (0)
#endif
    f32x16 pA0, pA1, pB0, pB1; float mnA, mnB, alA, alB; bf16x8 pa0, pa1, pa2, pa3; const int NT = ud.NT;
    int sp = 0, sc = 0, sn = 16384;
    __syncthreads();
    if (!mp.plain) { if (tid < 465) ((LAS float*)(lds + B3_RPB))[tid] = mp.rpb[tid] * LOG2E; }
    DMA_T(0, 0); WAIT0_BAR();
    DMA_T(1, sn);
    qkt<DK>(pA0, pA1, Kl, qr, r32, hi); MASK(pA0, pA1, 0); sm_part(pA0, pA1, m_reg, mnA, alA);
    WAIT0_BAR(); ROT();
    for (int j = 1; j + 1 < NT; j += 2) {
        DMA_T(j + 1, sn);
        SBAR(); qkt<DK>(pB0, pB1, Kl + sc, qr, r32, hi);
        sm_fin(pA0, pA1, alA, l_reg, pa0, pa1, pa2, pa3); SBAR();
        PVP1(vb0 + sp, pB0, pB1, j, mnB, alB);
        WAIT0_BAR(); RESC(alB); ROT();
        if (j + 2 < NT) DMA_T(j + 2, sn);
        SBAR(); qkt<DK>(pA0, pA1, Kl + sc, qr, r32, hi);
        sm_fin(pB0, pB1, alB, l_reg, pa0, pa1, pa2, pa3); SBAR();
        PVP1(vb0 + sp, pA0, pA1, j + 1, mnA, alA);
        WAIT0_BAR(); RESC(alA); ROT();
    }
    SBAR(); qkt<DK>(pB0, pB1, Kl + sc, qr, r32, hi);
    sm_fin(pA0, pA1, alA, l_reg, pa0, pa1, pa2, pa3); SBAR();
    PVP1(vb0 + sp, pB0, pB1, NT - 1, mnB, alB);
    RESC(alB);
    sm_fin(pB0, pB1, alB, l_reg, pa0, pa1, pa2, pa3); SBAR();
    pv_d0(o, vb0 + sc, pa0, pa1, pa2, pa3);
    { if (hi == 0) li_l[r32] = l_reg; asm volatile("s_waitcnt lgkmcnt(0)" ::: "memory");
#pragma unroll
      for (int r = 0; r < 16; ++r) { const float rl = __builtin_amdgcn_rcpf(li_l[crow(r, hi)]);
#pragma unroll
          for (int d = 0; d < 4; ++d) o[d][r] *= rl; } }
    (void)mnA; (void)mnB;
#undef TROW
#undef DMA_T
#undef WAIT0_BAR
#undef ROT
#undef RESC
#undef MASK
#undef PVP1
}

constexpr int B4_K = 0, B4_V = 49152, B4_WS = 98304, B4_RPB = 100352;
static_assert(B4_RPB + 2048 <= RING_BYTES, "attention LDS map (B4)");
#ifndef B_STEP4
#define B_STEP4 1
#endif
__device__ __forceinline__ void attn_b4(LAS unsigned char* lds, const UnitD& ud, const ModeP& mp, f32x16 (&o)[4], int tid) {
    const int lane = tid & 63, r32 = lane & 31, hi = lane >> 5; const int wid = __builtin_amdgcn_readfirstlane(tid >> 6);
    const unsigned lds0 = (unsigned)(unsigned long)lds; LAS float* wsf = (LAS float*)(lds + B4_WS) + wid * 64;
    const LAS float* rtab = (const LAS float*)(lds + B4_RPB);
    const int qc = 32 * (wid & 1) + r32, qrow = mp.qr0 + (wid >> 1), rs = min(max(qrow - 4, 0), 24), cst = min(max(qc - 8, 0), 48);
    const unsigned koff = (unsigned)(((size_t)lane * LDP + wid * 8) * 2);
    const unsigned voff = (unsigned)(((size_t)(16 * (wid & 3) + (lane >> 2)) * LDP + (wid >> 2) * 32 + (lane & 3) * 8) * 2);
    const unsigned kdst = lds0 + B4_K + wid * 1024, vdst = lds0 + B4_V + wid * 1024;
#define TROW(j_) (ud.row_base + 64 * ((j_) < 4 ? (j_) : ud.off + min((j_) - 4, ud.cap)))
#define DMA_K(j_, sl) do { const bf16* k_ = ud.K + (size_t)TROW(j_) * LDP; const unsigned d_ = (unsigned)__builtin_amdgcn_readfirstlane((int)(kdst + (sl))); glds16s(k_, koff, d_); glds16s(k_ + 64, koff, d_ + 8192); } while (0)
#define DMA_V(j_, sl) do { const bf16* v_ = ud.V + (size_t)TROW(j_) * LDP; const unsigned d_ = (unsigned)__builtin_amdgcn_readfirstlane((int)(vdst + (sl))); glds16s(v_, voff, d_); glds16s(v_ + 64, voff, d_ + 8192); } while (0)
    const lds_cptr vp0 = (lds_cptr)lds + B4_V + ((lane >> 4) & 1) * 32 + (lane & 3) * 8 + (4 * hi + ((lane & 15) >> 2)) * 64;
    const lds_cptr kp0 = (lds_cptr)lds + B4_K + hi * 1024 + r32 * 16;
    __syncthreads();
    DMA_K(0, 0); DMA_V(0, 0); DMA_K(1, 16384); DMA_K(2, 32768);
    bf16x8 qr[8];
    { const bf16* Qw = ud.Q + (size_t)(wid * 32 + r32) * LDP + hi * 8;
#pragma unroll
      for (int d0 = 0; d0 < 8; ++d0) qr[d0] = *(const bf16x8*)(Qw + d0 * 16); }
    if (!mp.plain) { if (tid < 465) ((LAS float*)(lds + B4_RPB))[tid] = mp.rpb[tid] * LOG2E; }
    float mhat = 0.f, l_reg = 0.f;
#pragma unroll
    for (int d = 0; d < 4; ++d) o[d] = f32x16{};
    bool resc = false; const int NT = ud.NT;
    f32x16 pA0, pA1, pB0, pB1; bf16x8 kfr[4]; s16x4 vlo[4], vhi[4]; u32x4_t pw0, pw1, pw2, pw3;
    int sl_prev = 0, sl_cur = 0, sl_next = 16384;
#define ROT() do { sl_prev = sl_cur; sl_cur = sl_next; sl_next = (sl_next == 32768) ? 0 : sl_next + 16384; } while (0)
#define MFMA_(a, b, c) __builtin_amdgcn_mfma_f32_32x32x16_bf16(a, b, c, 0, 0, 0)
#define KF1(s, kp, g) kfr[s] = *(const LAS bf16x8*)((kp) + ((g) >> 1) * 2048 + ((g) & 1) * 512)
#define EX(v) __builtin_amdgcn_exp2f((v) + nmh)
#define RESC4() do { if (resc) { _Pragma("unroll") for (int d_ = 0; d_ < 4; ++d_) _Pragma("unroll") for (int r = 0; r < 16; ++r) o[d_][r] *= wsf[crow(r, hi)]; } } while (0)
#define WAIT0_BAR() asm volatile("s_waitcnt vmcnt(0) lgkmcnt(0)\n\ts_barrier" ::: "memory")
    WAIT0_BAR();
    pA0 = f32x16{}; pA1 = f32x16{};
#pragma unroll
    for (int g = 0; g < 16; g += 2) { KF1(0, kp0, g); KF1(1, kp0, g + 1); pA0 = MFMA_(kfr[0], qr[g >> 1], pA0); pA1 = MFMA_(kfr[1], qr[g >> 1], pA1); }
    { mhat = rowmax3(pA0, pA1); const float nmh = -mhat;
#pragma unroll
      for (int r = 0; r < 16; ++r) { pA0[r] = EX(pA0[r]); pA1[r] = EX(pA1[r]); } }
    asm volatile("s_waitcnt lgkmcnt(0)\n\ts_barrier" ::: "memory");
    DMA_V(1, 16384); ROT();
    KF1(0, kp0 + sl_cur, 0); KF1(1, kp0 + sl_cur, 1); KF1(2, kp0 + sl_cur, 2); KF1(3, kp0 + sl_cur, 3);
#define PKW(P, i) cvt_pk_bf16(P[i], P[i + 1])
#define VFR(s) (bf16x8){vlo[s][0], vlo[s][1], vlo[s][2], vlo[s][3], vhi[s][0], vhi[s][1], vhi[s][2], vhi[s][3]}
#define VRD(s, g) do { vlo[s] = vtr(vp_ + (((g) & 3) * 4096 + ((g) >> 2) * 1024)); vhi[s] = vtr(vp_ + (((g) & 3) * 4096 + ((g) >> 2) * 1024 + 512)); } while (0)
#define GA(g, CD, CS, a0, a1, W, PW, RD) do { CD = MFMA_(kfr[(g) & 3], qr[(g) >> 1], CS); RD; sacc += a0; sacc += a1; W; A3_PIN(PW); A3_PIN(sacc); SBAR(); } while (0)
#define GB(g, PA, X, i, RD) do { o[(g) & 3] = MFMA_(__builtin_bit_cast(bf16x8, PA), VFR((g) & 3), o[(g) & 3]); RD; X[i] = EX(X[i]); X[i + 1] = EX(X[i + 1]); A3_PIN(X); SBAR(); } while (0)
#define KNX(G, s) do { if (G) KF1(s, kp0 + sl_next, s); } while (0)
#define STEPB(C0, C1, P0, P1, t, GK, GV, GL) do { SBAR(); \
    const lds_cptr vp_ = vp0 + sl_prev; const lds_cptr kq_ = kp0 + sl_cur; float sacc = P0[0] + P0[1]; \
    GA(0,  C0, f32x16{}, P0[2],  P0[3],  pw0[0] = PKW(P0, 0),  pw0, KF1(0, kq_, 4)); \
    GA(1,  C1, f32x16{}, P0[4],  P0[5],  pw0[1] = PKW(P0, 2),  pw0, KF1(1, kq_, 5)); \
    GA(2,  C0, C0,       P0[6],  P0[7],  pw0[2] = PKW(P0, 4),  pw0, KF1(2, kq_, 6)); \
    GA(3,  C1, C1,       P0[8],  P0[9],  pw0[3] = PKW(P0, 6),  pw0, KF1(3, kq_, 7)); \
    GA(4,  C0, C0,       P0[10], P0[11], pw1[0] = PKW(P0, 8),  pw1, KF1(0, kq_, 8)); \
    GA(5,  C1, C1,       P0[12], P0[13], pw1[1] = PKW(P0, 10), pw1, KF1(1, kq_, 9)); \
    GA(6,  C0, C0,       P0[14], P0[15], pw1[2] = PKW(P0, 12), pw1, KF1(2, kq_, 10)); \
    GA(7,  C1, C1,       P1[0],  P1[1],  pw1[3] = PKW(P0, 14), pw1, KF1(3, kq_, 11)); \
    GA(8,  C0, C0,       P1[2],  P1[3],  pw2[0] = PKW(P1, 0),  pw2, KF1(0, kq_, 12)); \
    GA(9,  C1, C1,       P1[4],  P1[5],  pw2[1] = PKW(P1, 2),  pw2, KF1(1, kq_, 13)); \
    GA(10, C0, C0,       P1[6],  P1[7],  pw2[2] = PKW(P1, 4),  pw2, KF1(2, kq_, 14)); \
    GA(11, C1, C1,       P1[8],  P1[9],  pw2[3] = PKW(P1, 6),  pw2, KF1(3, kq_, 15)); \
    GA(12, C0, C0,       P1[10], P1[11], pw3[0] = PKW(P1, 8),  pw3, VRD(0, 0)); \
    GA(13, C1, C1,       P1[12], P1[13], pw3[1] = PKW(P1, 10), pw3, VRD(1, 1)); \
    GA(14, C0, C0,       P1[14], P1[15], pw3[2] = PKW(P1, 12), pw3, VRD(2, 2)); \
    GA(15, C1, C1,       0.f,    0.f,    pw3[3] = PKW(P1, 14), pw3, VRD(3, 3)); \
    l_reg += sacc; \
    if (GK) DMA_K((t) + 2, sl_prev); if (GV) DMA_V((t) + 1, sl_next);                                                      \
    if (!mp.plain && (t) >= 4) b_mask(C0, C1, (t), rtab, mp.kr0, mp.nkr, qrow, rs, qc, cst, hi); \
    { const float rm = rowmax3(C0, C1) - mhat; resc = false;                                                               \
      if (__builtin_expect(__any(rm > THR2), 0)) { const float dl = fmaxf(rm, 0.f); mhat += dl;                            \
          const float f = __builtin_amdgcn_exp2f(-dl); l_reg *= f; if (hi == 0) wsf[r32] = f; resc = true; } } \
    const float nmh = -mhat; SBAR(); \
    GB(0,  pw0, C0, 0,  VRD(0, 4));  GB(1,  pw0, C0, 2,  VRD(1, 5));  GB(2,  pw0, C0, 4,  VRD(2, 6));  GB(3,  pw0, C0, 6,  VRD(3, 7)); \
    GB(4,  pw1, C0, 8,  VRD(0, 8));  GB(5,  pw1, C0, 10, VRD(1, 9));  GB(6,  pw1, C0, 12, VRD(2, 10)); GB(7,  pw1, C0, 14, VRD(3, 11)); \
    GB(8,  pw2, C1, 0,  VRD(0, 12)); GB(9,  pw2, C1, 2,  VRD(1, 13)); GB(10, pw2, C1, 4,  VRD(2, 14)); GB(11, pw2, C1, 6,  VRD(3, 15)); \
    GB(12, pw3, C1, 8,  KNX(GL, 0)); GB(13, pw3, C1, 10, KNX(GL, 1)); GB(14, pw3, C1, 12, KNX(GL, 2)); GB(15, pw3, C1, 14, KNX(GL, 3)); \
    } while (0)
#define ACT(j_) (mp.plain || (j_) < 4 || (((j_) - 4 < mp.nkr) && (mp.kr0 + (j_) - 4 >= rs) && (mp.kr0 + (j_) - 4 < rs + 8)))
#define STEPI(C0, C1, t, GK, GV, GL) do { if (GK) DMA_K((t) + 2, sl_prev); if (GV) DMA_V((t) + 1, sl_next); resc = false; C0 = f32x16{}; C1 = f32x16{}; \
    if ((GL) && ACT((t) + 1)) { KF1(0, kp0 + sl_next, 0); KF1(1, kp0 + sl_next, 1); KF1(2, kp0 + sl_next, 2); KF1(3, kp0 + sl_next, 3); } } while (0)
#define STEPX(C0, C1, P0, P1, t, GK, GV, GL) do { if (ACT(t) || ACT((t) - 1)) STEPB(C0, C1, P0, P1, t, GK, GV, GL); else STEPI(C0, C1, t, GK, GV, GL); } while (0)
    int t = 1;
    for (; t + 3 < NT; t += 2) {
        STEPX(pB0, pB1, pA0, pA1, t, true, true, true);     WAIT0_BAR(); RESC4(); ROT();
        STEPX(pA0, pA1, pB0, pB1, t + 1, true, true, true); WAIT0_BAR(); RESC4(); ROT();
    }
    for (; t + 1 < NT; t += 2) {
        STEPX(pB0, pB1, pA0, pA1, t, (t + 2 < NT), (t + 1 < NT), (t + 1 < NT));         WAIT0_BAR(); RESC4(); ROT();
        STEPX(pA0, pA1, pB0, pB1, t + 1, (t + 3 < NT), (t + 2 < NT), (t + 2 < NT));     WAIT0_BAR(); RESC4(); ROT();
    }
    STEPX(pB0, pB1, pA0, pA1, NT - 1, false, false, false); RESC4();
    if (ACT(NT - 1)) { float sacc = pB0[0] + pB0[1];
#pragma unroll
      for (int r = 2; r < 16; ++r) sacc += pB0[r];
#pragma unroll
      for (int r = 0; r < 16; ++r) sacc += pB1[r];
      l_reg += sacc;
      pw0 = (u32x4_t){PKW(pB0, 0), PKW(pB0, 2), PKW(pB0, 4), PKW(pB0, 6)}; pw1 = (u32x4_t){PKW(pB0, 8), PKW(pB0, 10), PKW(pB0, 12), PKW(pB0, 14)};
      pw2 = (u32x4_t){PKW(pB1, 0), PKW(pB1, 2), PKW(pB1, 4), PKW(pB1, 6)}; pw3 = (u32x4_t){PKW(pB1, 8), PKW(pB1, 10), PKW(pB1, 12), PKW(pB1, 14)};
      const lds_cptr vp_ = vp0 + sl_cur;
#define DR4(ks, PA) do { VRD(0, 4 * (ks)); VRD(1, 4 * (ks) + 1); VRD(2, 4 * (ks) + 2); VRD(3, 4 * (ks) + 3); \
      o[0] = MFMA_(__builtin_bit_cast(bf16x8, PA), VFR(0), o[0]); o[1] = MFMA_(__builtin_bit_cast(bf16x8, PA), VFR(1), o[1]); \
      o[2] = MFMA_(__builtin_bit_cast(bf16x8, PA), VFR(2), o[2]); o[3] = MFMA_(__builtin_bit_cast(bf16x8, PA), VFR(3), o[3]); } while (0)
      DR4(0, pw0); DR4(1, pw1); DR4(2, pw2); DR4(3, pw3);
#undef DR4
    }
    { auto rr = __builtin_amdgcn_permlane32_swap(__float_as_uint(l_reg), __float_as_uint(l_reg), false, false); l_reg = __uint_as_float(rr[0]) + __uint_as_float(rr[1]); }
    if (hi == 0) wsf[32 + r32] = l_reg; asm volatile("s_waitcnt lgkmcnt(0)" ::: "memory");
#pragma unroll
    for (int r = 0; r < 16; ++r) { const float rl = __builtin_amdgcn_rcpf(wsf[32 + crow(r, hi)]);
#pragma unroll
        for (int d = 0; d < 4; ++d) o[d][r] *= rl; }
#undef TROW
#undef DMA_K
#undef DMA_V
#undef ROT
#undef MFMA_
#undef KF1
#undef EX
#undef RESC4
#undef WAIT0_BAR
#undef PKW
#undef VFR
#undef VRD
#undef GA
#undef GB
#undef KNX
#undef STEPB
#undef STEPI
#undef STEPX
#undef ACT
}

template <int KIND>
__device__ __forceinline__ void attn_epi(LAS unsigned char* lds, const f32x16 (&o)[4], int tid, int grow0, bf16* OUT, int ocol, const float* gw, float cm, const bf16* CG) {
    const int wid = __builtin_amdgcn_readfirstlane(tid >> 6), lane = tid & 63, r32 = lane & 31, hi = lane >> 5;
    __syncthreads();
    LAS float* Ow = (LAS float*)(lds + wid * L_OEPI);
#pragma unroll
    for (int d = 0; d < 4; ++d)
#pragma unroll
        for (int r = 0; r < 16; ++r) Ow[crow(r, hi) * 132 + d * 32 + r32] = o[d][r];
    asm volatile("s_waitcnt lgkmcnt(0)" ::: "memory");
    const int row = lane >> 1, half = lane & 1; const size_t grow = (size_t)(grow0 + wid * 32 + row);
    f32x4 x[16]; float ss = 0.f;
#pragma unroll
    for (int i = 0; i < 16; ++i) { x[i] = *(const LAS f32x4*)(Ow + row * 132 + half * 64 + 4 * i); ss += (x[i][0] * x[i][0] + x[i][1] * x[i][1]) + (x[i][2] * x[i][2] + x[i][3] * x[i][3]); }
    if constexpr (KIND != 1) {
        ss += swz_xor<1>(ss);
        const float rstd = 1.0f / sqrtf(ss * (1.0f / 128.0f) + EPS) * cm;
#pragma unroll
        for (int i = 0; i < 16; ++i) x[i] = x[i] * rstd * *(const f32x4*)(gw + half * 64 + 4 * i);
    }
    if constexpr (KIND == 2) {
        const v4u* cg = (const v4u*)(CG + grow * LDP + half * 64);
#pragma unroll
        for (int i = 0; i < 8; ++i) { const v4u g = cg[i];
            x[2 * i][0] *= silu_f(bflo(g.x)); x[2 * i][1] *= silu_f(bfhi(g.x)); x[2 * i][2] *= silu_f(bflo(g.y)); x[2 * i][3] *= silu_f(bfhi(g.y));
            x[2 * i + 1][0] *= silu_f(bflo(g.z)); x[2 * i + 1][1] *= silu_f(bfhi(g.z)); x[2 * i + 1][2] *= silu_f(bflo(g.w)); x[2 * i + 1][3] *= silu_f(bfhi(g.w)); }
    }
    v4u* op = (v4u*)(OUT + grow * 1024 + ocol + half * 64);
#pragma unroll
    for (int i = 0; i < 8; ++i) { v4u w; w.x = cvt_pk_bf16(x[2 * i][0], x[2 * i][1]); w.y = cvt_pk_bf16(x[2 * i][2], x[2 * i][3]); w.z = cvt_pk_bf16(x[2 * i + 1][0], x[2 * i + 1][1]); w.w = cvt_pk_bf16(x[2 * i + 1][2], x[2 * i + 1][3]); op[i] = w; }
}

constexpr int CST_K = 0, CST_VF = 16384, CST_VB = 32768;
__device__ __forceinline__ bf16x8 trfrag(int vb, int off) { s16x4 l, h; asm volatile("ds_read_b64_tr_b16 %0, %1" : "=&v"(l) : "v"(vb + off) : "memory"); asm volatile("ds_read_b64_tr_b16 %0, %1" : "=&v"(h) : "v"(vb + off + 2048) : "memory");
    return (bf16x8){l[0], l[1], l[2], l[3], h[0], h[1], h[2], h[3]}; }
__device__ __forceinline__ bf16x8 scale_frag(bf16x8 q, float f) { const v4u w = __builtin_bit_cast(v4u, q); v4u o;
    o.x = cvt_pk_bf16(bflo(w.x) * f, bfhi(w.x) * f); o.y = cvt_pk_bf16(bflo(w.y) * f, bfhi(w.y) * f); o.z = cvt_pk_bf16(bflo(w.z) * f, bfhi(w.z) * f); o.w = cvt_pk_bf16(bflo(w.w) * f, bfhi(w.w) * f);
    return __builtin_bit_cast(bf16x8, o); }
__device__ __forceinline__ void c_state_item(LAS unsigned char* lds, const bf16* K, const bf16* V, int row0, float lf, float lb, float* UO, int tid) {
    const int wid = __builtin_amdgcn_readfirstlane(tid >> 6), lane = tid & 63, r32 = lane & 31, hi = lane >> 5;
    const int sr = tid >> 4, sc = (tid & 15) * 8, kr64 = tid >> 3, kc64 = (tid & 7) * 8;
    const int dkh = wid >> 2, dvq = wid & 3;
    const int vbK = (int)(unsigned)(unsigned long)(lds + CST_K) + v_rd_base(lane), vbF = (int)(unsigned)(unsigned long)(lds + CST_VF) + v_rd_base(lane), vbB = (int)(unsigned)(unsigned long)(lds + CST_VB) + v_rd_base(lane);
    f32x16 aF = f32x16{}, aB = f32x16{};
    for (int t = 0; t < 4; ++t) {
        const bf16x8 kk = *(const bf16x8*)(K + (size_t)(row0 + 64 * t + kr64) * LDP + kc64);
        const bf16x8 v0 = *(const bf16x8*)(V + (size_t)(row0 + 64 * t + sr) * LDP + sc), v1 = *(const bf16x8*)(V + (size_t)(row0 + 64 * t + 32 + sr) * LDP + sc);
        const float j0 = (float)(64 * t + sr), j1 = j0 + 32.f;
        const float f0 = __builtin_amdgcn_exp2f(lf * (255.f - j0)), f1 = __builtin_amdgcn_exp2f(lf * (255.f - j1)), b0 = __builtin_amdgcn_exp2f(lb * j0), b1 = __builtin_amdgcn_exp2f(lb * j1);
        __syncthreads();
        *(LAS bf16x8*)(lds + CST_K + v_st(kr64, kc64)) = kk;
        *(LAS bf16x8*)(lds + CST_VF + v_st(sr, sc)) = scale_frag(v0, f0); *(LAS bf16x8*)(lds + CST_VF + v_st(32 + sr, sc)) = scale_frag(v1, f1);
        *(LAS bf16x8*)(lds + CST_VB + v_st(sr, sc)) = scale_frag(v0, b0); *(LAS bf16x8*)(lds + CST_VB + v_st(32 + sr, sc)) = scale_frag(v1, b1);
        __syncthreads();
#pragma unroll
        for (int ks = 0; ks < 4; ++ks) {
            const bf16x8 a = trfrag(vbK, v_rd_off(dkh, ks, 0)), bf = trfrag(vbF, v_rd_off(dvq, ks, 0)), bb = trfrag(vbB, v_rd_off(dvq, ks, 0));
            asm volatile("s_waitcnt lgkmcnt(0)" ::: "memory"); SBAR();
            aF = __builtin_amdgcn_mfma_f32_32x32x16_bf16(a, bf, aF, 0, 0, 0);
            aB = __builtin_amdgcn_mfma_f32_32x32x16_bf16(a, bb, aB, 0, 0, 0);
        }
    }
    float* o0 = UO + (size_t)(32 * dkh) * 128 + 32 * dvq + r32;
#pragma unroll
    for (int r = 0; r < 16; ++r) { o0[(size_t)crow(r, hi) * 128] = aF[r]; o0[8192 + (size_t)crow(r, hi) * 128] = aB[r]; }
    __syncthreads();
}
__device__ __forceinline__ void c_build_states(LAS unsigned char* lds, const float* UBH, int c, float lf, float lb, int tid) {
    const int d = tid >> 3, c0 = (tid & 7) * 16;
    f32x4 sf[4], sb[4];
#pragma unroll
    for (int q = 0; q < 4; ++q) { sf[q] = (f32x4){0.f, 0.f, 0.f, 0.f}; sb[q] = (f32x4){0.f, 0.f, 0.f, 0.f}; }
#pragma unroll
    for (int g = 0; g < 3; ++g) {
        f32x4 x[3][4]; float wf[3], wb[3];
#pragma unroll
        for (int u = 0; u < 3; ++u) { const int cp = 3 * g + u; const bool fw = cp < c;
            const float w = (cp == c) ? 0.f : fw ? __builtin_amdgcn_exp2f(lf * (float)(256 * (c - cp) - 255)) : __builtin_amdgcn_exp2f(lb * (float)(256 * (cp - c) - 255));
            wf[u] = fw ? w : 0.f; wb[u] = fw ? 0.f : w;
            const f32x4* src = (const f32x4*)(UBH + ((size_t)cp * 2 + (fw ? 0 : 1)) * 8192 + (size_t)d * 128 + c0);
#pragma unroll
            for (int q = 0; q < 4; ++q) x[u][q] = src[q]; }
#pragma unroll
        for (int u = 0; u < 3; ++u)
#pragma unroll
            for (int q = 0; q < 4; ++q) { sf[q] += x[u][q] * wf[u]; sb[q] += x[u][q] * wb[u]; }
    }
    { const float w = __builtin_amdgcn_exp2f(lb * (float)(2049 - 256 * c));
      const f32x4* src = (const f32x4*)(UBH + (size_t)1 * 8192 + (size_t)d * 128 + c0);
#pragma unroll
      for (int q = 0; q < 4; ++q) sb[q] += src[q] * w; }
#pragma unroll
    for (int half = 0; half < 2; ++half) {
        v4u wf, wb; wf.x = cvt_pk_bf16(sf[2 * half][0], sf[2 * half][1]); wf.y = cvt_pk_bf16(sf[2 * half][2], sf[2 * half][3]); wf.z = cvt_pk_bf16(sf[2 * half + 1][0], sf[2 * half + 1][1]); wf.w = cvt_pk_bf16(sf[2 * half + 1][2], sf[2 * half + 1][3]);
        wb.x = cvt_pk_bf16(sb[2 * half][0], sb[2 * half][1]); wb.y = cvt_pk_bf16(sb[2 * half][2], sb[2 * half][3]); wb.z = cvt_pk_bf16(sb[2 * half + 1][0], sb[2 * half + 1][1]); wb.w = cvt_pk_bf16(sb[2 * half + 1][2], sb[2 * half + 1][3]);
        *(LAS v4u*)(lds + L_STASH + v_st(d, c0 + 8 * half)) = wf; *(LAS v4u*)(lds + L_STASH + 16384 + v_st(d, c0 + 8 * half)) = wb; }
}
__device__ __forceinline__ void c_state_steps(LAS unsigned char* lds, const bf16* Q, float lf, float lb, f32x16 (&o)[4], int tid) {
    const int wid = __builtin_amdgcn_readfirstlane(tid >> 6), lane = tid & 63, r32 = lane & 31, hi = lane >> 5;
    const float il = (float)(wid * 32 + r32), ff = __builtin_amdgcn_exp2f(lf * il), fb = __builtin_amdgcn_exp2f(lb * (255.f - il));
    const bf16* Qw = Q + (size_t)(wid * 32 + r32) * LDP + hi * 8;
    bf16x8 q0 = *(const bf16x8*)(Qw), q1 = *(const bf16x8*)(Qw + 16), q2 = *(const bf16x8*)(Qw + 32), q3 = *(const bf16x8*)(Qw + 48);
    const int vbF = (int)(unsigned)(unsigned long)(lds + L_STASH) + v_rd_base(lane);
    pv_d0(o, vbF, scale_frag(q0, ff), scale_frag(q1, ff), scale_frag(q2, ff), scale_frag(q3, ff));
    pv_d0(o, vbF + 16384, scale_frag(q0, fb), scale_frag(q1, fb), scale_frag(q2, fb), scale_frag(q3, fb));
}
}

__device__ __forceinline__ void mix_simple(int l, const bf16* P, bf16* OA, bf16* OB, bf16* YR, const float* dlam, const float* dnorm, const float* rpb, const float* rdecay,
                                           const float* rnorm, float lam_init, LAS float* buf, int gw, int NGW, int lane, int modemask) {
    float lam;
    { const float v = dlam[lane] * dlam[64 + lane], w = dlam[128 + lane] * dlam[192 + lane]; lam = expf(wave_sum(v)) - expf(wave_sum(w)) + lam_init; }
    for (int it = gw; it < 3 * R * 8; it += NGW) {
        const int mode = it / (R * 8), rem = it - mode * (R * 8);
        if (!((modemask >> mode) & 1)) continue;
        const int b = rem / (8 * SB), h = (rem / SB) & 7, s = rem % SB;
        const bool cq = s < CTXL; if (cq && l == 1) continue;
        const int row = b * SB + s; const bf16* Pb = P + (size_t)b * SB * INC; const bf16* Prow = P + (size_t)row * INC;
        if (mode == 0) {
            const int nk = cq ? CTXL : SB; float oa0 = 0.f, oa1 = 0.f;
            for (int map = 0; map < 2; ++map) {
                float q[64]; load_q<64>(q, Prow + C_AQ + h * 128 + map * 64);
                float mx = -INFINITY;
                for (int j = lane; j < nk; j += 64) { const float sc = dot_q<64>(q, Pb + (size_t)j * INC + C_AK + h * 128 + map * 64); buf[j] = sc; mx = fmaxf(mx, sc); }
                const float inv = softmax_buf(buf, nk, mx, lane);
                float a0 = 0.f, a1 = 0.f; const bf16* vb = Pb + C_AV + h * 128 + lane;
#pragma unroll 8
                for (int j = 0; j < nk; ++j) { const float p = buf[j]; a0 += p * bf1(vb[(size_t)j * INC]); a1 += p * bf1(vb[(size_t)j * INC + 64]); }
                a0 *= inv; a1 *= inv;
                if (map == 0) { oa0 = a0; oa1 = a1; } else { oa0 -= lam * a0; oa1 -= lam * a1; }
                LDS_WAIT(); asm volatile("" ::: "memory");
            }
            const float rstd = 1.0f / sqrtf(wave_sum(oa0 * oa0 + oa1 * oa1) * (1.0f / 128.0f) + EPS), cm = 1.0f - lam_init;
            bf16* op = OA + (size_t)row * 1024 + h * 128 + lane;
            op[0] = (bf16)f2bf(oa0 * rstd * dnorm[lane] * cm); op[64] = (bf16)f2bf(oa1 * rstd * dnorm[64 + lane] * cm);
        } else if (mode == 1) {
            float q[128]; load_q<128>(q, Prow + C_BQ + h * 128);
            float mx = -INFINITY; int nk = CTXL, r = 0, qc = 0, rs = 0, cs = 0;
            for (int j = lane; j < CTXL; j += 64) { const float sc = dot_q<128>(q, Pb + (size_t)j * INC + C_BK + h * 128); buf[j] = sc; mx = fmaxf(mx, sc); }
            if (!cq) { const int t = s - CTXL; r = t >> 6; qc = t & 63; rs = min(max(r - 4, 0), 24); cs = min(max(qc - 8, 0), 48); nk = CTXL + 128;
                for (int i = lane; i < 128; i += 64) { const int kr = rs + (i >> 4), kc = cs + (i & 15);
                    const float sc = dot_q<128>(q, Pb + (size_t)(CTXL + kr * 64 + kc) * INC + C_BK + h * 128) + rpb[(h * 15 + (kr - r + 7)) * 31 + (kc - qc + 15)] * LOG2E;
                    buf[CTXL + i] = sc; mx = fmaxf(mx, sc); } }
            const float inv = softmax_buf(buf, nk, mx, lane);
            float a0 = 0.f, a1 = 0.f; const bf16* vb = Pb + C_BV + h * 128 + lane;
#pragma unroll 8
            for (int j = 0; j < nk; ++j) { const int kk = (j < CTXL) ? j : CTXL + (rs + ((j - CTXL) >> 4)) * 64 + cs + ((j - CTXL) & 15);
                const float p = buf[j]; a0 += p * bf1(vb[(size_t)kk * INC]); a1 += p * bf1(vb[(size_t)kk * INC + 64]); }
            bf16* op = OB + (size_t)row * 1024 + h * 128 + lane;
            op[0] = (bf16)f2bf(a0 * inv); op[64] = (bf16)f2bf(a1 * inv);
            LDS_WAIT(); asm volatile("" ::: "memory");
        } else {
            float q[64]; load_q<64>(q, Prow + C_CQ + h * 64);
            const int nk = cq ? CTXL : SB;
            const float lf = -log1pf(expf(-rdecay[h])) * LOG2E, lb = -log1pf(expf(-rdecay[8 + h])) * LOG2E;
            for (int j = lane; j < nk; j += 64) { const float sc = dot_q<64>(q, Pb + (size_t)j * INC + C_CK + h * 64);
                const int df = s - j, db = ((!cq && j < CTXL) ? SB : 0) - df;
                const float w = (df >= 0 ? __builtin_amdgcn_exp2f(lf * (float)df) : 0.f) + (db >= 0 ? __builtin_amdgcn_exp2f(lb * (float)db) : 0.f);
                buf[j] = sc * w; }
            LDS_WAIT(); asm volatile("" ::: "memory");
            float a0 = 0.f, a1 = 0.f; const bf16* vb = Pb + C_CV + h * 128 + lane;
#pragma unroll 8
            for (int j = 0; j < nk; ++j) { const float p = buf[j]; a0 += p * bf1(vb[(size_t)j * INC]); a1 += p * bf1(vb[(size_t)j * INC + 64]); }
            const float rstd = 1.0f / sqrtf(wave_sum(a0 * a0 + a1 * a1) * (1.0f / 128.0f) + EPS);
            const bf16* gp = Prow + C_CG + h * 128 + lane;
            bf16* op = YR + (size_t)row * 1024 + h * 128 + lane;
            op[0] = (bf16)f2bf(a0 * rstd * rnorm[lane] * silu_f(bf1(gp[0]))); op[64] = (bf16)f2bf(a1 * rstd * rnorm[64 + lane] * silu_f(bf1(gp[64])));
            LDS_WAIT(); asm volatile("" ::: "memory");
        }
    }
}

__device__ __forceinline__ void mix_states(LAS unsigned char* lds, const bf16* P, float* UST, const float* rdecay, int vcu, int G, int tid_in) {
    for (int it = vcu; it < 64 * 9; it += G) {
        int tid = tid_in; asm volatile("" : "+v"(tid));
        const int bh = it / 9, c = it - bh * 9, b = bh >> 3, h = bh & 7;
        const float lf = -log1pf(expf(-rdecay[h])) * LOG2E, lb = -log1pf(expf(-rdecay[8 + h])) * LOG2E;
        att::c_state_item(lds, P + C_CK + h * 64, P + C_CV + h * 128, b * SB + 256 * c, lf, lb, UST + (size_t)it * 2 * 8192, tid);
    }
}

__device__ __forceinline__ void mix_mfma(int l, LAS unsigned char* lds, const bf16* P, bf16* OA, bf16* OB, bf16* YR, const float* dlam, const float* dnorm, const float* rpb,
                                         const float* rdecay, const float* rnorm, float lam_init, const float* UST, unsigned* STG, int vcu, int G, int tid_in, int modemask) {
    const int wid = __builtin_amdgcn_readfirstlane(tid_in >> 6);
    const int nun = 512 + (l == 0 ? 64 : 0);
    if (modemask & 1) {
        float lam; { const int lane = tid_in & 63; const float v = dlam[lane] * dlam[64 + lane], w = dlam[128 + lane] * dlam[192 + lane]; lam = expf(wave_sum(v)) - expf(wave_sum(w)) + lam_init; }
        lam = __builtin_bit_cast(float, __builtin_amdgcn_readfirstlane(__builtin_bit_cast(int, lam)));
        for (int u = vcu; u < nun; u += G) {
            const bool cu = u >= 512; const int uu = cu ? u - 512 : u;
            const int b = cu ? (uu >> 3) : (uu >> 6), h = cu ? (uu & 7) : ((uu >> 3) & 7), qb = cu ? 0 : (uu & 7);
            const int grow0 = b * SB + (cu ? 0 : CTXL + 256 * qb), NT = cu ? 4 : 36;
            att::f32x16 o[4];
            for (int map = 0; map < 2; ++map) {
                int tid = tid_in; asm volatile("" : "+v"(tid)); const int lane = tid & 63;
                const att::UnitD ud{P + (size_t)grow0 * INC + C_AQ + h * 128 + map * 64, P + C_AK + h * 128 + map * 64, P + C_AV + h * 128, b * SB, 4, 1000, NT};
                const att::ModeP mp{};
#if A_RING3
                att::attn_a3(lds, ud.Q, ud.K, ud.V, ud.row_base, ud.NT, o, tid); (void)mp;
                LAS unsigned* st = (LAS unsigned*)(lds + (wid < 7 ? att::L_STASH3 + wid * 8192 : LTAB_OFF)) + lane;
#else
                att::attn_core<64, 0, 2>(lds, ud, mp, o, tid);
                LAS unsigned* st = (LAS unsigned*)(lds + att::L_STASH) + wid * 2048 + lane;
#endif
                if (map == 0) {
#pragma unroll
                    for (int d = 0; d < 4; ++d)
#pragma unroll
                        for (int r2 = 0; r2 < 8; ++r2) st[(d * 8 + r2) * 64] = cvt_pk_bf16(o[d][2 * r2], o[d][2 * r2 + 1]);
                } else {
#pragma unroll
                    for (int d = 0; d < 4; ++d)
#pragma unroll
                        for (int r2 = 0; r2 < 8; ++r2) { const unsigned w = st[(d * 8 + r2) * 64]; o[d][2 * r2] = bflo(w) - lam * o[d][2 * r2]; o[d][2 * r2 + 1] = bfhi(w) - lam * o[d][2 * r2 + 1]; }
                }
                LDS_WAIT(); asm volatile("" ::: "memory");
            }
            { int tid = tid_in; asm volatile("" : "+v"(tid)); att::attn_epi<0>(lds, o, tid, grow0, OA, h * 128, dnorm, 1.0f - lam_init, nullptr); }
        }
    }
    if (modemask & 4) {
        for (int u = (vcu + 64) % G; u < nun; u += G) {
            const bool cu = u >= 512; const int uu = cu ? u - 512 : u;
            const int b = cu ? (uu >> 3) : (uu >> 6), h = cu ? (uu & 7) : ((uu >> 3) & 7), c = cu ? 0 : (uu & 7) + 1;
            const int grow0 = b * SB + 256 * c;
            att::f32x16 o[4]; int tid = tid_in; asm volatile("" : "+v"(tid));
            const float lf = -log1pf(expf(-rdecay[h])) * LOG2E, lb = -log1pf(expf(-rdecay[8 + h])) * LOG2E;
            const bf16* Qp = P + (size_t)grow0 * INC + C_CQ + h * 64;
            __syncthreads();
            if (!cu) att::c_build_states(lds, UST + (size_t)(b * 8 + h) * 9 * 2 * 8192, c, lf, lb, tid);
            const att::UnitD ud{Qp, P + C_CK + h * 64, P + C_CV + h * 128, grow0, 4, 1000, 4};
            att::ModeP mp{}; mp.lf = lf; mp.lb = lb; mp.sq0 = 0; mp.latq = 0;
            att::attn_core<64, 2, 2>(lds, ud, mp, o, tid);
            if (!cu) att::c_state_steps(lds, Qp, lf, lb, o, tid);
            att::attn_epi<2>(lds, o, tid, grow0, YR, h * 128, rnorm, 1.0f, P + C_CG + h * 128);
        }
    }
    if (modemask & 2) {
        for (int u = (vcu + 128) % G; u < nun; u += G) {
            const bool cu = u >= 512; const int uu = cu ? u - 512 : u;
            const int b = cu ? (uu >> 3) : (uu >> 6), h = cu ? (uu & 7) : ((uu >> 3) & 7), g = cu ? 0 : (uu & 7);
            const int grow0 = b * SB + (cu ? 0 : CTXL + 256 * g);
            const int kr0 = min(max(4 * g - 4, 0), 24), kr1 = min(max(4 * g - 1, 0), 24) + 7, nkr = kr1 - kr0 + 1, NT = cu ? 4 : ((4 + nkr + 1) & ~1);
            att::f32x16 o[4]; int tid = tid_in; asm volatile("" : "+v"(tid));
            const att::UnitD ud{P + (size_t)grow0 * INC + C_BQ + h * 128, P + C_BK + h * 128, P + C_BV + h * 128, b * SB, 4 + kr0, nkr - 1, NT};
            att::ModeP mp{}; mp.plain = cu ? 1 : 0; mp.kr0 = kr0; mp.nkr = nkr; mp.qr0 = 4 * g; mp.rpb = rpb + h * 465;
#if B_STEP4
            att::attn_b4(lds, ud, mp, o, tid);
#elif B_RING3
            att::attn_b3(lds, ud, mp, o, tid);
#else
            att::attn_core<128, 1, BSD>(lds, ud, mp, o, tid);
#endif
            att::attn_epi<1>(lds, o, tid, grow0, OB, h * 128, nullptr, 1.0f, nullptr);
        }
    }
    __syncthreads();
}

struct TArgs { const float* xin; const float* cin; const bf16* hin; bf16* hout; float* fout; const bf16* Y; const bf16* YP; float wgt; const float* gate; const float* postg;
               const float* preg; const float* shift; const float* scale; bf16* U; int upd, nxt, skip_ctx; };
template <bool XIN> struct RawRow { typename std::conditional<XIN, v4u, v2u>::type v[8]; v2u y[8]; };
template <bool XIN> __device__ __forceinline__ void thin_load_row(const TArgs& T, int row, int lane, RawRow<XIN>& r) {
    const int b = row / SB, s = row - b * SB; const bool cq = s < CTXL;
    if (cq && T.skip_ctx) return;
    if constexpr (XIN) { const v4u* hi_ = (const v4u*)(cq ? T.cin + (size_t)(b * CTXL + s) * DM : T.xin + (size_t)(b * SEQ + s - CTXL) * DM) + lane;
#pragma unroll
        for (int j = 0; j < 8; ++j) r.v[j] = __builtin_nontemporal_load(hi_ + 64 * j); }
    else { const v2u* hi_ = (const v2u*)(T.hin + (size_t)row * DM) + lane;
#pragma unroll
        for (int j = 0; j < 8; ++j) r.v[j] = __builtin_nontemporal_load(hi_ + 64 * j); }
    if (T.upd) {
        if (cq && T.YP) { const v2u* yp = (const v2u*)(T.YP + (size_t)(b * CTXL + s) * DM) + lane; constexpr size_t ZS = (size_t)NBATCH * CTXL * DM / 4;
#pragma unroll
            for (int j = 0; j < 8; ++j) { const v2u w0 = yp[64 * j], w1 = yp[64 * j + ZS], w2 = yp[64 * j + 2 * ZS], w3 = yp[64 * j + 3 * ZS];
                r.y[j] = (v2u){cvt_pk_bf16((bflo(w0.x) + bflo(w1.x)) + (bflo(w2.x) + bflo(w3.x)), (bfhi(w0.x) + bfhi(w1.x)) + (bfhi(w2.x) + bfhi(w3.x))),
                               cvt_pk_bf16((bflo(w0.y) + bflo(w1.y)) + (bflo(w2.y) + bflo(w3.y)), (bfhi(w0.y) + bfhi(w1.y)) + (bfhi(w2.y) + bfhi(w3.y)))}; } }
        else { const v2u* yp = (const v2u*)(T.Y + (size_t)row * DM) + lane;
#pragma unroll
            for (int j = 0; j < 8; ++j) r.y[j] = __builtin_nontemporal_load(yp + 64 * j); }
    }
}
template <bool XIN> __device__ __forceinline__ void thin_do_row(const TArgs& T, int row, int lane, const RawRow<XIN>& r, const LAS f32x4* L) {
    const int b = row / SB, s = row - b * SB; const bool cq = s < CTXL;
    if (cq && T.skip_ctx) return;
    const int co = cq ? 512 : 0;
    f32x4 v[8];
#pragma unroll
    for (int j = 0; j < 8; ++j) { if constexpr (XIN) v[j] = __builtin_bit_cast(f32x4, r.v[j]); else v[j] = (f32x4){bflo(r.v[j].x), bfhi(r.v[j].x), bflo(r.v[j].y), bfhi(r.v[j].y)}; }
    if (T.upd) {
        f32x4 y[8]; float ss = 0.f;
#pragma unroll
        for (int j = 0; j < 8; ++j) y[j] = (f32x4){bflo(r.y[j].x), bfhi(r.y[j].x), bflo(r.y[j].y), bfhi(r.y[j].y)};
#pragma unroll
        for (int j = 0; j < 8; ++j) ss += (y[j][0] * y[j][0] + y[j][1] * y[j][1]) + (y[j][2] * y[j][2] + y[j][3] * y[j][3]);
        const float rstd = 1.0f / sqrtf(wave_sum(ss) * (1.0f / DM) + EPS) * T.wgt;
#pragma unroll
        for (int j = 0; j < 8; ++j) v[j] += L[co + lane + 64 * j] * (y[j] * rstd * L[1024 + lane + 64 * j]);
        if (T.fout) { if (!cq) { f32x4* ho_ = (f32x4*)(T.fout + (size_t)(b * SEQ + s - CTXL) * DM) + lane;
#pragma unroll
            for (int j = 0; j < 8; ++j) ho_[64 * j] = v[j]; } }
        else { v2u* ho_ = (v2u*)(T.hout + (size_t)row * DM) + lane;
#pragma unroll
            for (int j = 0; j < 8; ++j) { v2u w; w.x = cvt_pk_bf16(v[j][0], v[j][1]); w.y = cvt_pk_bf16(v[j][2], v[j][3]); ho_[64 * j] = w;
                v[j] = (f32x4){bflo(w.x), bfhi(w.x), bflo(w.y), bfhi(w.y)}; } }
    }
    if (T.nxt) {
        float ss = 0.f;
#pragma unroll
        for (int j = 0; j < 8; ++j) ss += (v[j][0] * v[j][0] + v[j][1] * v[j][1]) + (v[j][2] * v[j][2] + v[j][3] * v[j][3]);
        const float rstd = 1.0f / sqrtf(wave_sum(ss) * (1.0f / DM) + EPS);
        v2u* up = (v2u*)(T.U + (size_t)row * DM) + lane;
#pragma unroll
        for (int j = 0; j < 8; ++j) { const f32x4 u = (v[j] * rstd * L[1536 + lane + 64 * j]) * (L[2048 + co + lane + 64 * j] + 1.0f) + L[3072 + co + lane + 64 * j];
            v2u w; w.x = cvt_pk_bf16(u[0], u[1]); w.y = cvt_pk_bf16(u[2], u[3]); up[64 * j] = w; }
    }
}
template <bool XIN> __device__ __forceinline__ void thin_phase(const TArgs& T, LAS unsigned char* lds, int vcu, int G, int tid) {
    const int lane = tid & 63, wave = __builtin_amdgcn_readfirstlane(tid >> 6);
    const int rpc = R / G, base = vcu * rpc, bb = base / SB;
    LAS f32x4* L = (LAS f32x4*)lds;
    f32x4 sv[8];
#pragma unroll
    for (int vsel = 0; vsel < 8; ++vsel) { const size_t mo = (size_t)((vsel & 1) ? 8 : bb) * (9 * DM);
        const float* src = (vsel < 2) ? (T.upd ? T.gate + mo : nullptr) : (vsel == 2) ? (T.upd ? T.postg : nullptr) : (vsel == 3) ? (T.nxt ? T.preg : nullptr)
                         : (vsel < 6) ? (T.nxt ? T.scale + mo : nullptr) : (T.nxt ? T.shift + mo : nullptr);
        sv[vsel] = src ? ((const f32x4*)src)[tid] : (f32x4){0.f, 0.f, 0.f, 0.f}; }
    const int nk = rpc / NWAVES, r0 = base + wave;
    RawRow<XIN> A, B, C;
    thin_load_row<XIN>(T, r0, lane, A); if (1 < nk) thin_load_row<XIN>(T, r0 + NWAVES, lane, B);
#pragma unroll
    for (int vsel = 0; vsel < 8; ++vsel) L[vsel * 512 + tid] = sv[vsel];
    __syncthreads();
    for (int k = 0; k < nk; k += 3) {
        if (k + 2 < nk) thin_load_row<XIN>(T, r0 + NWAVES * (k + 2), lane, C);
        thin_do_row<XIN>(T, r0 + NWAVES * k, lane, A, L);
        if (k + 1 < nk) { if (k + 3 < nk) thin_load_row<XIN>(T, r0 + NWAVES * (k + 3), lane, A);
            thin_do_row<XIN>(T, r0 + NWAVES * (k + 1), lane, B, L); }
        if (k + 2 < nk) { if (k + 4 < nk) thin_load_row<XIN>(T, r0 + NWAVES * (k + 4), lane, B);
            thin_do_row<XIN>(T, r0 + NWAVES * (k + 2), lane, C, L); }
    }
    __syncthreads();
}

__device__ __forceinline__ void p0_convert(int l, const float* w1, const float* w2, const float* win, const float* wb, const float* wo, unsigned char* wt, LAS unsigned char* lds, int gw, int NGW, int wave, int lane, int it0 = 0, int it1 = 1 << 30) {
    LAS float* scr = (LAS float*)(lds + wave * 16384);
    constexpr int I_W1 = 32 * 352, I_W2 = 88 * 64, I_IN = 32 * 480, I_WB = 16 * 64, I_WO = 32 * 64, NIT = 2 * I_W1 + 2 * I_W2 + I_IN + 3 * I_WB + I_WO;
    const int itE = it1 < NIT ? it1 : NIT;
    for (int it = it0 + gw; it < itE; it += NGW) {
        int r = it;
        if (r < 2 * I_W1) { const int i = r / I_W1; r -= i * I_W1; const int kb = r / 352, n0 = (r % 352) * 32;
            const int orow0 = (n0 < FFN) ? (n0 / 128) * 256 + (n0 % 128) : ((n0 - FFN) / 128) * 256 + 128 + ((n0 - FFN) % 128);
            transpose_item(w1 + (size_t)(l * 2 + i) * DM * (2 * FFN), DM, 2 * FFN, (bf16*)(wt + (i ? WT_W1B : WT_W1A)), kb * 64, n0, orow0, (n0 < FFN) ? -LOG2E : -1.0f / LOG2E, scr, lane); continue; }
        r -= 2 * I_W1;
        if (r < 2 * I_W2) { const int i = r / I_W2; r -= i * I_W2; const int kb = r / 64, n0 = (r % 64) * 32;
            transpose_item(w2 + (size_t)(l * 2 + i) * FFN * DM, FFN, DM, (bf16*)(wt + (i ? WT_W2B : WT_W2A)), kb * 64, n0, n0, 1.0f, scr, lane); continue; }
        r -= 2 * I_W2;
        if (r < I_IN) { const int kb = r / 480, n0 = (r % 480) * 32;
            const float sc = (n0 < C_AK) ? SCALE_A : (n0 >= C_BQ && n0 < C_BK) ? SCALE_B : (n0 >= C_CK && n0 < C_CV) ? SCALE_CK : 1.0f;
            transpose_item(win + (size_t)l * DM * INC, DM, INC, (bf16*)(wt + WT_IN), kb * 64, n0, n0, sc, scr, lane); continue; }
        r -= I_IN;
        if (r < 3 * I_WB) { const int br = r / I_WB; r -= br * I_WB; const int kb = r / 64, n0 = (r % 64) * 32;
            transpose_item(wb + (size_t)(l * 3 + br) * 1024 * DM, 1024, DM, (bf16*)(wt + WT_WB) + (size_t)br * DM * 1024, kb * 64, n0, n0, 1.0f, scr, lane); continue; }
        r -= 3 * I_WB;
        { const int kb = r / 64, n0 = (r % 64) * 32; transpose_item(wo + (size_t)l * DM * DM, DM, DM, (bf16*)(wt + WT_WO), kb * 64, n0, n0, 1.0f, scr, lane); }
    }
}
__device__ __forceinline__ void p0_mod(const float* c, const float* cctx, const float* wmod, const float* bmod, float* MOD, LAS unsigned char* lds, int it0, int it1, int G, int tid, int wave, int lane) {
    LAS float* S = (LAS float*)(lds + wave * 9216);
    for (int it = it0; it < it1; it += G) {
        const int l = it / 72, n0 = (it % 72) * 256, k0 = wave * 256;
        { float xs[9][4];
#pragma unroll
          for (int r = 0; r < 9; ++r)
#pragma unroll
              for (int q = 0; q < 4; ++q) xs[r][q] = (r < 8) ? c[r * DM + k0 + lane + 64 * q] : cctx[k0 + lane + 64 * q];
#pragma unroll
          for (int r = 0; r < 9; ++r)
#pragma unroll
              for (int q = 0; q < 4; ++q) { const float x = xs[r][q]; S[r * 256 + lane + 64 * q] = x / (1.0f + expf(-x)); } }
        LDS_WAIT(); asm volatile("" ::: "memory");
        f32x4 acc[9];
#pragma unroll
        for (int r = 0; r < 9; ++r) acc[r] = (f32x4){0.f, 0.f, 0.f, 0.f};
        const float* wp = wmod + ((size_t)(l * DM + k0)) * 18432 + n0 + 4 * lane;
        for (int kk = 0; kk < 256; kk += 16) {
            f32x4 w[16];
#pragma unroll
            for (int i = 0; i < 16; ++i) w[i] = __builtin_nontemporal_load((const f32x4*)(wp + (size_t)(kk + i) * 18432));
#pragma unroll
            for (int g = 0; g < 4; ++g)
#pragma unroll
                for (int r = 0; r < 9; ++r) { const f32x4 s = *(const LAS f32x4*)(S + r * 256 + kk + 4 * g); acc[r] += w[4 * g] * s[0] + w[4 * g + 1] * s[1] + w[4 * g + 2] * s[2] + w[4 * g + 3] * s[3]; }
        }
        asm volatile("" ::: "memory");
#pragma unroll
        for (int r = 0; r < 9; ++r) *(LAS f32x4*)(S + r * 256 + 4 * lane) = acc[r];
        __syncthreads();
        for (int idx = tid; idx < 9 * 256; idx += NWAVES * 64) { const int r = idx >> 8, cc = idx & 255; float s = bmod[l * 18432 + n0 + cc];
#pragma unroll
            for (int w = 0; w < NWAVES; ++w) s += ((const LAS float*)(lds + w * 9216))[r * 256 + cc];
            MOD[(size_t)(l * 9 + r) * 18432 + n0 + cc] = s; }
        __syncthreads();
    }
}

constexpr int BG_NIT = 2 * 32 * 352 + 2 * 88 * 64 + 32 * 480 + 3 * 16 * 64 + 32 * 64;
#ifndef P0_SPLIT
#define P0_SPLIT 38000
#endif
#ifndef BG1
#define BG1 13000
#define BG2 26000
#define BG3 54272
#endif
#define BG_CONVERT(FIRST_IDLE, IT0, IT1) do { if (l == 0 && (int)blockIdx.x >= (FIRST_IDLE) && (IT1) > (IT0)) { PH_VARS \
    p0_convert(1, a.in[8], a.in[9], a.in[10], a.in[16], a.in[17], ws + WS_WT1, lds, ((int)blockIdx.x - (FIRST_IDLE)) * NWAVES + wave, (G - (FIRST_IDLE)) * NWAVES, wave, lane, (IT0), (IT1)); } } while (0)
#ifndef PROBE_DUP
#define PROBE_DUP 0
#endif
#ifndef MFMA_MODES
#define MFMA_MODES 7
#endif
#define GEMM_PHASE_Z(EPI_T, E_, Aptr, Bptr, N_, K_, LD_, ZA_, ZB_, ZN_, NM_, LAT_) do { \
    pg8::Gemm g_{(const bf16*)(Aptr), (const bf16*)(Bptr), R, (N_), (K_), (LD_), (size_t)(ZA_), (size_t)(ZB_)}; pg8::PanelOrder S_; S_.init((NM_), (N_), G, (int)blockIdx.x, (LAT_), (ZN_)); \
    pg8::gemm_phase<EPI_T, pg8::PanelOrder, true, true>(lds, g_, S_, E_); } while (0)
#define GEMM_PHASE_CTX(Aptr, Bptr, N_, KS_, LD_) do { const ep::EpiF32Part Ep_{(float*)YP}; \
    pg8::Gemm g_{(const bf16*)(Aptr), (const bf16*)(Bptr), R, (N_), (KS_), (LD_), (size_t)(KS_) * 2, (size_t)(KS_) * 2}; pg8::CtxSplitOrder S_; S_.init((N_), G, (int)blockIdx.x); \
    pg8::gemm_phase<ep::EpiF32Part, pg8::CtxSplitOrder, true, true>(lds, g_, S_, Ep_); } while (0)
#define GEMM_PHASE_LC(Aptr, Bptr, K_) do { const ep::EpiYMix Em_{Y, YP}; \
    pg8::Gemm g_{(const bf16*)(Aptr), (const bf16*)(Bptr), R, DM, (K_), (K_), (size_t)((K_) / 4) * 2, (size_t)((K_) / 4) * 2}; pg8::LatCtxOrder S_; S_.init(G, (int)blockIdx.x, (K_) / 256); \
    pg8::gemm_phase<ep::EpiYMix, pg8::LatCtxOrder, true, true>(lds, g_, S_, Em_); } while (0)
#define GEMM_PHASE(EPI_T, E_, Aptr, Bptr, N_, K_, NM_, LAT_) GEMM_PHASE_Z(EPI_T, E_, Aptr, Bptr, N_, K_, K_, 0, 0, 1, NM_, LAT_)

#define LTAB_FILL() do { __syncthreads(); { int tid0 = threadIdx.x; asm volatile("" : "+v"(tid0)); for (int e = tid0; e < 1024; e += NWAVES * 64) { const int pos = e >> 4, i = e & 15; \
        const float rev = (float)pos * __builtin_amdgcn_exp2f(-(float)i * 0.8304820237218406f) * 0.15915494309189535f; \
        ((LAS f32x2*)(lds + LTAB_OFF))[e] = (f32x2){__builtin_amdgcn_cosf(rev), __builtin_amdgcn_sinf(rev)}; } } __syncthreads(); } while (0)
__global__ void __launch_bounds__(NWAVES * 64, 2) fwd_kernel(Args a_in) {
    extern __shared__ __attribute__((aligned(16))) unsigned char lds_raw[];
    LAS unsigned char* lds = (LAS unsigned char*)lds_raw;
    constexpr int G = GRID;
    const int bx = blockIdx.x, vcu = (bx % 8) * (G / 8) + bx / 8, NGW = G * NWAVES;
    { const int tid0 = threadIdx.x; for (int u = tid0; u < (LDS_BYTES - LDSCTL_OFF) / 4; u += NWAVES * 64) ((LAS unsigned*)(lds + LDSCTL_OFF))[u] = 0u; }
    __syncthreads();
    XcdBarrier bar = xcd_barrier_post((unsigned*)(a_in.ws + WS_CTL) + CW_BAR, (volatile LAS unsigned*)(lds + MISC_OFF) + 8);
#define GRID_BAR() do { XcdBarrier b_ = bar; asm volatile("" : "+s"(b_.bar)); xcd_barrier(b_); } while (0)
#define PH_VARS \
    int tid = threadIdx.x; asm volatile("" : "+v"(tid)); const int lane = tid & 63, wave = __builtin_amdgcn_readfirstlane(tid >> 6), gw = vcu * NWAVES + wave; (void)lane; (void)gw; \
    const __attribute__((address_space(4))) Args* ap = (const __attribute__((address_space(4))) Args*)__builtin_amdgcn_kernarg_segment_ptr(); asm volatile("" : "+s"(ap)); const __attribute__((address_space(4))) Args& a = *ap;     \
    unsigned char* ws = a.ws; \
    float* MOD = (float*)(ws + WS_MOD); f32x2* TAB = (f32x2*)(ws + WS_TAB); float* HC = (float*)(ws + WS_HC); bf16* U = (bf16*)(ws + WS_U); \
    bf16* OA = (bf16*)(ws + WS_OA); bf16* OB = (bf16*)(ws + WS_OB); bf16* YR = (bf16*)(ws + WS_YR); float* MACC = (float*)(ws + WS_MACC); bf16* YP = (bf16*)MACC; bf16* HB = (bf16*)(ws + WS_MACC + 64 * MiB); \
    unsigned char* wt = ws + (l ? WS_WT1 : WS_WT); bf16* P = (bf16*)(ws + WS_R1); bf16* ACT = (bf16*)(ws + WS_R1 + R1_ACT); bf16* Y = (bf16*)(ws + WS_R1 + R1_Y); float* hlat = a.out; \
    const float* MODl = MOD + (size_t)l * 9 * 18432; const float* pre = a.in[6] + l * 3 * DM; const float* post = a.in[7] + l * 3 * DM; const int lat = (l == 1), nM = lat ? 64 : NPAN; \
    (void)MOD; (void)TAB; (void)HC; (void)U; (void)OA; (void)OB; (void)YR; (void)MACC; (void)YP; (void)HB; (void)wt; (void)P; (void)ACT; (void)Y; (void)hlat; (void)MODl; (void)pre; (void)post; (void)nM;

    for (int l = 0; l < 2; ++l) {
        if (l == 0) { PH_VARS
          if (bx < 72) p0_mod(a.in[1], a.in[3], a.in[4], a.in[5], MOD, lds, bx, 72, G, tid, wave, lane);
          else p0_convert(0, a.in[8], a.in[9], a.in[10], a.in[16], a.in[17], wt, lds, (bx - 72) * NWAVES + wave, (G - 72) * NWAVES, wave, lane, 0, P0_SPLIT);
          p0_convert(0, a.in[8], a.in[9], a.in[10], a.in[16], a.in[17], wt, lds, gw, NGW, wave, lane, P0_SPLIT, BG_NIT);
          GRID_BAR(); }
        if (l == 1 && BG3 < BG_NIT) { PH_VARS p0_convert(1, a.in[8], a.in[9], a.in[10], a.in[16], a.in[17], wt, lds, gw, NGW, wave, lane, BG3, BG_NIT); GRID_BAR(); }
        if (l == 0) {
            PH_VARS
            TArgs T{a.in[0], a.in[2], nullptr, nullptr, nullptr, nullptr, nullptr, 0.f, nullptr, nullptr, pre, MODl, MODl + DM, U, 0, 1, 0};
            if (T.xin) thin_phase<true>(T, lds, vcu, G, tid); else thin_phase<false>(T, lds, vcu, G, tid); GRID_BAR();
        }
        if (PROBE_DUP & 4096) { for (int e_ = 0; e_ < 10; ++e_) GRID_BAR(); }
        { PH_VARS const ep::EpiSwiGLU E{ACT}; GEMM_PHASE(ep::EpiSwiGLU, E, U, wt + WT_W1A, 2 * FFN, DM, NPAN, 0); } BG_CONVERT(96, 0, BG1); GRID_BAR();
        if (PROBE_DUP & 8192) { PH_VARS const ep::EpiNull E{OA}; GEMM_PHASE(ep::EpiNull, E, U, wt + WT_W1A, 2 * FFN, DM, NPAN, 0); GRID_BAR(); }
        if (PROBE_DUP & 4) { PH_VARS const ep::EpiSwiGLU E{ACT}; GEMM_PHASE(ep::EpiSwiGLU, E, U, wt + WT_W1A, 2 * FFN, DM, NPAN, 0); GRID_BAR(); }
        { PH_VARS GEMM_PHASE_LC(ACT, wt + WT_W2A, FFN); } GRID_BAR();
        if (PROBE_DUP & 8) { PH_VARS const ep::EpiBf16 E{Y, DM}; GEMM_PHASE(ep::EpiBf16, E, ACT, wt + WT_W2A, DM, FFN, 64, 1); GRID_BAR(); }
        if (PROBE_DUP & 2048) { PH_VARS GEMM_PHASE_CTX(ACT, wt + WT_W2A, DM, FFN / 4, FFN); GRID_BAR(); }
        if (PROBE_DUP & 32) { PH_VARS
            TArgs T{l == 0 ? a.in[0] : nullptr, a.in[2], HB, (bf16*)ACT, nullptr, Y, YP, 0.5f, MODl + 2 * DM, post, pre + DM, MODl + 3 * DM, MODl + 4 * DM, OA, 1, 1, 0};
            if (T.xin) thin_phase<true>(T, lds, vcu, G, tid); else thin_phase<false>(T, lds, vcu, G, tid); GRID_BAR(); }
        {
            PH_VARS
            TArgs T{l == 0 ? a.in[0] : nullptr, a.in[2], HB, HB, nullptr, Y, YP, 0.5f, MODl + 2 * DM, post, pre + DM, MODl + 3 * DM, MODl + 4 * DM, U, 1, 1, 0};
            if (T.xin) thin_phase<true>(T, lds, vcu, G, tid); else thin_phase<false>(T, lds, vcu, G, tid); } GRID_BAR();
        LTAB_FILL();
        if (l == 0) { PH_VARS const ep::EpiInProj E{P, (const LAS f32x2*)(lds + LTAB_OFF)}; GEMM_PHASE(ep::EpiInProj, E, U, wt + WT_IN, INC, DM, NPAN, 0); }
        else { { PH_VARS const ep::EpiInProj E{P, (const LAS f32x2*)(lds + LTAB_OFF)}; GEMM_PHASE(ep::EpiInProj, E, U, wt + WT_IN, INC, DM, 64, 1); }
               { PH_VARS const ep::EpiInProj E{P, (const LAS f32x2*)(lds + LTAB_OFF)}; pg8::Gemm g_{(const bf16*)U, (const bf16*)(wt + WT_IN), R, INC, DM, DM, 0, 0}; pg8::CtxColsOrder S_; S_.init(G, (int)blockIdx.x);
                 pg8::gemm_phase<ep::EpiInProj, pg8::CtxColsOrder, true, true>(lds, g_, S_, E); } }
        GRID_BAR();
        if (PROBE_DUP & 16) { LTAB_FILL(); PH_VARS const ep::EpiInProj E{P, (const LAS f32x2*)(lds + LTAB_OFF)}; GEMM_PHASE(ep::EpiInProj, E, U, wt + WT_IN, INC, DM, NPAN, 0); GRID_BAR(); }
        if (PROBE_DUP & (64 | 128 | 256)) { PH_VARS
          mix_mfma(l, lds, P, OA, OB, YR, a.in[11] + l * 256, a.in[12] + l * 128, a.in[13] + l * 8 * 465, a.in[14] + l * 16, a.in[15] + l * 128,
                   l == 0 ? 0.2f : 0.35550906759096926f, (const float*)U, (unsigned*)YP, vcu, G, tid, ((PROBE_DUP & 64) ? 1 : 0) | ((PROBE_DUP & 128) ? 4 : 0) | ((PROBE_DUP & 256) ? 2 : 0)); }
        { PH_VARS mix_states(lds, P, (float*)U, a.in[14] + l * 16, vcu, G, tid); } GRID_BAR();
        for (int rep_ = 0; rep_ < ((PROBE_DUP & 2) ? 2 : 1); ++rep_)
        { PH_VARS
          if (MFMA_MODES) mix_mfma(l, lds, P, OA, OB, YR, a.in[11] + l * 256, a.in[12] + l * 128, a.in[13] + l * 8 * 465, a.in[14] + l * 16, a.in[15] + l * 128,
                   l == 0 ? 0.2f : 0.35550906759096926f, (const float*)U, (unsigned*)YP, vcu, G, tid, MFMA_MODES);
          if ((7 & ~MFMA_MODES) != 0) mix_simple(l, P, OA, OB, YR, a.in[11] + l * 256, a.in[12] + l * 128, a.in[13] + l * 8 * 465, a.in[14] + l * 16, a.in[15] + l * 128,
                   l == 0 ? 0.2f : 0.35550906759096926f, (LAS float*)(lds + wave * 9216), gw, NGW, lane, 7 & ~MFMA_MODES); }
        GRID_BAR();
        for (int rep_ = 0; rep_ < ((PROBE_DUP & 512) ? 2 : 1); ++rep_) {
        { PH_VARS const ep::EpiMerge E{P + C_GATE, U}; GEMM_PHASE_Z(ep::EpiMerge, E, OA, wt + WT_WB, DM, 1024, 1024, WS_OB - WS_OA, (size_t)DM * 1024 * 2, 3, nM, lat); } }
        if (l == 0 && bx >= 64 && bx < 136) { PH_VARS p0_mod(a.in[1], a.in[3], a.in[4], a.in[5], MOD, lds, 72 + (bx - 64), 144, G, tid, wave, lane); }
        BG_CONVERT(136, BG2, BG3); GRID_BAR();
        if (l == 0) { PH_VARS GEMM_PHASE_LC(U, wt + WT_WO, DM); } else { PH_VARS const ep::EpiBf16 E{Y, DM}; GEMM_PHASE(ep::EpiBf16, E, U, wt + WT_WO, DM, DM, 64, 1); }
        GRID_BAR();
        if (PROBE_DUP & 1024) { PH_VARS const ep::EpiBf16 E{Y, DM}; GEMM_PHASE(ep::EpiBf16, E, U, wt + WT_WO, DM, DM, nM, lat); GRID_BAR(); }
        {
            PH_VARS
            TArgs T{nullptr, nullptr, HB, HB, nullptr, Y, YP, 1.0f, MODl + 5 * DM, post + DM, pre + 2 * DM, MODl + 6 * DM, MODl + 7 * DM, U, 1, 1, lat};
            if (T.xin) thin_phase<true>(T, lds, vcu, G, tid); else thin_phase<false>(T, lds, vcu, G, tid); } GRID_BAR();
        { PH_VARS const ep::EpiSwiGLU E{ACT}; GEMM_PHASE(ep::EpiSwiGLU, E, U, wt + WT_W1B, 2 * FFN, DM, nM, lat); } BG_CONVERT(96, BG1, BG2); GRID_BAR();
        if (l == 0) { PH_VARS GEMM_PHASE_LC(ACT, wt + WT_W2B, FFN); } else { PH_VARS const ep::EpiBf16 E{Y, DM}; GEMM_PHASE(ep::EpiBf16, E, ACT, wt + WT_W2B, DM, FFN, 64, 1); }
        GRID_BAR();
        {
            PH_VARS
            const float* MOD1 = MOD + (size_t)9 * 18432;
            TArgs T{nullptr, nullptr, HB, HB, l == 1 ? hlat : nullptr, Y, YP, 0.5f, MODl + 8 * DM, post + 2 * DM, a.in[6] + 3 * DM, MOD1, MOD1 + DM, U, 1, l == 0 ? 1 : 0, lat};
            if (T.xin) thin_phase<true>(T, lds, vcu, G, tid); else thin_phase<false>(T, lds, vcu, G, tid); }
        if (l == 0) GRID_BAR();
    }
}

extern "C" void kernel_launch(void* const* d_in, const int* in_sizes, int n_in, void* d_out, int out_size, void* d_ws, size_t ws_size, hipStream_t stream) {
    static int grid = 0;
    if (grid == 0) {
        if (n_in != 18 || in_sizes[0] != NBATCH * SEQ * DM || out_size != NBATCH * SEQ * DM || ws_size < WS_END) {
            fprintf(stderr, "kernel_launch: unexpected shapes / workspace (n_in %d, in0 %d, out %d, ws %zu, need %zu); nothing launched\n", n_in, n_in > 0 ? in_sizes[0] : -1, out_size, ws_size, (size_t)WS_END); grid = -1; return; }
        int dev = 0, cus = 0, per_cu = 0;
        if (hipGetDevice(&dev) != hipSuccess || hipDeviceGetAttribute(&cus, hipDeviceAttributeMultiprocessorCount, dev) != hipSuccess) { grid = -1; return; }
        if (hipFuncSetAttribute((const void*)fwd_kernel, hipFuncAttributeMaxDynamicSharedMemorySize, LDS_BYTES) != hipSuccess) { fprintf(stderr, "kernel_launch: hipFuncSetAttribute failed\n"); grid = -1; return; }
        if (hipOccupancyMaxActiveBlocksPerMultiprocessor(&per_cu, (const void*)fwd_kernel, NWAVES * 64, LDS_BYTES) != hipSuccess || per_cu < 1)
            fprintf(stderr, "kernel_launch: note: occupancy query says %d workgroups per CU\n", per_cu);
        (void)hipGetLastError();
        if (cus < GRID) { fprintf(stderr, "kernel_launch: this kernel needs %d CUs (device has %d); nothing launched\n", GRID, cus); grid = -1; return; }
        grid = GRID;
    }
    if (grid < 0) return;
    if (hipMemsetAsync((char*)d_ws + WS_CTL, 0, CTL_ZERO_BYTES, stream) != hipSuccess) { fprintf(stderr, "kernel_launch: memset failed\n"); return; }
    Args a{};
    for (int i = 0; i < 18; ++i) a.in[i] = (const float*)d_in[i];
    a.out = (float*)d_out; a.ws = (unsigned char*)d_ws;
    hipLaunchKernelGGL(fwd_kernel, dim3(grid), dim3(NWAVES * 64), LDS_BYTES, stream, a);
    const hipError_t le = hipPeekAtLastError();
    if (le != hipSuccess) fprintf(stderr, "kernel_launch: launch failed: %s\n", hipGetErrorName(le));
}
```
